# Optimizing an MI355X kernel written in HIP

```python
import jax, jax.numpy as jnp
from jax import lax
import numpy as np

D_MODEL = 4096
BATCH = 1
SEQ = 16384
DEPTH = 1
DEC_BATCH = 32
DEC_SEQ = 32
PAST_LEN = 1024

CHUNK = 64
N_PAST_CHUNKS = 8
BAND_PAST = N_PAST_CHUNKS * CHUNK
BAND = BAND_PAST + CHUNK
D_MIX = D_MODEL
D_CONV = D_MIX // 2
D_ATTN = D_MIX - D_CONV
HEAD_DIM = 128
N_HEADS = D_ATTN // HEAD_DIM
CONV_WIDTH = 3
MAX_REL = 256
NORM_EPS = 1e-6
ATTN_SCALE = HEAD_DIM ** -0.5
ADA_INIT = 0.2
IN_SPLITS = (D_CONV, 2 * D_CONV, 3 * D_CONV, 4 * D_CONV,
             4 * D_CONV + D_ATTN, 4 * D_CONV + 2 * D_ATTN, 4 * D_CONV + 3 * D_ATTN)
W_IN_COLS = 4 * D_CONV + 4 * D_ATTN

kernel_name = "hybrid_conv_chunkattn_stream_step"


def rmsnorm(x, g):
    xf = x.astype(jnp.float32)
    xf = xf * lax.rsqrt(jnp.mean(xf * xf, axis=-1, keepdims=True) + NORM_EPS)
    return xf.astype(x.dtype) * g


def branch_inputs(x, c, g_norm, w_ada, b_ada, w_in):
    mod = (c @ w_ada + b_ada)[:, None, :]
    shift, scale, gate = jnp.split(mod, 3, axis=-1)
    h = rmsnorm(x, g_norm) * (1 + scale) + shift
    parts = jnp.split(h @ w_in, IN_SPLITS, axis=-1)
    return parts, gate


def depthwise_conv(u_ext, conv_w, conv_b):
    t = u_ext.shape[1] - (CONV_WIDTH - 1)
    out = conv_b
    for i in range(CONV_WIDTH):
        out = out + conv_w[i] * u_ext[:, i:i + t]
    return out


def rel_bias_lookup(rel_bias, rel):
    return rel_bias[:, jnp.clip(rel, -MAX_REL, MAX_REL) + MAX_REL]


def band_attention(q, k, v, bias, mask):
    s = jnp.einsum('bqhd,bkhd->bhqk', q, k).astype(jnp.float32) * ATTN_SCALE + bias.astype(jnp.float32)
    if mask is not None:
        s = jnp.where(mask, s, -jnp.inf)
    p = jax.nn.softmax(s, axis=-1).astype(v.dtype)
    return jnp.einsum('bhqk,bkhd->bqhd', p, v)


def merge(x, a, o, z_conv, z_attn, gate, w_out):
    mixed = jnp.concatenate([a * jax.nn.silu(z_conv), o * jax.nn.silu(z_attn)], axis=-1)
    return x + gate * (mixed @ w_out)


def prompt_layer(x, c, g_norm, w_ada, b_ada, w_in, conv_w, conv_b, rel_bias, w_out):
    bsz, seq, _ = x.shape
    (xin, bg, cg, z_conv, q, k, v, z_attn), gate = branch_inputs(x, c, g_norm, w_ada, b_ada, w_in)
    u = cg * xin
    u_ext = jnp.pad(u, ((0, 0), (CONV_WIDTH - 1, 0), (0, 0)))
    a = bg * depthwise_conv(u_ext, conv_w, conv_b)
    n_chunks = seq // CHUNK
    q, k, v = (t.reshape(bsz, seq, N_HEADS, HEAD_DIM) for t in (q, k, v))
    pad = ((0, 0), (BAND_PAST, 0), (0, 0), (0, 0))
    kp, vp = jnp.pad(k, pad), jnp.pad(v, pad)
    offs = jnp.arange(BAND)
    bias = rel_bias_lookup(rel_bias, jnp.arange(CHUNK)[:, None] + BAND_PAST - offs[None, :])
    q_chunks = jnp.moveaxis(q.reshape(bsz, n_chunks, CHUNK, N_HEADS, HEAD_DIM), 1, 0)

    def one_chunk(args):
        ci, qc = args
        start = ci * CHUNK
        kb = lax.dynamic_slice_in_dim(kp, start, BAND, axis=1)
        vb = lax.dynamic_slice_in_dim(vp, start, BAND, axis=1)
        mask = (start - BAND_PAST + offs >= 0)[None, :]
        return band_attention(qc, kb, vb, bias, mask)

    o = lax.map(one_chunk, (jnp.arange(n_chunks), q_chunks))
    o = jnp.moveaxis(o, 0, 1).reshape(bsz, seq, D_ATTN)
    x_new = merge(x, a, o, z_conv, z_attn, gate, w_out)
    rows = min(BAND_PAST, seq)
    return x_new, k[:, seq - rows:], v[:, seq - rows:], u[:, seq - (CONV_WIDTH - 1):]


def sample_layer(x, c, cache_k, cache_v, cache_conv, g_norm, w_ada, b_ada, w_in, conv_w, conv_b, rel_bias, w_out):
    bsz, t, _ = x.shape
    (xin, bg, cg, z_conv, q, k, v, z_attn), gate = branch_inputs(x, c, g_norm, w_ada, b_ada, w_in)
    u = cg * xin
    u_ext = jnp.concatenate([cache_conv, u], axis=1)
    a = bg * depthwise_conv(u_ext, conv_w, conv_b)
    q, k, v = (z.reshape(bsz, t, N_HEADS, HEAD_DIM) for z in (q, k, v))
    r = cache_k.shape[1]
    kc = jnp.concatenate([cache_k, k], axis=1)
    vc = jnp.concatenate([cache_v, v], axis=1)
    bias = rel_bias_lookup(rel_bias, r + jnp.arange(t)[:, None] - jnp.arange(r + t)[None, :])
    o = band_attention(q, kc, vc, bias, None).reshape(bsz, t, D_ATTN)
    x_new = merge(x, a, o, z_conv, z_attn, gate, w_out)
    return x_new, k, v, u_ext[:, -(CONV_WIDTH - 1):]


def setup_inputs(seed: int = 0) -> dict:
    key = jax.random.key(seed)
    ks = jax.random.split(key, 16)
    f32 = jnp.float32
    r = min(BAND_PAST, PAST_LEN)
    nrm = lambda k, s: jax.random.normal(k, s, f32)
    return {
        'x_prompt': nrm(ks[0], (BATCH, SEQ, D_MODEL)),
        'x_sample': nrm(ks[1], (DEC_BATCH, DEC_SEQ, D_MODEL)),
        'cache_k': nrm(ks[2], (DEPTH, DEC_BATCH, r, N_HEADS, HEAD_DIM)),
        'cache_v': nrm(ks[3], (DEPTH, DEC_BATCH, r, N_HEADS, HEAD_DIM)),
        'cache_conv': nrm(ks[4], (DEPTH, DEC_BATCH, CONV_WIDTH - 1, D_CONV)),
        'c_prompt': nrm(ks[5], (BATCH, D_MODEL)),
        'c_sample': nrm(ks[6], (DEC_BATCH, D_MODEL)),
        'g_norm': 1.0 + 0.01 * nrm(ks[7], (DEPTH, D_MODEL)),
        'w_ada': ADA_INIT * D_MODEL ** -0.5 * nrm(ks[8], (DEPTH, D_MODEL, 3 * D_MODEL)),
        'b_ada': 0.02 * nrm(ks[9], (DEPTH, 3 * D_MODEL)),
        'w_in': D_MODEL ** -0.5 * nrm(ks[10], (DEPTH, D_MODEL, W_IN_COLS)),
        'conv_w': CONV_WIDTH ** -0.5 * nrm(ks[11], (DEPTH, CONV_WIDTH, D_CONV)),
        'conv_b': 0.01 * nrm(ks[12], (DEPTH, D_CONV)),
        'rel_bias': 0.5 * nrm(ks[13], (DEPTH, N_HEADS, 2 * MAX_REL + 1)),
        'w_out': D_MIX ** -0.5 * nrm(ks[14], (DEPTH, D_MIX, D_MODEL)),
        'g_final': 1.0 + 0.01 * nrm(ks[15], (D_MODEL,)),
    }


def reference(x_prompt, x_sample, cache_k, cache_v, cache_conv, c_prompt, c_sample,
              g_norm, w_ada, b_ada, w_in, conv_w, conv_b, rel_bias, w_out, g_final):
    xp, xs = x_prompt, x_sample
    kp_l, vp_l, up_l, ks_l, vs_l, us_l = [], [], [], [], [], []
    for l in range(DEPTH):
        xp, kp, vp, up = prompt_layer(xp, c_prompt, g_norm[l], w_ada[l], b_ada[l], w_in[l],
                                      conv_w[l], conv_b[l], rel_bias[l], w_out[l])
        xs, kn, vn, un = sample_layer(xs, c_sample, cache_k[l], cache_v[l], cache_conv[l],
                                      g_norm[l], w_ada[l], b_ada[l], w_in[l],
                                      conv_w[l], conv_b[l], rel_bias[l], w_out[l])
        kp_l.append(kp); vp_l.append(vp); up_l.append(up)
        ks_l.append(kn); vs_l.append(vn); us_l.append(un)
    y_prompt = rmsnorm(xp, g_final)
    y_sample = rmsnorm(xs, g_final)
    return (y_prompt, y_sample, jnp.stack(kp_l), jnp.stack(vp_l), jnp.stack(up_l),
            jnp.stack(ks_l), jnp.stack(vs_l), jnp.stack(us_l))
```

```cpp
#include <hip/hip_runtime.h>
#include <cstdio>
#include <cstdint>

#ifndef MK_N_LAUNCHES
#define MK_N_LAUNCHES 1
#endif
constexpr int N_LAUNCHES = MK_N_LAUNCHES;
constexpr int PER_PHASE = 6;

constexpr int DM = 4096, MP = 16384, NSB = 32, NST = 32, MS = NSB * NST, MT = MP + MS;
constexpr int LDK = DM + 64;
constexpr int NIN = 16384, DC = 2048, DA = 2048, NH = 16, HD = 128;
constexpr int KPITCH = 576;
constexpr int KROWS = MP + NSB * KPITCH;
constexpr float NORM_EPS = 1e-6f;
constexpr float LOG2E = 1.4426950408889634f;
constexpr float QSCALE = 0.08838834764831845f * LOG2E;
constexpr size_t O_YP = 0, O_YS = (size_t)MP * DM, O_KP = O_YS + (size_t)MS * DM, O_VP = O_KP + 512 * 2048, O_CP = O_VP + 512 * 2048, O_KS = O_CP + 2 * 2048,
                 O_VS = O_KS + (size_t)MS * 2048, O_CS = O_VS + (size_t)MS * 2048, O_END = O_CS + (size_t)NSB * 2 * 2048;
static_assert(O_END == 77729792, "output size");

namespace pg8 {
#define PG8_LAS __attribute__((address_space(3)))
typedef unsigned short bf16_t;
typedef short bf16x8 __attribute__((ext_vector_type(8)));
typedef float f32x4 __attribute__((ext_vector_type(4)));
typedef unsigned u32x4 __attribute__((ext_vector_type(4)));
constexpr int BM = 256, BK = 64, HALF = 128, HTB = HALF * BK * 2  , STAGE_BYTES = 8 * HTB, NXCD = 8, WGM = 8;

__host__ __device__ __forceinline__ int lds_byte(int r, int c) { const int st = (r >> 4) * 2 + (c >> 5), rr = r & 15, cc = c & 31, ob = rr * 64 + cc * 2; return st * 1024 + (ob ^ (((ob >> 9) & 1) << 5)); }
__host__ __device__ __forceinline__ void stage_rc(int b, int& R, int& C) { const int st = b / 1024, sb = b % 1024, swz = sb ^ (((sb >> 9) & 1) << 5); R = (st >> 1) * 16 + swz / 64; C = (st & 1) * 32 + (swz % 64) / 2; }
__host__ __device__ __forceinline__ int perm32(int rho) { const int n = rho >> 4, i = rho & 15; return 8 * (i >> 2) + 4 * n + (i & 3); }

struct Unit { int pm, pn, kb, nt, part; };
struct Gemm { const bf16_t* A; const bf16_t* Bt; int M, N, K, ld;
#if defined(PROBE_GEMM)
    int probe;
#endif
};

struct StaticOrder {
    int nM, nN, nwg, G, c, nK;
#if defined(PROBE_HOT)
    int hot;
#endif
    __host__ __device__ void init(int M, int N, int K, int G_, int c_) { nM = M / BM; nN = N / BM; nK = K / BK; nwg = nM * nN; G = G_; c = c_;
#if defined(PROBE_HOT)
        hot = 0;
#endif
    }
    __host__ __device__ bool next(int i, Unit& u) const {
        const long L = (long)i * G + c; if (L >= nwg) return false;
#if defined(PROBE_HOT)
        if (hot) { const int l = c >> 3; u.pm = l & 7; u.pn = (l >> 3) + PROBE_HOT - 1; return true; }
#endif
        int wgid = (int)L; { const int q = nwg / NXCD, r = nwg % NXCD, xcd = wgid % NXCD, off = wgid / NXCD; wgid = (xcd < r ? xcd * (q + 1) : r * (q + 1) + (xcd - r) * q) + off; }
        const int nig = WGM * nN, gid = wgid / nig, fm = gid * WGM, gsz = (nM - fm) < WGM ? (nM - fm) : WGM;
        u.pm = fm + ((wgid % nig) % gsz); u.pn = (wgid % nig) / gsz; u.kb = 0; u.nt = nK; u.part = -1; return true;
    }
    __device__ __forceinline__ void a_ready(const Unit&) const {}
    __device__ __forceinline__ void done(const Unit&) const {}
};
__device__ __forceinline__ unsigned cvt_pk_bf16(float lo, float hi) { unsigned r; asm volatile("v_cvt_pk_bf16_f32 %0, %1, %2" : "=v"(r) : "v"(lo), "v"(hi)); return r; }
typedef float f32x2 __attribute__((ext_vector_type(2)));
__device__ __forceinline__ float silu_f(float x) { return x * __builtin_amdgcn_rcpf(1.0f + __builtin_amdgcn_exp2f(-1.4426950408889634f * x)); }
__device__ __forceinline__ f32x4 silu4(f32x4 v) { f32x4 r; r[0] = silu_f(v[0]); r[1] = silu_f(v[1]); r[2] = silu_f(v[2]); r[3] = silu_f(v[3]); return r; }
__device__ __forceinline__ u32x4 pack8(f32x4 v0, f32x4 v1) { u32x4 w; w.x = cvt_pk_bf16(v0[0], v0[1]); w.y = cvt_pk_bf16(v0[2], v0[3]); w.z = cvt_pk_bf16(v1[0], v1[1]); w.w = cvt_pk_bf16(v1[2], v1[3]); return w; }
__device__ __forceinline__ int krow_of(int row) { return row < MP ? row : MP + ((row - MP) >> 5) * KPITCH + 512 + (row & 31); }

struct EpiIn {
    static constexpr bool PERM = true, AFTER_DRAIN = false;
    bf16_t *U, *G, *Q, *SZ, *KA, *VA; float* out;
    __device__ __forceinline__ void operator()(const f32x4 (&acc)[2][2][4][2], const Unit& u, int wr, int wc, int fr, int fq) const {
        const int pn = u.pn, row0 = u.pm * BM + wr * 64 + fr;
        if (pn < 32) {
            const int col = (pn & 15) * 128 + wc * 32 + 8 * fq;
            if (pn < 16) {
#pragma unroll
                for (int ai = 0; ai < 2; ++ai)
#pragma unroll
                    for (int m = 0; m < 4; ++m) { const int row = row0 + ai * HALF + m * 16;
                        const f32x4 v0 = acc[ai][0][m][0] * acc[ai][1][m][0], v1 = acc[ai][0][m][1] * acc[ai][1][m][1];
                        *(u32x4*)(U + (size_t)row * DC + col) = pack8(v0, v1);
                        if (u.pm >= 63) { long o = -1;
                            if (row >= MP) { const int t = row & 31; if (t >= 30) o = (long)O_CS + (long)((((row - MP) >> 5) * 2 + (t - 30)) * 2048); }
                            else if (row >= MP - 2) o = (long)O_CP + (long)((row - (MP - 2)) * 2048);
                            if (o >= 0) { *(f32x4*)(out + o + col) = v0; *(f32x4*)(out + o + col + 4) = v1; } } }
            } else {
#pragma unroll
                for (int ai = 0; ai < 2; ++ai)
#pragma unroll
                    for (int m = 0; m < 4; ++m) { const int row = row0 + ai * HALF + m * 16;
                        const f32x4 v0 = acc[ai][0][m][0] * silu4(acc[ai][1][m][0]), v1 = acc[ai][0][m][1] * silu4(acc[ai][1][m][1]);
                        *(u32x4*)(G + (size_t)row * DC + col) = pack8(v0, v1); }
            }
        } else {
            const int part = (pn - 32) >> 3, colp = ((pn - 32) & 7) * 256 + wc * 32 + 8 * fq;
            if (part == 0) {
#pragma unroll
                for (int ai = 0; ai < 2; ++ai)
#pragma unroll
                    for (int m = 0; m < 4; ++m) { const int row = row0 + ai * HALF + m * 16;
#pragma unroll
                        for (int bj = 0; bj < 2; ++bj) *(u32x4*)(Q + (size_t)row * DA + colp + bj * HALF) = pack8(acc[ai][bj][m][0] * QSCALE, acc[ai][bj][m][1] * QSCALE); }
            } else if (part == 3) {
#pragma unroll
                for (int ai = 0; ai < 2; ++ai)
#pragma unroll
                    for (int m = 0; m < 4; ++m) { const int row = row0 + ai * HALF + m * 16;
#pragma unroll
                        for (int bj = 0; bj < 2; ++bj) *(u32x4*)(SZ + (size_t)row * DA + colp + bj * HALF) = pack8(silu4(acc[ai][bj][m][0]), silu4(acc[ai][bj][m][1])); }
            } else {
                bf16_t* dst = part == 1 ? KA : VA;
                float* odp = out + (part == 1 ? O_KP : O_VP); float* ods = out + (part == 1 ? O_KS : O_VS);
#pragma unroll
                for (int ai = 0; ai < 2; ++ai)
#pragma unroll
                    for (int m = 0; m < 4; ++m) { const int row = row0 + ai * HALF + m * 16; const size_t kr = (size_t)krow_of(row);
#pragma unroll
                        for (int bj = 0; bj < 2; ++bj) { *(u32x4*)(dst + kr * DA + colp + bj * HALF) = pack8(acc[ai][bj][m][0], acc[ai][bj][m][1]);
                            if (u.pm >= 62) { float* o = row >= MP ? ods + (size_t)(row - MP) * DA : odp + (size_t)(row - (MP - 512)) * DA;
                                *(f32x4*)(o + colp + bj * HALF) = acc[ai][bj][m][0]; *(f32x4*)(o + colp + bj * HALF + 4) = acc[ai][bj][m][1]; } } }
            }
        }
    }
};
struct EpiOut {
    static constexpr bool PERM = true, AFTER_DRAIN = false;
    const float *xp, *xs, *gate; bf16_t* XN; float* PART;
    __device__ __forceinline__ void operator()(const f32x4 (&acc)[2][2][4][2], const Unit& u, int wr, int wc, int fr, int fq) const {
        const int row0 = u.pm * BM + wr * 64 + fr, col = u.pn * BM + wc * 32 + 8 * fq;
        if (u.part >= 0) {
            float* pb = PART + (size_t)u.part * MS * DM;
#pragma unroll
            for (int ai = 0; ai < 2; ++ai)
#pragma unroll
                for (int m = 0; m < 4; ++m) { float* pr = pb + (size_t)(row0 + ai * HALF + m * 16 - MP) * DM + col;
#pragma unroll
                    for (int bj = 0; bj < 2; ++bj) { *(f32x4*)(pr + bj * HALF) = acc[ai][bj][m][0]; *(f32x4*)(pr + bj * HALF + 4) = acc[ai][bj][m][1]; } }
            return;
        }
#pragma unroll
        for (int ai = 0; ai < 2; ++ai)
#pragma unroll
            for (int m = 0; m < 4; ++m) { const int row = row0 + ai * HALF + m * 16;
                const float* xr = row < MP ? xp + (size_t)row * DM : xs + (size_t)(row - MP) * DM;
                const float* gr = gate + (size_t)(row < MP ? 0 : 1 + ((row - MP) >> 5)) * DM;
                bf16_t* yr = XN + (size_t)row * DM;
#pragma unroll
                for (int bj = 0; bj < 2; ++bj) { const int c = col + bj * HALF;
                    const f32x4 x0 = *(const f32x4*)(xr + c), x1 = *(const f32x4*)(xr + c + 4), g0 = *(const f32x4*)(gr + c), g1 = *(const f32x4*)(gr + c + 4);
                    *(u32x4*)(yr + c) = pack8(x0 + g0 * acc[ai][bj][m][0], x1 + g1 * acc[ai][bj][m][1]); } }
    }
};
struct TailSplitOrder {
    StaticOrder so; int c;
    __device__ void init(int G, int c_) { so.init(MP, DM, DM, G, c_); c = c_; }
    __device__ bool next(int i, Unit& u) const {
        if (i < 4) return so.next(i, u);
        if (i > 4) return false;
        const int kq = c & 3, r = c >> 2; u.pm = MP / BM + (r & 3); u.pn = r >> 2; u.kb = kq * (DM / 4) * 2; u.nt = DM / 4 / BK; u.part = kq; return true;
    }
    __device__ __forceinline__ void a_ready(const Unit&) const {}
    __device__ __forceinline__ void done(const Unit&) const {}
};
template <class Epi, class Sched, bool ALIGN_EPI = false, bool SP2 = false>
__device__ __forceinline__ void gemm_phase(PG8_LAS unsigned char* lds, const Gemm g, const Sched& S, const Epi& E) {
    const int tid = threadIdx.x, wid = __builtin_amdgcn_readfirstlane(tid >> 6), lane = tid & 63, wr = wid >> 2, wc = wid & 3, fr = lane & 15, fq = lane >> 4;
    const int LD = g.ld;
    unsigned voffA[2], voffB[2];
#pragma unroll
    for (int i = 0; i < 2; ++i) { int R, C; stage_rc(tid * 16 + i * 8192, R, C); const int Rb = Epi::PERM ? ((R & ~31) + perm32(R & 31)) : R;
        voffA[i] = (unsigned)(R * LD + C) * 2u; voffB[i] = (unsigned)(Rb * LD + C) * 2u; }
    const size_t kstep = (size_t)(BK * 2);
    const size_t hstep = (size_t)HALF * LD * 2;
    const size_t tstep = 2 * hstep;
    const unsigned ldsw = (unsigned)wid * 1024u;
    const int aoff = lds_byte(wr * 64 + fr, fq * 8), boff = lds_byte(wc * 32 + fr, fq * 8);
#define PG8_SA(b, h) (((b) * 2 + (h)) * HTB)
#define PG8_SB(b, h) ((4 + (b) * 2 + (h)) * HTB)
#if defined(PROBE_GEMM)
    const int pf = g.probe;
#define PG8_PF(b) if (!(pf & (b)))
#else
#define PG8_PF(b)
#endif
#define PG8_STAGE(bufoff, gbase, voff) do { PG8_PF(2) _Pragma("unroll") for (int _i = 0; _i < 2; ++_i) \
        __builtin_amdgcn_global_load_lds((const unsigned*)((const char*)(gbase) + (voff)[_i]), (PG8_LAS unsigned*)(lds + (bufoff) + ldsw + _i * 8192), 16, 0, 0); } while (0)
#define PG8_LDA(dst, b, h) do { _Pragma("unroll") for (int m = 0; m < 4; ++m) _Pragma("unroll") for (int k = 0; k < 2; ++k) dst[m][k] = *(const PG8_LAS bf16x8*)(lds + PG8_SA(b, h) + aoff + m * 2048 + k * 1024); } while (0)
#define PG8_LDB(dst, b, h) do { _Pragma("unroll") for (int n = 0; n < 2; ++n) _Pragma("unroll") for (int k = 0; k < 2; ++k) dst[n][k] = *(const PG8_LAS bf16x8*)(lds + PG8_SB(b, h) + boff + n * 2048 + k * 1024); } while (0)
#define PG8_MMA(ai, bj, At, Bt) do { __builtin_amdgcn_s_setprio(1); PG8_PF(1) _Pragma("unroll") for (int m = 0; m < 4; ++m) _Pragma("unroll") for (int n = 0; n < 2; ++n) _Pragma("unroll") for (int k = 0; k < 2; ++k) \
        acc[ai][bj][m][n] = __builtin_amdgcn_mfma_f32_16x16x32_bf16(Bt[n][k], At[m][k], acc[ai][bj][m][n], 0, 0, 0); __builtin_amdgcn_s_setprio(0); } while (0)
#define PG8_WAIT_V(n) asm volatile("s_waitcnt vmcnt(" #n ")" ::: "memory")
#define PG8_WAIT_L(n) asm volatile("s_waitcnt lgkmcnt(" #n ")" ::: "memory")
#define PG8_BAR __builtin_amdgcn_s_barrier()
#define PG8_SCHED __builtin_amdgcn_sched_barrier(0)
    Unit cur, nxt; int ui = 0;
    if (!S.next(0, cur)) return;
    f32x4 acc[2][2][4][2];
#pragma unroll
    for (int a = 0; a < 2; ++a)
#pragma unroll
        for (int b = 0; b < 2; ++b)
#pragma unroll
            for (int m = 0; m < 4; ++m)
#pragma unroll
                for (int n = 0; n < 2; ++n) acc[a][b][m][n] = (f32x4){0.f, 0.f, 0.f, 0.f};
    bf16x8 At[4][2], B0[2][2], B1[2][2];
    const char* cA = (const char*)g.A + (size_t)cur.pm * tstep + cur.kb; const char* cB = (const char*)g.Bt + (size_t)cur.pn * tstep + cur.kb;
    S.a_ready(cur);
    if constexpr (SP2) {
        PG8_STAGE(PG8_SB(0, 0), cB, voffB); PG8_STAGE(PG8_SB(0, 1), cB + hstep, voffB); PG8_STAGE(PG8_SA(0, 0), cA, voffA); PG8_STAGE(PG8_SA(0, 1), cA + hstep, voffA);
        if (wr == 1) PG8_BAR;
        PG8_WAIT_V(2); PG8_BAR;
        PG8_STAGE(PG8_SB(1, 0), cB + kstep, voffB); PG8_STAGE(PG8_SA(1, 0), cA + kstep, voffA); PG8_STAGE(PG8_SB(1, 1), cB + hstep + kstep, voffB);
        PG8_WAIT_V(6); PG8_BAR;
    } else {
        PG8_STAGE(PG8_SB(0, 0), cB, voffB); PG8_STAGE(PG8_SA(0, 0), cA, voffA); PG8_STAGE(PG8_SB(0, 1), cB + hstep, voffB); PG8_STAGE(PG8_SA(0, 1), cA + hstep, voffA);
        if (wr == 1) PG8_BAR;
        PG8_WAIT_V(4); PG8_BAR;
        PG8_STAGE(PG8_SB(1, 0), cB + kstep, voffB); PG8_STAGE(PG8_SA(1, 0), cA + kstep, voffA); PG8_STAGE(PG8_SB(1, 1), cB + hstep + kstep, voffB);
        PG8_WAIT_V(6); PG8_BAR;
    }
    for (;;) {
        const bool has_next = S.next(ui + 1, nxt);
        const char* nA = has_next ? (const char*)g.A + (size_t)nxt.pm * tstep + nxt.kb : cA; const char* nB = has_next ? (const char*)g.Bt + (size_t)nxt.pn * tstep + nxt.kb : cB;
        const int nt = cur.nt;
        for (int t = 0; t < nt; t += 2) {
            const bool last = (t == nt - 2);
            const char* a1 = cA + (size_t)(t + 1) * kstep;
            const char* a2 = last ? nA : cA + (size_t)(t + 2) * kstep; const char* b2 = last ? nB : cB + (size_t)(t + 2) * kstep;
            const char* a3 = a2 + kstep; const char* b3 = b2 + kstep;
            if (last && has_next) S.a_ready(nxt);
            if constexpr (SP2) {
            PG8_LDB(B0, 0, 0); PG8_LDB(B1, 0, 1); PG8_SCHED; PG8_LDA(At, 0, 0); PG8_STAGE(PG8_SA(1, 1), a1 + hstep, voffA);
            PG8_WAIT_V(8); PG8_WAIT_L(0); PG8_BAR; PG8_MMA(0, 0, At, B0); PG8_MMA(0, 1, At, B1); PG8_BAR; PG8_SCHED;
            PG8_LDA(At, 0, 1); PG8_STAGE(PG8_SB(0, 0), b2, voffB); PG8_STAGE(PG8_SB(0, 1), b2 + hstep, voffB); PG8_STAGE(PG8_SA(0, 0), a2, voffA);
            PG8_WAIT_V(8); PG8_WAIT_L(0); PG8_BAR; PG8_MMA(1, 0, At, B0); PG8_MMA(1, 1, At, B1); PG8_BAR; PG8_SCHED;
            PG8_LDB(B0, 1, 0); PG8_LDB(B1, 1, 1); PG8_SCHED; PG8_LDA(At, 1, 0); PG8_STAGE(PG8_SA(0, 1), a2 + hstep, voffA);
            PG8_WAIT_V(8); PG8_WAIT_L(0); PG8_BAR; PG8_MMA(0, 0, At, B0); PG8_MMA(0, 1, At, B1); PG8_BAR; PG8_SCHED;
            PG8_LDA(At, 1, 1); PG8_STAGE(PG8_SB(1, 0), b3, voffB); PG8_STAGE(PG8_SB(1, 1), b3 + hstep, voffB); PG8_STAGE(PG8_SA(1, 0), a3, voffA);
            PG8_WAIT_V(8); PG8_WAIT_L(0); PG8_BAR; PG8_MMA(1, 0, At, B0); PG8_MMA(1, 1, At, B1); PG8_BAR; PG8_SCHED;
            } else {
            PG8_LDB(B0, 0, 0); PG8_SCHED; PG8_LDA(At, 0, 0); PG8_STAGE(PG8_SA(1, 1), a1 + hstep, voffA);
            PG8_WAIT_L(8); PG8_BAR; PG8_WAIT_L(0); PG8_MMA(0, 0, At, B0); PG8_BAR; PG8_SCHED;
            PG8_LDB(B1, 0, 1); PG8_STAGE(PG8_SB(0, 0), b2, voffB);
            PG8_BAR; PG8_WAIT_L(0); PG8_MMA(0, 1, At, B1); PG8_BAR;
            PG8_LDA(At, 0, 1); PG8_STAGE(PG8_SA(0, 0), a2, voffA);
            PG8_BAR; PG8_WAIT_L(0); PG8_MMA(1, 0, At, B0); PG8_BAR; PG8_SCHED;
            PG8_STAGE(PG8_SB(0, 1), b2 + hstep, voffB);
            PG8_WAIT_V(6); PG8_BAR; PG8_MMA(1, 1, At, B1); PG8_BAR;
            PG8_LDB(B0, 1, 0); PG8_SCHED; PG8_LDA(At, 1, 0); PG8_STAGE(PG8_SA(0, 1), a2 + hstep, voffA);
            PG8_WAIT_L(8); PG8_BAR; PG8_WAIT_L(0); PG8_MMA(0, 0, At, B0); PG8_BAR; PG8_SCHED;
            PG8_LDB(B1, 1, 1); PG8_STAGE(PG8_SB(1, 0), b3, voffB);
            PG8_BAR; PG8_WAIT_L(0); PG8_MMA(0, 1, At, B1); PG8_BAR;
            PG8_LDA(At, 1, 1); PG8_STAGE(PG8_SA(1, 0), a3, voffA);
            PG8_BAR; PG8_WAIT_L(0); PG8_MMA(1, 0, At, B0); PG8_BAR; PG8_SCHED;
            PG8_STAGE(PG8_SB(1, 1), b3 + hstep, voffB);
            PG8_WAIT_V(6); PG8_BAR; PG8_MMA(1, 1, At, B1); PG8_BAR;
            }
        }
        if constexpr (ALIGN_EPI) { if (wr == 0) PG8_BAR; }
        if constexpr (!Epi::AFTER_DRAIN) { PG8_PF(8) E(acc, cur, wr, wc, fr, fq); S.done(cur); }
        if (!has_next) break;
#pragma unroll
        for (int a = 0; a < 2; ++a)
#pragma unroll
            for (int b = 0; b < 2; ++b)
#pragma unroll
                for (int m = 0; m < 4; ++m)
#pragma unroll
                    for (int n = 0; n < 2; ++n) acc[a][b][m][n] = (f32x4){0.f, 0.f, 0.f, 0.f};
        cur = nxt; cA = nA; cB = nB; ++ui;
        if constexpr (ALIGN_EPI) { if (wr == 1) PG8_BAR; }
    }
    PG8_WAIT_V(0);
    if constexpr (!ALIGN_EPI) { if (wr == 0) PG8_BAR; }
    PG8_BAR;
    if constexpr (Epi::AFTER_DRAIN) { E.fused(acc, cur, wr, wc, fr, fq, lds, wid, lane); S.done(cur); }
#undef PG8_SA
#undef PG8_SB
#undef PG8_STAGE
#undef PG8_LDA
#undef PG8_LDB
#undef PG8_MMA
#undef PG8_WAIT_V
#undef PG8_WAIT_L
#undef PG8_BAR
#undef PG8_SCHED
}
}

#ifndef PG8_SP2
#define PG8_SP2 true
#endif
#ifndef PG8_ALIGN
#define PG8_ALIGN true
#endif
constexpr size_t MiB = 1u << 20;
constexpr size_t WS_CTL = 0, CTL_ZERO_BYTES = 1 * MiB;
constexpr size_t WS_MOD = 2 * MiB;
constexpr size_t MOD_STRIDE = (size_t)33 * DM * 4;
constexpr size_t WS_WT2 = 4 * MiB;
constexpr size_t WS_WT1 = 38 * MiB;
constexpr size_t WS_H = 170 * MiB;
constexpr size_t WS_U = 310 * MiB, WS_G = 378 * MiB, WS_Q = 446 * MiB, WS_SZ = 514 * MiB;
constexpr size_t WS_KA = 582 * MiB, WS_VA = 718 * MiB, WS_END = 854 * MiB;
static_assert(WS_WT2 + (size_t)DM * LDK * 2 <= WS_WT1 && WS_WT1 + (size_t)NIN * LDK * 2 <= WS_H, "d_ws map (weights)");
static_assert(WS_MOD + 3 * MOD_STRIDE <= WS_WT2 && WS_H + (size_t)MT * LDK * 2 <= WS_U && WS_U + (size_t)MT * DC * 2 <= WS_G && WS_KA + (size_t)KROWS * DA * 2 <= WS_VA && WS_VA + (size_t)KROWS * DA * 2 <= WS_END, "d_ws map");
constexpr size_t WS_XN = WS_U;
constexpr size_t WS_PART = WS_Q;
static_assert(WS_XN + (size_t)MT * DM * 2 <= WS_Q && WS_PART + (size_t)4 * MS * DM * 4 <= WS_SZ, "d_ws overlays");
constexpr int CW_TMO = 0, CW_BAR = 4096;
constexpr int RING_OFF = 0, RING_BYTES = 131072;
constexpr int LDSCTL_OFF = RING_BYTES, MISC_OFF = LDSCTL_OFF + 320;
constexpr int LDS_BYTES = 147456;
constexpr int NWAVES = 8;

#define GAS __attribute__((address_space(1)))
#define LAS __attribute__((address_space(3)))
typedef unsigned short bf16;
typedef unsigned v4u __attribute__((ext_vector_type(4)));
typedef unsigned v2u __attribute__((ext_vector_type(2)));
typedef float f32x4 __attribute__((ext_vector_type(4)));
typedef float f32x16 __attribute__((ext_vector_type(16)));
typedef short bf16x8 __attribute__((ext_vector_type(8)));
typedef short s16x4 __attribute__((ext_vector_type(4)));
typedef GAS unsigned gu32;
#define RLX_AGENT __ATOMIC_RELAXED, __HIP_MEMORY_SCOPE_AGENT
#define LDS_WAIT() asm volatile("s_waitcnt lgkmcnt(0)" ::: "memory")
#define VM_WAIT() asm volatile("s_waitcnt vmcnt(0)" ::: "memory")
__device__ __forceinline__ unsigned cvtpk(float lo, float hi) { unsigned r; asm volatile("v_cvt_pk_bf16_f32 %0, %1, %2" : "=v"(r) : "v"(lo), "v"(hi)); return r; }
__device__ __forceinline__ float bf2f(unsigned short b) { return __uint_as_float(((unsigned)b) << 16); }
__device__ __forceinline__ float wave_sum(float v) {
#pragma unroll
    for (int o = 1; o < 64; o <<= 1) v += __shfl_xor(v, o);
    return v;
}
#define XB_TMO      128
#define XB_XCNT(j)  (256  + 64 * (j))
#define XB_XSUB(j)  (1280 + 64 * (j))
#define XB_XGEN(j)  (2304 + 64 * (j))
#define XB_TOP      3328
#define XB_TOPGEN   3392
#define XCD_BAR_WORDS 3456
#define XB_SPIN_CAP (1u << 18)

__device__ __forceinline__ unsigned xb_ld(unsigned* p)              { return __hip_atomic_load(p, __ATOMIC_RELAXED, __HIP_MEMORY_SCOPE_AGENT); }
__device__ __forceinline__ unsigned xb_add(unsigned* p, unsigned v) { return __hip_atomic_fetch_add(p, v, __ATOMIC_RELAXED, __HIP_MEMORY_SCOPE_AGENT); }
__device__ __forceinline__ unsigned xb_xcc_id() { return (unsigned)__builtin_amdgcn_s_getreg((3 << 11) | 20) & 0xFu; }
#define XB_SPIN(cond, bar) do { unsigned _sp = 0; while (cond) { __builtin_amdgcn_s_sleep(1); \
    if ((++_sp & 255u) == 0u) { if (xb_ld(&(bar)[XB_TMO])) break; if (_sp > XB_SPIN_CAP) { atomicAdd(&(bar)[XB_TMO], 1u); break; } } } } while (0)

struct XcdBarrier {
    unsigned* bar; unsigned x;
    volatile LAS unsigned* st;
};

__device__ __forceinline__ XcdBarrier xcd_barrier_post(unsigned* bar, volatile LAS unsigned* st) {
    XcdBarrier b; b.bar = bar; b.x = xb_xcc_id(); b.st = st;
    if (threadIdx.x == 0) (void)xb_add(&bar[XB_XCNT(b.x)], 1u);
    return b;
}
__device__ __forceinline__ void xcd_barrier_complete(unsigned* bar, unsigned x, unsigned& nloc, unsigned& nx) {
    const unsigned G = gridDim.x * gridDim.y * gridDim.z;
    unsigned sum, cnt, mine, sp = 0u;
    for (;;) {
        sum = 0u; cnt = 0u; mine = 0u;
#pragma unroll
        for (unsigned j = 0; j < 16; ++j) { const unsigned c = xb_ld(&bar[XB_XCNT(j)]); sum += c; cnt += (c > 0u) ? 1u : 0u; mine = (j == x) ? c : mine; }
        if (sum == G) break;
        __builtin_amdgcn_s_sleep(1);
        if ((++sp & 255u) == 0u) { if (xb_ld(&bar[XB_TMO])) break; if (sp > XB_SPIN_CAP) { atomicAdd(&bar[XB_TMO], 1u); break; } }
    }
    nloc = mine > 0u ? mine : 1u; nx = cnt > 0u ? cnt : 1u;
}

__device__ __forceinline__ void xcd_barrier(const XcdBarrier& b) {
    asm volatile("s_waitcnt vmcnt(0)" ::: "memory");
    __syncthreads();
    if (threadIdx.x == 0) {
        unsigned* bar = b.bar;
        __builtin_amdgcn_s_waitcnt(0);
        unsigned nloc = b.st[0], nx = b.st[1];
        if (nloc == 0u) { xcd_barrier_complete(bar, b.x, nloc, nx); b.st[0] = nloc; b.st[1] = nx; }
        const unsigned old = xb_add(&bar[XB_XSUB(b.x)], 1u);
        const unsigned gen = old / nloc;
        if (old + 1u == (gen + 1u) * nloc) {
            __builtin_amdgcn_fence(__ATOMIC_RELEASE, "agent");
            asm volatile("s_waitcnt vmcnt(0)" ::: "memory");
            const unsigned og = xb_add(&bar[XB_TOP], 1u);
            const unsigned tg = og / nx;
            if (og + 1u == (tg + 1u) * nx) xb_add(&bar[XB_TOPGEN], 1u);
            else XB_SPIN(xb_ld(&bar[XB_TOPGEN]) == tg, bar);
            __builtin_amdgcn_fence(__ATOMIC_ACQUIRE, "agent");
            xb_add(&bar[XB_XGEN(b.x)], 1u);
            asm volatile("s_waitcnt vmcnt(0)" ::: "memory");
        } else {
            XB_SPIN(xb_ld(&bar[XB_XGEN(b.x)]) == gen, bar);
            __builtin_amdgcn_fence(__ATOMIC_ACQUIRE, "agent");
            asm volatile("s_waitcnt vmcnt(0)" ::: "memory");
        }
    }
    __syncthreads();
}

struct Frame {
    LAS unsigned char* lds;
    volatile LAS unsigned* MISC;
    gu32* ctl;
    int tid, lane, wave, vcu, G;
    const float *x_prompt, *x_sample, *cache_k, *cache_v, *cache_conv, *c_prompt, *c_sample, *g_norm, *w_ada, *b_ada, *w_in, *conv_w, *conv_b, *rel_bias, *w_out, *g_final;
    float* out;
    float *modA, *modB, *gate;
    bf16 *WT1, *WT2, *H, *MIX, *U, *Gc, *Q, *SZ, *KA, *VA, *XN; float* PART;
};

__device__ __forceinline__ int win_src_col(int np) {
    const int tile = np >> 8, r = np & 255, half = r >> 7, c = r & 127;
    if (tile < 16) return (half ? 4096 : 0) + 128 * tile + c;
    if (tile < 32) return (half ? 6144 : 2048) + 128 * (tile - 16) + c;
    return np;
}
__device__ __forceinline__ void p0_transpose_item(const float* W, int K, int N, bf16* WT, int k0, int src_n0, int dst_n0, LAS float* scr, int lane) {
#pragma unroll 8
    for (int i = 0; i < 32; ++i) { const int kk = 2 * i + (lane >> 5); scr[kk * 33 + (lane & 31)] = W[(size_t)(k0 + kk) * N + src_n0 + (lane & 31)]; }
    LDS_WAIT(); asm volatile("" ::: "memory");
    const int c = lane & 7;
#pragma unroll
    for (int j = 0; j < 4; ++j) { const int n = (lane >> 3) + 8 * j; const LAS float* s = scr + (8 * c) * 33 + n;
        v4u o; o.x = cvtpk(s[0 * 33], s[1 * 33]); o.y = cvtpk(s[2 * 33], s[3 * 33]); o.z = cvtpk(s[4 * 33], s[5 * 33]); o.w = cvtpk(s[6 * 33], s[7 * 33]);
        *(GAS v4u*)(WT + (size_t)(dst_n0 + n) * LDK + k0 + 8 * c) = o; }
    LDS_WAIT(); asm volatile("" ::: "memory");
}
__device__ __forceinline__ void p0_ada_task(Frame& F, int task) {
    const int n0 = 64 * task, lane = F.lane, w = F.wave, b = lane & 31, kp = lane >> 5;
    LAS float* cs = (LAS float*)(F.lds + RING_OFF + w * 8704);
    f32x16 acc0 = {}, acc1 = {}; float ap0 = 0.f, ap1 = 0.f;
    const float* wbase = F.w_ada + n0 + 2 * b;
    for (int ch = 0; ch < 8; ++ch) {
        const int k0 = 512 * w + 64 * ch;
#pragma unroll
        for (int j = 0; j < 8; ++j) { const int idx = j * 64 + lane, row = idx >> 4, c4 = idx & 15;
            const f32x4 v = *(const f32x4*)(F.c_sample + (size_t)row * DM + k0 + 4 * c4);
            LAS float* d = cs + row * 65 + 4 * c4; d[0] = v[0]; d[1] = v[1]; d[2] = v[2]; d[3] = v[3]; }
        cs[32 * 65 + lane] = F.c_prompt[k0 + lane];
        LDS_WAIT(); asm volatile("" ::: "memory");
#pragma unroll 4
        for (int ks = 0; ks < 32; ++ks) {
            const int k = k0 + 2 * ks + kp;
            const v2u wv = *(const v2u*)(wbase + (size_t)k * (3 * DM));
            const float w0 = __uint_as_float(wv.x), w1 = __uint_as_float(wv.y);
            const float a = cs[b * 65 + 2 * ks + kp], cp = cs[32 * 65 + 2 * ks + kp];
            acc0 = __builtin_amdgcn_mfma_f32_32x32x2f32(a, w0, acc0, 0, 0, 0);
            acc1 = __builtin_amdgcn_mfma_f32_32x32x2f32(a, w1, acc1, 0, 0, 0);
            ap0 = fmaf(cp, w0, ap0); ap1 = fmaf(cp, w1, ap1);
        }
        LDS_WAIT(); asm volatile("" ::: "memory");
    }
    ap0 += __shfl_xor(ap0, 32); ap1 += __shfl_xor(ap1, 32);
#pragma unroll
    for (int i = 0; i < 16; ++i) { const int r = 8 * (i >> 2) + 4 * kp + (i & 3); cs[r * 64 + 2 * b] = acc0[i]; cs[r * 64 + 2 * b + 1] = acc1[i]; }
    if (kp == 0) { cs[32 * 64 + 2 * b] = ap0; cs[32 * 64 + 2 * b + 1] = ap1; }
    LDS_WAIT(); __syncthreads();
    for (int idx = F.tid; idx < 33 * 64; idx += NWAVES * 64) {
        float s = 0.f;
#pragma unroll
        for (int q = 0; q < 8; ++q) s += ((LAS float*)(F.lds + RING_OFF + q * 8704))[idx];
        const int r = idx >> 6, col = n0 + (idx & 63), bb = (r == 32) ? 0 : 1 + r;
        s += F.b_ada[col];
        if (col < DM) F.modB[(size_t)bb * DM + col] = s;
        else if (col < 2 * DM) F.modA[(size_t)bb * DM + col - DM] = F.g_norm[col - DM] * (1.f + s);
        else F.gate[(size_t)bb * DM + col - 2 * DM] = s;
    }
    __syncthreads();
}
__device__ __forceinline__ void p0_prologue(Frame& F) {
    constexpr int N_ADA = 3 * DM / 64;
    for (int t = F.vcu; t < N_ADA; t += F.G) p0_ada_task(F, t);
    LAS float* scr = (LAS float*)(F.lds + RING_OFF + F.wave * 16384);
    const int gw = F.vcu * NWAVES + F.wave, NGW = F.G * NWAVES, lane = F.lane;
    constexpr int I_IN = (DM / 64) * (NIN / 32), I_OUT = (DM / 64) * (DM / 32), I_CACHE = NSB * 512, I_PAD = NSB * 32;
    constexpr int NITEMS = I_IN + I_OUT + 2 * I_CACHE + 2 * I_PAD;
    for (int it = gw; it < NITEMS; it += NGW) {
        int r = it;
        if (r < I_IN) { const int nblk = NIN / 32, kb = r / nblk, nb = r % nblk; p0_transpose_item(F.w_in, DM, NIN, F.WT1, 64 * kb, win_src_col(32 * nb), 32 * nb, scr, lane); continue; } r -= I_IN;
        if (r < I_OUT) { const int nblk = DM / 32, kb = r / nblk, nb = r % nblk; p0_transpose_item(F.w_out, DM, DM, F.WT2, 64 * kb, 32 * nb, 32 * nb, scr, lane); continue; } r -= I_OUT;
        if (r < 2 * I_CACHE) { const int which = r >= I_CACHE; if (which) r -= I_CACHE;
            const float* src = (which ? F.cache_v : F.cache_k) + (size_t)r * 2048; bf16* dst = (which ? F.VA : F.KA) + (size_t)(MP + (r >> 9) * KPITCH + (r & 511)) * 2048;
#pragma unroll
            for (int j = 0; j < 4; ++j) { const f32x4 a = *(const f32x4*)(src + 512 * j + 8 * lane), b = *(const f32x4*)(src + 512 * j + 8 * lane + 4);
                v4u o; o.x = cvtpk(a[0], a[1]); o.y = cvtpk(a[2], a[3]); o.z = cvtpk(b[0], b[1]); o.w = cvtpk(b[2], b[3]); *(GAS v4u*)(dst + 512 * j + 8 * lane) = o; }
            continue; } r -= 2 * I_CACHE;
        { const int which = r >= I_PAD; if (which) r -= I_PAD;
            bf16* dst = (which ? F.VA : F.KA) + (size_t)(MP + (r >> 5) * KPITCH + 544 + (r & 31)) * 2048;
#pragma unroll
            for (int j = 0; j < 4; ++j) *(GAS v4u*)(dst + 512 * j + 8 * lane) = (v4u){0u, 0u, 0u, 0u}; }
    }
}
__device__ __forceinline__ void p1_hrows(Frame& F) {
    const int gw = F.vcu * NWAVES + F.wave, NGW = F.G * NWAVES, lane = F.lane;
    f32x4 A[16], B[16]; int cur_bb = -1;
    for (int m = gw; m < MT; m += NGW) {
        const float* xrow = m < MP ? F.x_prompt + (size_t)m * DM : F.x_sample + (size_t)(m - MP) * DM;
        const int bb = m < MP ? 0 : 1 + ((m - MP) >> 5);
        const GAS f32x4* xr = (const GAS f32x4*)xrow + lane;
        f32x4 v[16];
#pragma unroll
        for (int j = 0; j < 16; ++j) v[j] = xr[64 * j];
        if (bb != cur_bb) { cur_bb = bb;
            const GAS f32x4* ar = (const GAS f32x4*)(F.modA + (size_t)bb * DM) + lane; const GAS f32x4* br = (const GAS f32x4*)(F.modB + (size_t)bb * DM) + lane;
#pragma unroll
            for (int j = 0; j < 16; ++j) { A[j] = ar[64 * j]; B[j] = br[64 * j]; } }
        float s = 0.f;
#pragma unroll
        for (int j = 0; j < 16; ++j) s += (v[j].x * v[j].x + v[j].y * v[j].y) + (v[j].z * v[j].z + v[j].w * v[j].w);
        const float rstd = 1.0f / sqrtf(wave_sum(s) * (1.f / DM) + NORM_EPS);
        GAS v2u* o8 = (GAS v2u*)(F.H + (size_t)m * LDK) + lane;
#pragma unroll
        for (int j = 0; j < 16; ++j) { const f32x4 hv = (v[j] * rstd) * A[j] + B[j]; v2u o; o.x = cvtpk(hv.x, hv.y); o.y = cvtpk(hv.z, hv.w); o8[64 * j] = o; }
    }
}
__device__ __forceinline__ void p5_final(Frame& F, bool splitk) {
    const int gw = F.vcu * NWAVES + F.wave, NGW = F.G * NWAVES, lane = F.lane;
    f32x4 gf[16];
#pragma unroll
    for (int j = 0; j < 8; ++j) { gf[2 * j] = *(const GAS f32x4*)(F.g_final + 512 * j + 8 * lane); gf[2 * j + 1] = *(const GAS f32x4*)(F.g_final + 512 * j + 8 * lane + 4); }
    for (int m = gw; m < MT; m += NGW) {
        f32x4 v[16];
        if (m >= MP && splitk) {
            const float* xr = F.x_sample + (size_t)(m - MP) * DM + 8 * lane; const float* gr = F.gate + (size_t)(1 + ((m - MP) >> 5)) * DM + 8 * lane;
            const float* pr = F.PART + (size_t)(m - MP) * DM + 8 * lane;
#pragma unroll
            for (int j = 0; j < 16; ++j) { const int o = 512 * (j >> 1) + 4 * (j & 1);
                const f32x4 p0 = *(const GAS f32x4*)(pr + o), p1 = *(const GAS f32x4*)(pr + (size_t)MS * DM + o), p2 = *(const GAS f32x4*)(pr + (size_t)2 * MS * DM + o), p3 = *(const GAS f32x4*)(pr + (size_t)3 * MS * DM + o);
                v[j] = *(const GAS f32x4*)(xr + o) + *(const GAS f32x4*)(gr + o) * ((p0 + p1) + (p2 + p3)); }
        } else {
            const bf16* xn = F.XN + (size_t)m * DM + 8 * lane; v4u w[8];
#pragma unroll
            for (int j = 0; j < 8; ++j) w[j] = *(const GAS v4u*)(xn + 512 * j);
#pragma unroll
            for (int j = 0; j < 8; ++j) { v[2 * j] = (f32x4){__uint_as_float(w[j].x << 16), __uint_as_float(w[j].x & 0xffff0000u), __uint_as_float(w[j].y << 16), __uint_as_float(w[j].y & 0xffff0000u)};
                v[2 * j + 1] = (f32x4){__uint_as_float(w[j].z << 16), __uint_as_float(w[j].z & 0xffff0000u), __uint_as_float(w[j].w << 16), __uint_as_float(w[j].w & 0xffff0000u)}; }
        }
        float s = 0.f;
#pragma unroll
        for (int j = 0; j < 16; ++j) s += (v[j].x * v[j].x + v[j].y * v[j].y) + (v[j].z * v[j].z + v[j].w * v[j].w);
        const float rstd = 1.0f / sqrtf(wave_sum(s) * (1.f / DM) + NORM_EPS);
        float* yr = F.out + (size_t)m * DM + 8 * lane;
#pragma unroll
        for (int j = 0; j < 16; ++j) *(GAS f32x4*)(yr + 512 * (j >> 1) + 4 * (j & 1)) = (v[j] * rstd) * gf[j];
    }
}
namespace att {
constexpr int SHM_V = 16384, SHM_K = 16384, OFF_V = 0, OFF_K = 2 * SHM_V, OFF_WS = OFF_K + 2 * SHM_K, OFF_BT = OFF_WS + 8 * 256;
constexpr float THRL = 8.f * 1.4426950408889634f;
#define KSWZ(row, colB) ((row) * 256 + ((colB) ^ (((row) & 7) << 4)))
#define SBAR() __builtin_amdgcn_sched_barrier(0)
__device__ __forceinline__ int crow(int r, int hi) { return (r & 3) + 8 * (r >> 2) + 4 * hi; }
__device__ __forceinline__ int v_st(int k, int c) { const int kk = (k & ~0xC) | ((k & 4) << 1) | ((k & 8) >> 1); return ((kk >> 3) * 4 + (c >> 5)) * 512 + ((kk & 7) * 32 + (c & 31)) * 2; }
__device__ __forceinline__ int v_rd_base(int lane) { return ((lane & 3) << 3) | (((lane >> 2) & 3) << 6) | (((lane >> 4) & 1) << 5) | (((lane >> 5) & 1) << 8); }
constexpr int v_rd_off(int d0, int ks, int half) { return d0 * 512 + ks * 4096 + half * 2048; }
template <int OFF> __device__ __forceinline__ s16x4 tr_read(int vb) { s16x4 r; asm volatile("ds_read_b64_tr_b16 %0, %1 offset:%2" : "=&v"(r) : "v"(vb), "i"(OFF) : "memory"); return r; }
#define PK(L, H) (bf16x8){L[0], L[1], L[2], L[3], H[0], H[1], H[2], H[3]}
#define RD8(D0, X) const s16x4 X##l0 = tr_read<v_rd_off(D0, 0, 0)>(vb), X##h0 = tr_read<v_rd_off(D0, 0, 1)>(vb), X##l1 = tr_read<v_rd_off(D0, 1, 0)>(vb), X##h1 = tr_read<v_rd_off(D0, 1, 1)>(vb), \
                            X##l2 = tr_read<v_rd_off(D0, 2, 0)>(vb), X##h2 = tr_read<v_rd_off(D0, 2, 1)>(vb), X##l3 = tr_read<v_rd_off(D0, 3, 0)>(vb), X##h3 = tr_read<v_rd_off(D0, 3, 1)>(vb)
#define MM4(OD, X) do { OD = __builtin_amdgcn_mfma_f32_32x32x16_bf16(PK(X##l0, X##h0), pa0, OD, 0, 0, 0); OD = __builtin_amdgcn_mfma_f32_32x32x16_bf16(PK(X##l1, X##h1), pa1, OD, 0, 0, 0); \
                        OD = __builtin_amdgcn_mfma_f32_32x32x16_bf16(PK(X##l2, X##h2), pa2, OD, 0, 0, 0); OD = __builtin_amdgcn_mfma_f32_32x32x16_bf16(PK(X##l3, X##h3), pa3, OD, 0, 0, 0); } while (0)
__device__ __forceinline__ void pv_all(f32x16 (&o)[4], int vb, bf16x8 pa0, bf16x8 pa1, bf16x8 pa2, bf16x8 pa3) {
  RD8(0, a); RD8(1, b);
  asm volatile("s_waitcnt lgkmcnt(8)" ::: "memory"); SBAR(); MM4(o[0], a); SBAR();
  RD8(2, c);
  asm volatile("s_waitcnt lgkmcnt(8)" ::: "memory"); SBAR(); MM4(o[1], b); SBAR();
  RD8(3, d);
  asm volatile("s_waitcnt lgkmcnt(8)" ::: "memory"); SBAR(); MM4(o[2], c); SBAR();
  asm volatile("s_waitcnt lgkmcnt(0)" ::: "memory"); SBAR(); MM4(o[3], d);
}
#undef PK
#undef RD8
#undef MM4
struct AUnit { int h, qrow0, krow0, t0, T, sample, probe; };
__device__ __forceinline__ void attn_unit(Frame& F, char* lds, const AUnit u) {
  const int tid = F.tid, wid = F.wave, lane = F.lane, r32 = lane & 31, hi = lane >> 5;
  bf16* V_lds = (bf16*)(lds + OFF_V); bf16* K_lds = (bf16*)(lds + OFF_K);
  float* btab = (float*)(lds + OFF_BT);
  for (int i = tid; i < 640; i += 512) { const int bi = i + 192 < 512 ? i + 192 : 512; btab[i] = F.rel_bias[u.h * 513 + bi] * LOG2E; }
  const bool wact = u.sample ? (wid == 0) : true;
  const int lo = u.sample ? 0 : (wid >> 1), hi_t = lo + 8, ibase = u.sample ? 0 : 32 * (wid & 1);
  const int qrow = u.qrow0 + (u.sample ? 0 : 32 * wid);
  float m_reg = -1e30f, l_reg = 0.f; f32x16 o[4] = {}; bf16x8 qr[8];
  { const bf16* Qw = F.Q + (size_t)(qrow + r32) * DA + u.h * HD + hi * 8;
#pragma unroll
    for (int d0 = 0; d0 < 8; ++d0) qr[d0] = *(const bf16x8*)(Qw + d0 * 16); }
  const int sr = tid >> 4, sc = (tid & 15) * 8, vst0 = v_st(sr, sc), vst1 = v_st(32 + sr, sc);
  const int vb0 = (int)(uintptr_t)V_lds + v_rd_base(lane);
  bf16x8 xv0, xv1, xk0, xk1;
#define SLOAD(S, t) do { const size_t off_ = (size_t)(u.krow0 + 64 * (t) + sr) * DA + u.h * HD + sc; \
    S##v0 = *(const bf16x8*)(F.VA + off_); S##v1 = *(const bf16x8*)(F.VA + off_ + 32 * DA); S##k0 = *(const bf16x8*)(F.KA + off_); S##k1 = *(const bf16x8*)(F.KA + off_ + 32 * DA); } while (0)
#define SWRITE(b, S) do { *(bf16x8*)((char*)V_lds + (b) * SHM_V + vst0) = S##v0; *(bf16x8*)((char*)V_lds + (b) * SHM_V + vst1) = S##v1; const int kc = sc * 2; \
    *(bf16x8*)((char*)K_lds + (b) * SHM_K + KSWZ(sr, kc)) = S##k0; *(bf16x8*)((char*)K_lds + (b) * SHM_K + KSWZ(32 + sr, kc)) = S##k1; } while (0)
#define WGBAR() do { asm volatile("s_waitcnt lgkmcnt(0)" ::: "memory"); __builtin_amdgcn_s_barrier(); asm volatile("" ::: "memory"); } while (0)
  SLOAD(x, u.t0); SWRITE(0, x);
#define COMPUTE(t, cur) do { if (wact && (t) >= lo && (t) <= hi_t && !(u.probe & 1)) { \
      const int dt = (t) - lo; f32x16 p0, p1; \
      if (dt <= 3) { const float c = btab[639]; _Pragma("unroll") for (int r = 0; r < 16; ++r) { p0[r] = c; p1[r] = c; } } \
      else { const float* bp = btab + (517 - 64 * dt + ibase + r32 - 4 * hi); \
        _Pragma("unroll") for (int r = 0; r < 16; ++r) { const int kk = (r & 3) + 8 * (r >> 2); p0[r] = bp[59 - kk]; p1[r] = bp[27 - kk]; } } \
      if (u.sample && (t) == 8) { _Pragma("unroll") for (int r = 0; r < 16; ++r) p1[r] = -1e30f; } \
      { const bf16* Ks = (const bf16*)((const char*)K_lds + (cur) * SHM_K); \
        _Pragma("unroll") for (int d0 = 0; d0 < 8; ++d0) { const int cb = (d0 * 16 + hi * 8) * 2; \
          const bf16x8 b0 = *(const bf16x8*)((const char*)Ks + KSWZ(r32, cb)), b1 = *(const bf16x8*)((const char*)Ks + KSWZ(32 + r32, cb)); \
          p0 = __builtin_amdgcn_mfma_f32_32x32x16_bf16(b0, qr[d0], p0, 0, 0, 0); \
          p1 = __builtin_amdgcn_mfma_f32_32x32x16_bf16(b1, qr[d0], p1, 0, 0, 0); } } \
      float pmax = p0[0]; \
      _Pragma("unroll") for (int r = 1; r < 16; ++r) pmax = fmaxf(pmax, p0[r]); \
      _Pragma("unroll") for (int r = 0; r < 16; ++r) pmax = fmaxf(pmax, p1[r]); \
      { auto rr = __builtin_amdgcn_permlane32_swap(__float_as_uint(pmax), __float_as_uint(pmax), false, false); pmax = fmaxf(__uint_as_float(rr[0]), __uint_as_float(rr[1])); } \
      float mn, alpha; \
      if (__all(pmax - m_reg <= THRL)) { mn = m_reg; alpha = 1.f; } \
      else { mn = fmaxf(m_reg, pmax); alpha = __builtin_amdgcn_exp2f(m_reg - mn); m_reg = mn; } \
      float ps = 0.f; \
      _Pragma("unroll") for (int r = 0; r < 16; ++r) { p0[r] = __builtin_amdgcn_exp2f(p0[r] - mn); p1[r] = __builtin_amdgcn_exp2f(p1[r] - mn); ps += p0[r] + p1[r]; } \
      { auto rr = __builtin_amdgcn_permlane32_swap(__float_as_uint(ps), __float_as_uint(ps), false, false); ps = __uint_as_float(rr[0]) + __uint_as_float(rr[1]); } \
      if (__any(alpha < 1.f)) { _Pragma("unroll") for (int d = 0; d < 4; ++d) _Pragma("unroll") for (int r = 0; r < 16; ++r) o[d][r] *= alpha; } \
      l_reg = l_reg * alpha + ps; \
      bf16x8 pa0, pa1, pa2, pa3; \
      PK4(p0, 0, pa0); PK4(p0, 8, pa1); PK4(p1, 0, pa2); PK4(p1, 8, pa3); \
      pv_all(o, vb0 + (cur) * SHM_V, pa0, pa1, pa2, pa3); } } while (0)
#define PK4(P, BASE, OUT) do { unsigned a0 = cvtpk(P[BASE + 0], P[BASE + 1]), a1 = cvtpk(P[BASE + 2], P[BASE + 3]);   \
    unsigned b0 = cvtpk(P[BASE + 4], P[BASE + 5]), b1 = cvtpk(P[BASE + 6], P[BASE + 7]);                              \
    auto r0 = __builtin_amdgcn_permlane32_swap(a0, b0, false, false); auto r1 = __builtin_amdgcn_permlane32_swap(a1, b1, false, false); \
    v4u w_ = {r0[0], r1[0], r0[1], r1[1]}; OUT = *reinterpret_cast<bf16x8*>(&w_); } while (0)
#define STEP(t, cur) do { WGBAR(); const bool more_ = (t) + 1 < u.T && !(u.probe & 2); if (more_) SLOAD(x, (t) + 1); COMPUTE(t, cur); if (more_) SWRITE((cur) ^ 1, x); } while (0)
  for (int t = u.t0; t < u.T; t += 2) { STEP(t, 0); if (t + 1 < u.T) STEP(t + 1, 1); }
#undef STEP
#undef PK4
#undef COMPUTE
#undef WGBAR
#undef SLOAD
#undef SWRITE
  if (wact && !(u.probe & 4)) {
    const float rl = __builtin_amdgcn_rcpf(l_reg); const int orow = qrow + r32;
    const bf16* szr = F.SZ + (size_t)orow * DA + u.h * HD + 4 * hi; bf16* mr = F.MIX + (size_t)orow * LDK + DC + u.h * HD + 4 * hi;
    v2u sz[16];
#pragma unroll
    for (int d0 = 0; d0 < 4; ++d0)
#pragma unroll
      for (int g = 0; g < 4; ++g) sz[d0 * 4 + g] = *(const GAS v2u*)(szr + d0 * 32 + g * 8);
#pragma unroll
    for (int d0 = 0; d0 < 4; ++d0)
#pragma unroll
      for (int g = 0; g < 4; ++g) { const v2u z = sz[d0 * 4 + g];
        const float v0 = o[d0][4 * g + 0] * rl * __uint_as_float(z.x << 16), v1 = o[d0][4 * g + 1] * rl * __uint_as_float(z.x & 0xffff0000u);
        const float v2 = o[d0][4 * g + 2] * rl * __uint_as_float(z.y << 16), v3 = o[d0][4 * g + 3] * rl * __uint_as_float(z.y & 0xffff0000u);
        v2u w; w.x = cvtpk(v0, v1); w.y = cvtpk(v2, v3); *(GAS v2u*)(mr + d0 * 32 + g * 8) = w; }
  }
  __syncthreads();
}
}
__device__ __forceinline__ void p3_attention(Frame& F, char* lds, int probe) {
  for (int u = F.vcu; u < NH * (MP / 256); u += F.G) { const int h = u >> 6, qb = u & 63; const int t0 = 8 - 4 * qb > 0 ? 8 - 4 * qb : 0;
    att::attn_unit(F, lds, att::AUnit{h, 256 * qb, 256 * qb - 512, t0, 12, 0, probe}); }
  for (int u = F.vcu; u < NSB * NH; u += F.G) { const int b = u >> 4, h = u & 15;
    att::attn_unit(F, lds, att::AUnit{h, MP + 32 * b, MP + b * KPITCH, 0, 9, 1, probe}); }
}
__device__ __forceinline__ void unpack8(const v4u w, float (&f)[8]) {
  f[0] = __uint_as_float(w.x << 16); f[1] = __uint_as_float(w.x & 0xffff0000u); f[2] = __uint_as_float(w.y << 16); f[3] = __uint_as_float(w.y & 0xffff0000u);
  f[4] = __uint_as_float(w.z << 16); f[5] = __uint_as_float(w.z & 0xffff0000u); f[6] = __uint_as_float(w.w << 16); f[7] = __uint_as_float(w.w & 0xffff0000u); }
__device__ __forceinline__ void p3_convmix(Frame& F) {
  const int gw = F.vcu * NWAVES + F.wave, NGW = F.G * NWAVES, lane = F.lane;
  constexpr int RB = 34; static_assert(MT % RB == 0 && (MT / RB) * 4 == 2048, "conv items");
  for (int it = gw; it < (MT / RB) * 4; it += NGW) {
    const int rb = it >> 2, c = 512 * (it & 3) + 8 * lane, r0 = RB * rb;
    float w0[8], w1[8], w2[8], cb[8], um2[8], um1[8];
    { const f32x4 a0 = *(const GAS f32x4*)(F.conv_w + c), a1 = *(const GAS f32x4*)(F.conv_w + c + 4), b0 = *(const GAS f32x4*)(F.conv_w + DC + c), b1 = *(const GAS f32x4*)(F.conv_w + DC + c + 4);
      const f32x4 c0 = *(const GAS f32x4*)(F.conv_w + 2 * DC + c), c1 = *(const GAS f32x4*)(F.conv_w + 2 * DC + c + 4), d0 = *(const GAS f32x4*)(F.conv_b + c), d1 = *(const GAS f32x4*)(F.conv_b + c + 4);
#pragma unroll
      for (int j = 0; j < 4; ++j) { w0[j] = a0[j]; w0[4 + j] = a1[j]; w1[j] = b0[j]; w1[4 + j] = b1[j]; w2[j] = c0[j]; w2[4 + j] = c1[j]; cb[j] = d0[j]; cb[4 + j] = d1[j]; } }
    if (r0 == 0) {
#pragma unroll
      for (int j = 0; j < 8; ++j) { um2[j] = 0.f; um1[j] = 0.f; } }
    else if (r0 > MP && ((r0 - MP) & 31) == 1) { const float* cc = F.cache_conv + (size_t)((r0 - MP) >> 5) * 2 * DC + DC + c;
#pragma unroll
      for (int j = 0; j < 8; ++j) um2[j] = cc[j];
      unpack8(*(const GAS v4u*)(F.U + (size_t)(r0 - 1) * DC + c), um1); }
    else if (r0 >= MP && ((r0 - MP) & 31) == 0) {
#pragma unroll
      for (int j = 0; j < 8; ++j) { um2[j] = 0.f; um1[j] = 0.f; } }
    else { unpack8(*(const GAS v4u*)(F.U + (size_t)(r0 - 2) * DC + c), um2); unpack8(*(const GAS v4u*)(F.U + (size_t)(r0 - 1) * DC + c), um1); }
    for (int g0 = 0; g0 < RB; g0 += 8) {
      const int nr = RB - g0 < 8 ? RB - g0 : 8;
      v4u ur[8], gr[8];
#pragma unroll
      for (int i = 0; i < 8; ++i) if (i < nr) { const size_t ro = (size_t)(r0 + g0 + i) * DC + c; ur[i] = *(const GAS v4u*)(F.U + ro); gr[i] = *(const GAS v4u*)(F.Gc + ro); }
#pragma unroll
      for (int i = 0; i < 8; ++i) if (i < nr) { const int r = r0 + g0 + i; float uu[8], gg[8], ov[8];
        if (r >= MP && ((r - MP) & 31) == 0) { const float* cc = F.cache_conv + (size_t)((r - MP) >> 5) * 2 * DC + c;
#pragma unroll
          for (int j = 0; j < 8; ++j) { um2[j] = cc[j]; um1[j] = cc[DC + j]; } }
        unpack8(ur[i], uu); unpack8(gr[i], gg);
#pragma unroll
        for (int j = 0; j < 8; ++j) { ov[j] = (cb[j] + w0[j] * um2[j] + w1[j] * um1[j] + w2[j] * uu[j]) * gg[j]; um2[j] = um1[j]; um1[j] = uu[j]; }
        v4u o; o.x = cvtpk(ov[0], ov[1]); o.y = cvtpk(ov[2], ov[3]); o.z = cvtpk(ov[4], ov[5]); o.w = cvtpk(ov[6], ov[7]);
        *(GAS v4u*)(F.MIX + (size_t)r * LDK + c) = o; }
    }
  }
}
struct Args { const float* in[16]; float* out; unsigned char* ws; int ph_lo, ph_hi; };
__global__ void __launch_bounds__(NWAVES * 64, 2) fwd(Args args) {
    extern __shared__ __attribute__((aligned(16))) unsigned char lds[];
    Frame F;
    F.lds = (LAS unsigned char*)lds;
    F.MISC = (volatile LAS unsigned*)(F.lds + MISC_OFF);
    F.tid = threadIdx.x; F.lane = F.tid & 63; F.wave = __builtin_amdgcn_readfirstlane(F.tid >> 6);
    F.G = gridDim.x; { const int bx = blockIdx.x; F.vcu = (F.G % 8 == 0) ? (bx % 8) * (F.G / 8) + bx / 8 : bx; }
    unsigned char* ws = args.ws;
    F.ctl = (gu32*)(ws + WS_CTL);
    F.x_prompt = args.in[0]; F.x_sample = args.in[1]; F.cache_k = args.in[2]; F.cache_v = args.in[3]; F.cache_conv = args.in[4]; F.c_prompt = args.in[5]; F.c_sample = args.in[6];
    F.g_norm = args.in[7]; F.w_ada = args.in[8]; F.b_ada = args.in[9]; F.w_in = args.in[10]; F.conv_w = args.in[11]; F.conv_b = args.in[12]; F.rel_bias = args.in[13]; F.w_out = args.in[14]; F.g_final = args.in[15];
    F.out = args.out;
    F.modA = (float*)(ws + WS_MOD); F.modB = (float*)(ws + WS_MOD + MOD_STRIDE); F.gate = (float*)(ws + WS_MOD + 2 * MOD_STRIDE);
    F.WT1 = (bf16*)(ws + WS_WT1); F.WT2 = (bf16*)(ws + WS_WT2); F.H = (bf16*)(ws + WS_H); F.MIX = (bf16*)(ws + WS_H);
    F.U = (bf16*)(ws + WS_U); F.Gc = (bf16*)(ws + WS_G); F.Q = (bf16*)(ws + WS_Q); F.SZ = (bf16*)(ws + WS_SZ); F.KA = (bf16*)(ws + WS_KA); F.VA = (bf16*)(ws + WS_VA); F.XN = (bf16*)(ws + WS_XN); F.PART = (float*)(ws + WS_PART);
    for (int u = F.tid; u < (LDS_BYTES - LDSCTL_OFF) / 4; u += NWAVES * 64) ((LAS unsigned*)(F.lds + LDSCTL_OFF))[u] = 0u;
    __syncthreads();
    XcdBarrier bar; bar.bar = (unsigned*)(F.ctl + CW_BAR); bar.x = 0; bar.st = nullptr;
    if (N_LAUNCHES != PER_PHASE) bar = xcd_barrier_post((unsigned*)(F.ctl + CW_BAR), F.MISC + 8);
#define GRID_BAR() do { if (N_LAUNCHES != PER_PHASE) xcd_barrier(bar); } while (0)
    const int lo = args.ph_lo, hi = args.ph_hi;
    const bool splitk = (F.G == 256);
#define IN(k) (lo <= (k) && (k) < hi)
#define BOTH(k) (IN(k) && IN((k) + 1))
#ifndef PROBE_REPEAT
#define PROBE_REPEAT 0
#endif
#define REP(k) ((PROBE_REPEAT >> (4 * (k))) & 15)
    if (IN(0)) { for (int rep = 0; rep <= REP(0); ++rep) { p0_prologue(F); if (BOTH(0)) GRID_BAR(); } }
    if (IN(1)) { for (int rep = 0; rep <= REP(1); ++rep) { p1_hrows(F); if (BOTH(1)) GRID_BAR(); } }
    for (int rep = 0; rep <= REP(2); ++rep)
    if (IN(2)) {
        pg8::Gemm g{F.H, F.WT1, MT, NIN, DM, LDK}; pg8::StaticOrder S; S.init(MT, NIN, DM, F.G, (int)blockIdx.x);
#if defined(PROBE_GEMM)
        g.probe = rep ? PROBE_GEMM : 0;
#endif
#if defined(PROBE_HOT)
        S.hot = rep;
#endif
        pg8::EpiIn E{F.U, F.Gc, F.Q, F.SZ, F.KA, F.VA, F.out};
        pg8::gemm_phase<pg8::EpiIn, pg8::StaticOrder, PG8_ALIGN, PG8_SP2>(F.lds + RING_OFF, g, S, E);
        if (BOTH(2)) GRID_BAR();
    }
    for (int rep = 0; rep <= REP(3); ++rep)
    if (IN(3)) {
#if defined(PROBE_P3) && PROBE_P3 == 1
        if (rep == 0) p3_convmix(F); p3_attention(F, (char*)lds + RING_OFF, rep ? PROBE_ATT : 0);
#elif defined(PROBE_P3) && PROBE_P3 == 2
        if (rep == 0) p3_attention(F, (char*)lds + RING_OFF, 0); p3_convmix(F);
#else
        p3_attention(F, (char*)lds + RING_OFF, 0); p3_convmix(F);
#endif
        if (BOTH(3)) GRID_BAR(); }
    for (int rep = 0; rep <= REP(4); ++rep)
    if (IN(4)) {
        pg8::Gemm g{F.MIX, F.WT2, MT, DM, DM, LDK};
#if defined(PROBE_GEMM)
        g.probe = 0;
#endif
        pg8::EpiOut E{F.x_prompt, F.x_sample, F.gate, F.XN, F.PART};
        if (splitk) { pg8::TailSplitOrder S; S.init(F.G, (int)blockIdx.x); pg8::gemm_phase<pg8::EpiOut, pg8::TailSplitOrder, PG8_ALIGN, PG8_SP2>(F.lds + RING_OFF, g, S, E); }
        else { pg8::StaticOrder S; S.init(MT, DM, DM, F.G, (int)blockIdx.x); pg8::gemm_phase<pg8::EpiOut, pg8::StaticOrder, PG8_ALIGN, PG8_SP2>(F.lds + RING_OFF, g, S, E); }
        if (BOTH(4)) GRID_BAR();
    }
    if (IN(5)) { p5_final(F, splitk); }
#undef IN
#undef BOTH
}

extern "C" void kernel_launch(void* const* d_in, const int* in_sizes, int n_in, void* d_out, int out_size, void* d_ws, size_t ws_size, hipStream_t stream) {
    static int grid = 0;
    if (grid == 0) {
        if (n_in != 16 || in_sizes[0] != MP * DM || out_size != (int)O_END || ws_size < WS_END) {
            fprintf(stderr, "kernel_launch: shape mismatch: n_in %d in0 %d out %d ws %zu (need >= %zu); nothing launched\n", n_in, n_in > 0 ? in_sizes[0] : -1, out_size, ws_size, (size_t)WS_END); grid = -1; return; }
        int dev = 0, cus = 0, per_cu = 0;
        if (hipGetDevice(&dev) != hipSuccess || hipDeviceGetAttribute(&cus, hipDeviceAttributeMultiprocessorCount, dev) != hipSuccess) { fprintf(stderr, "kernel_launch: device query failed\n"); grid = -1; return; }
        if (hipFuncSetAttribute((const void*)fwd, hipFuncAttributeMaxDynamicSharedMemorySize, LDS_BYTES) != hipSuccess) { fprintf(stderr, "kernel_launch: hipFuncSetAttribute failed\n"); grid = -1; return; }
        if (hipOccupancyMaxActiveBlocksPerMultiprocessor(&per_cu, (const void*)fwd, NWAVES * 64, LDS_BYTES) != hipSuccess || per_cu < 1)
            fprintf(stderr, "kernel_launch: note: occupancy query reports %d workgroups per CU\n", per_cu);
        (void)hipGetLastError();
        grid = cus;
    }
    if (grid < 0) return;
    if (hipMemsetAsync((char*)d_ws + WS_CTL, 0, CTL_ZERO_BYTES, stream) != hipSuccess) { fprintf(stderr, "kernel_launch: memset failed\n"); return; }
    Args a{};
    for (int i = 0; i < 16; ++i) a.in[i] = (const float*)d_in[i];
    a.out = (float*)d_out; a.ws = (unsigned char*)d_ws;
    const int nl = (N_LAUNCHES == PER_PHASE) ? PER_PHASE : 1;
    for (int li = 0; li < nl; ++li) {
        a.ph_lo = (N_LAUNCHES == PER_PHASE) ? li : 0; a.ph_hi = (N_LAUNCHES == PER_PHASE) ? li + 1 : PER_PHASE;
        hipLaunchKernelGGL(fwd, dim3(grid), dim3(NWAVES * 64), LDS_BYTES, stream, a);
        const hipError_t le = hipPeekAtLastError();
        if (le != hipSuccess) { fprintf(stderr, "kernel_launch: launch %d failed: %s\n", li, hipGetErrorName(le)); break; }
    }
}
```

```cpp
#include <hip/hip_runtime.h>
#include <cstdio>
#include <cstdint>

#ifndef MK_N_LAUNCHES
#define MK_N_LAUNCHES 1
#endif
constexpr int N_LAUNCHES = MK_N_LAUNCHES;
constexpr int PER_PHASE = 6;

constexpr int DM = 4096, MP = 16384, NSB = 32, NST = 32, MS = NSB * NST, MT = MP + MS;
constexpr int LDK = DM + 64;
constexpr int NIN = 16384, DC = 2048, DA = 2048, NH = 16, HD = 128;
constexpr int KROWS = MT;
constexpr float NORM_EPS = 1e-6f;
constexpr float LOG2E = 1.4426950408889634f;
constexpr float QSCALE = 0.08838834764831845f * LOG2E;
constexpr size_t O_YP = 0, O_YS = (size_t)MP * DM, O_KP = O_YS + (size_t)MS * DM, O_VP = O_KP + 512 * 2048, O_CP = O_VP + 512 * 2048, O_KS = O_CP + 2 * 2048,
                 O_VS = O_KS + (size_t)MS * 2048, O_CS = O_VS + (size_t)MS * 2048, O_END = O_CS + (size_t)NSB * 2 * 2048;
static_assert(O_END == 77729792, "output size");

namespace pg8 {
#define PG8_LAS __attribute__((address_space(3)))
typedef unsigned short bf16_t;
typedef short bf16x8 __attribute__((ext_vector_type(8)));
typedef float f32x4 __attribute__((ext_vector_type(4)));
typedef unsigned u32x4 __attribute__((ext_vector_type(4)));
constexpr int BM = 256, BK = 64, HALF = 128, HTB = HALF * BK * 2  , STAGE_BYTES = 8 * HTB, NXCD = 8, WGM = 8;

__host__ __device__ __forceinline__ int lds_byte(int r, int c) { const int st = (r >> 4) * 2 + (c >> 5), rr = r & 15, cc = c & 31, ob = rr * 64 + cc * 2; return st * 1024 + (ob ^ (((ob >> 9) & 1) << 5)); }
__host__ __device__ __forceinline__ void stage_rc(int b, int& R, int& C) { const int st = b / 1024, sb = b % 1024, swz = sb ^ (((sb >> 9) & 1) << 5); R = (st >> 1) * 16 + swz / 64; C = (st & 1) * 32 + (swz % 64) / 2; }
__host__ __device__ __forceinline__ int perm32(int rho) { const int n = rho >> 4, i = rho & 15; return 8 * (i >> 2) + 4 * n + (i & 3); }

struct Unit { int pm, pn, kb, nt, part; };
struct Gemm { const bf16_t* A; const bf16_t* Bt; int M, N, K, ld;
#if defined(PROBE_GEMM)
    int probe;
#endif
};

struct StaticOrder {
    int nM, nN, nwg, G, c, nK;
#if defined(PROBE_HOT)
    int hot;
#endif
    __host__ __device__ void init(int M, int N, int K, int G_, int c_) { nM = M / BM; nN = N / BM; nK = K / BK; nwg = nM * nN; G = G_; c = c_;
#if defined(PROBE_HOT)
        hot = 0;
#endif
    }
    __host__ __device__ bool next(int i, Unit& u) const {
        const long L = (long)i * G + c; if (L >= nwg) return false;
#if defined(PROBE_HOT)
        if (hot) { const int l = c >> 3; u.pm = l & 7; u.pn = (l >> 3) + PROBE_HOT - 1; return true; }
#endif
        int wgid = (int)L; { const int q = nwg / NXCD, r = nwg % NXCD, xcd = wgid % NXCD, off = wgid / NXCD; wgid = (xcd < r ? xcd * (q + 1) : r * (q + 1) + (xcd - r) * q) + off; }
        const int nig = WGM * nN, gid = wgid / nig, fm = gid * WGM, gsz = (nM - fm) < WGM ? (nM - fm) : WGM;
        u.pm = fm + ((wgid % nig) % gsz); u.pn = (wgid % nig) / gsz; u.kb = 0; u.nt = nK; u.part = -1; return true;
    }
    __device__ __forceinline__ void a_ready(const Unit&) const {}
    __device__ __forceinline__ void done(const Unit&) const {}
};
__device__ __forceinline__ unsigned cvt_pk_bf16(float lo, float hi) { unsigned r; asm volatile("v_cvt_pk_bf16_f32 %0, %1, %2" : "=v"(r) : "v"(lo), "v"(hi)); return r; }
typedef float f32x2 __attribute__((ext_vector_type(2)));
__device__ __forceinline__ float silu_f(float x) { return x * __builtin_amdgcn_rcpf(1.0f + __builtin_amdgcn_exp2f(-1.4426950408889634f * x)); }
__device__ __forceinline__ f32x4 silu4(f32x4 v) { f32x4 r; r[0] = silu_f(v[0]); r[1] = silu_f(v[1]); r[2] = silu_f(v[2]); r[3] = silu_f(v[3]); return r; }
__device__ __forceinline__ u32x4 pack8(f32x4 v0, f32x4 v1) { u32x4 w; w.x = cvt_pk_bf16(v0[0], v0[1]); w.y = cvt_pk_bf16(v0[2], v0[3]); w.z = cvt_pk_bf16(v1[0], v1[1]); w.w = cvt_pk_bf16(v1[2], v1[3]); return w; }
__device__ __forceinline__ int krow_of(int row) { return row; }

struct EpiIn {
    static constexpr bool PERM = true, AFTER_DRAIN = false;
    bf16_t *U, *G, *Q, *SZ, *KA, *VA; float* out;
    __device__ __forceinline__ void operator()(const f32x4 (&acc)[2][2][4][2], const Unit& u, int wr, int wc, int fr, int fq) const {
        const int pn = u.pn, row0 = u.pm * BM + wr * 64 + fr;
        if (pn < 32) {
            const int col = (pn & 15) * 128 + wc * 32 + 8 * fq;
            if (pn < 16) {
#pragma unroll
                for (int ai = 0; ai < 2; ++ai)
#pragma unroll
                    for (int m = 0; m < 4; ++m) { const int row = row0 + ai * HALF + m * 16;
                        const f32x4 v0 = acc[ai][0][m][0] * acc[ai][1][m][0], v1 = acc[ai][0][m][1] * acc[ai][1][m][1];
                        *(u32x4*)(U + (size_t)row * DC + col) = pack8(v0, v1);
                        if (u.pm >= 63) { long o = -1;
                            if (row >= MP) { const int t = row & 31; if (t >= 30) o = (long)O_CS + (long)((((row - MP) >> 5) * 2 + (t - 30)) * 2048); }
                            else if (row >= MP - 2) o = (long)O_CP + (long)((row - (MP - 2)) * 2048);
                            if (o >= 0) { *(f32x4*)(out + o + col) = v0; *(f32x4*)(out + o + col + 4) = v1; } } }
            } else {
#pragma unroll
                for (int ai = 0; ai < 2; ++ai)
#pragma unroll
                    for (int m = 0; m < 4; ++m) { const int row = row0 + ai * HALF + m * 16;
                        const f32x4 v0 = acc[ai][0][m][0] * silu4(acc[ai][1][m][0]), v1 = acc[ai][0][m][1] * silu4(acc[ai][1][m][1]);
                        *(u32x4*)(G + (size_t)row * DC + col) = pack8(v0, v1); }
            }
        } else {
            const int part = (pn - 32) >> 3, colp = ((pn - 32) & 7) * 256 + wc * 32 + 8 * fq;
            if (part == 0) {
#pragma unroll
                for (int ai = 0; ai < 2; ++ai)
#pragma unroll
                    for (int m = 0; m < 4; ++m) { const int row = row0 + ai * HALF + m * 16;
#pragma unroll
                        for (int bj = 0; bj < 2; ++bj) *(u32x4*)(Q + (size_t)row * DA + colp + bj * HALF) = pack8(acc[ai][bj][m][0] * QSCALE, acc[ai][bj][m][1] * QSCALE); }
            } else if (part == 3) {
#pragma unroll
                for (int ai = 0; ai < 2; ++ai)
#pragma unroll
                    for (int m = 0; m < 4; ++m) { const int row = row0 + ai * HALF + m * 16;
#pragma unroll
                        for (int bj = 0; bj < 2; ++bj) *(u32x4*)(SZ + (size_t)row * DA + colp + bj * HALF) = pack8(silu4(acc[ai][bj][m][0]), silu4(acc[ai][bj][m][1])); }
            } else {
                bf16_t* dst = part == 1 ? KA : VA;
                float* odp = out + (part == 1 ? O_KP : O_VP); float* ods = out + (part == 1 ? O_KS : O_VS);
#pragma unroll
                for (int ai = 0; ai < 2; ++ai)
#pragma unroll
                    for (int m = 0; m < 4; ++m) { const int row = row0 + ai * HALF + m * 16; const size_t kr = (size_t)krow_of(row);
#pragma unroll
                        for (int bj = 0; bj < 2; ++bj) { *(u32x4*)(dst + kr * DA + colp + bj * HALF) = pack8(acc[ai][bj][m][0], acc[ai][bj][m][1]);
                            if (u.pm >= 62) { float* o = row >= MP ? ods + (size_t)(row - MP) * DA : odp + (size_t)(row - (MP - 512)) * DA;
                                *(f32x4*)(o + colp + bj * HALF) = acc[ai][bj][m][0]; *(f32x4*)(o + colp + bj * HALF + 4) = acc[ai][bj][m][1]; } } }
            }
        }
    }
};
struct EpiOut {
    static constexpr bool PERM = true, AFTER_DRAIN = false;
    const float *xp, *xs, *gate; bf16_t* XN; float* PART;
    __device__ __forceinline__ void operator()(const f32x4 (&acc)[2][2][4][2], const Unit& u, int wr, int wc, int fr, int fq) const {
        const int row0 = u.pm * BM + wr * 64 + fr, col = u.pn * BM + wc * 32 + 8 * fq;
        if (u.part >= 0) {
            float* pb = PART + (size_t)u.part * MS * DM;
#pragma unroll
            for (int ai = 0; ai < 2; ++ai)
#pragma unroll
                for (int m = 0; m < 4; ++m) { float* pr = pb + (size_t)(row0 + ai * HALF + m * 16 - MP) * DM + col;
#pragma unroll
                    for (int bj = 0; bj < 2; ++bj) { *(f32x4*)(pr + bj * HALF) = acc[ai][bj][m][0]; *(f32x4*)(pr + bj * HALF + 4) = acc[ai][bj][m][1]; } }
            return;
        }
#pragma unroll
        for (int ai = 0; ai < 2; ++ai)
#pragma unroll
            for (int m = 0; m < 4; ++m) { const int row = row0 + ai * HALF + m * 16;
                const float* xr = row < MP ? xp + (size_t)row * DM : xs + (size_t)(row - MP) * DM;
                const float* gr = gate + (size_t)(row < MP ? 0 : 1 + ((row - MP) >> 5)) * DM;
                bf16_t* yr = XN + (size_t)row * DM;
#pragma unroll
                for (int bj = 0; bj < 2; ++bj) { const int c = col + bj * HALF;
                    const f32x4 x0 = *(const f32x4*)(xr + c), x1 = *(const f32x4*)(xr + c + 4), g0 = *(const f32x4*)(gr + c), g1 = *(const f32x4*)(gr + c + 4);
                    *(u32x4*)(yr + c) = pack8(x0 + g0 * acc[ai][bj][m][0], x1 + g1 * acc[ai][bj][m][1]); } }
    }
};
struct TailSplitOrder {
    StaticOrder so; int c;
    __device__ void init(int G, int c_) { so.init(MP, DM, DM, G, c_); c = c_; }
    __device__ bool next(int i, Unit& u) const {
        if (i < 4) return so.next(i, u);
        if (i > 4) return false;
        const int kq = c & 3, r = c >> 2; u.pm = MP / BM + (r & 3); u.pn = r >> 2; u.kb = kq * (DM / 4) * 2; u.nt = DM / 4 / BK; u.part = kq; return true;
    }
    __device__ __forceinline__ void a_ready(const Unit&) const {}
    __device__ __forceinline__ void done(const Unit&) const {}
};
template <class Epi, class Sched, bool ALIGN_EPI = false, bool SP2 = false>
__device__ __forceinline__ void gemm_phase(PG8_LAS unsigned char* lds, const Gemm g, const Sched& S, const Epi& E) {
    const int tid = threadIdx.x, wid = __builtin_amdgcn_readfirstlane(tid >> 6), lane = tid & 63, wr = wid >> 2, wc = wid & 3, fr = lane & 15, fq = lane >> 4;
    const int LD = g.ld;
    unsigned voffA[2], voffB[2];
#pragma unroll
    for (int i = 0; i < 2; ++i) { int R, C; stage_rc(tid * 16 + i * 8192, R, C); const int Rb = Epi::PERM ? ((R & ~31) + perm32(R & 31)) : R;
        voffA[i] = (unsigned)(R * LD + C) * 2u; voffB[i] = (unsigned)(Rb * LD + C) * 2u; }
    const size_t kstep = (size_t)(BK * 2);
    const size_t hstep = (size_t)HALF * LD * 2;
    const size_t tstep = 2 * hstep;
    const unsigned ldsw = (unsigned)wid * 1024u;
    const int aoff = lds_byte(wr * 64 + fr, fq * 8), boff = lds_byte(wc * 32 + fr, fq * 8);
#define PG8_SA(b, h) (((b) * 2 + (h)) * HTB)
#define PG8_SB(b, h) ((4 + (b) * 2 + (h)) * HTB)
#if defined(PROBE_GEMM)
    const int pf = g.probe;
#define PG8_PF(b) if (!(pf & (b)))
#else
#define PG8_PF(b)
#endif
#define PG8_STAGE(bufoff, gbase, voff) do { PG8_PF(2) _Pragma("unroll") for (int _i = 0; _i < 2; ++_i) \
        __builtin_amdgcn_global_load_lds((const unsigned*)((const char*)(gbase) + (voff)[_i]), (PG8_LAS unsigned*)(lds + (bufoff) + ldsw + _i * 8192), 16, 0, 0); } while (0)
#define PG8_LDA(dst, b, h) do { _Pragma("unroll") for (int m = 0; m < 4; ++m) _Pragma("unroll") for (int k = 0; k < 2; ++k) dst[m][k] = *(const PG8_LAS bf16x8*)(lds + PG8_SA(b, h) + aoff + m * 2048 + k * 1024); } while (0)
#define PG8_LDB(dst, b, h) do { _Pragma("unroll") for (int n = 0; n < 2; ++n) _Pragma("unroll") for (int k = 0; k < 2; ++k) dst[n][k] = *(const PG8_LAS bf16x8*)(lds + PG8_SB(b, h) + boff + n * 2048 + k * 1024); } while (0)
#define PG8_MMA(ai, bj, At, Bt) do { __builtin_amdgcn_s_setprio(1); PG8_PF(1) _Pragma("unroll") for (int m = 0; m < 4; ++m) _Pragma("unroll") for (int n = 0; n < 2; ++n) _Pragma("unroll") for (int k = 0; k < 2; ++k) \
        acc[ai][bj][m][n] = __builtin_amdgcn_mfma_f32_16x16x32_bf16(Bt[n][k], At[m][k], acc[ai][bj][m][n], 0, 0, 0); __builtin_amdgcn_s_setprio(0); } while (0)
#define PG8_WAIT_V(n) asm volatile("s_waitcnt vmcnt(" #n ")" ::: "memory")
#define PG8_WAIT_L(n) asm volatile("s_waitcnt lgkmcnt(" #n ")" ::: "memory")
#define PG8_BAR __builtin_amdgcn_s_barrier()
#define PG8_SCHED __builtin_amdgcn_sched_barrier(0)
    Unit cur, nxt; int ui = 0;
    if (!S.next(0, cur)) return;
    f32x4 acc[2][2][4][2];
#pragma unroll
    for (int a = 0; a < 2; ++a)
#pragma unroll
        for (int b = 0; b < 2; ++b)
#pragma unroll
            for (int m = 0; m < 4; ++m)
#pragma unroll
                for (int n = 0; n < 2; ++n) acc[a][b][m][n] = (f32x4){0.f, 0.f, 0.f, 0.f};
    bf16x8 At[4][2], B0[2][2], B1[2][2];
    const char* cA = (const char*)g.A + (size_t)cur.pm * tstep + cur.kb; const char* cB = (const char*)g.Bt + (size_t)cur.pn * tstep + cur.kb;
    S.a_ready(cur);
    if constexpr (SP2) {
        PG8_STAGE(PG8_SB(0, 0), cB, voffB); PG8_STAGE(PG8_SB(0, 1), cB + hstep, voffB); PG8_STAGE(PG8_SA(0, 0), cA, voffA); PG8_STAGE(PG8_SA(0, 1), cA + hstep, voffA);
        if (wr == 1) PG8_BAR;
        PG8_WAIT_V(2); PG8_BAR;
        PG8_STAGE(PG8_SB(1, 0), cB + kstep, voffB); PG8_STAGE(PG8_SA(1, 0), cA + kstep, voffA); PG8_STAGE(PG8_SB(1, 1), cB + hstep + kstep, voffB);
        PG8_WAIT_V(6); PG8_BAR;
    } else {
        PG8_STAGE(PG8_SB(0, 0), cB, voffB); PG8_STAGE(PG8_SA(0, 0), cA, voffA); PG8_STAGE(PG8_SB(0, 1), cB + hstep, voffB); PG8_STAGE(PG8_SA(0, 1), cA + hstep, voffA);
        if (wr == 1) PG8_BAR;
        PG8_WAIT_V(4); PG8_BAR;
        PG8_STAGE(PG8_SB(1, 0), cB + kstep, voffB); PG8_STAGE(PG8_SA(1, 0), cA + kstep, voffA); PG8_STAGE(PG8_SB(1, 1), cB + hstep + kstep, voffB);
        PG8_WAIT_V(6); PG8_BAR;
    }
    for (;;) {
        const bool has_next = S.next(ui + 1, nxt);
        const char* nA = has_next ? (const char*)g.A + (size_t)nxt.pm * tstep + nxt.kb : cA; const char* nB = has_next ? (const char*)g.Bt + (size_t)nxt.pn * tstep + nxt.kb : cB;
        const int nt = cur.nt;
        for (int t = 0; t < nt; t += 2) {
            const bool last = (t == nt - 2);
            const char* a1 = cA + (size_t)(t + 1) * kstep;
            const char* a2 = last ? nA : cA + (size_t)(t + 2) * kstep; const char* b2 = last ? nB : cB + (size_t)(t + 2) * kstep;
            const char* a3 = a2 + kstep; const char* b3 = b2 + kstep;
            if (last && has_next) S.a_ready(nxt);
            if constexpr (SP2) {
            PG8_LDB(B0, 0, 0); PG8_LDB(B1, 0, 1); PG8_SCHED; PG8_LDA(At, 0, 0); PG8_STAGE(PG8_SA(1, 1), a1 + hstep, voffA);
            PG8_WAIT_V(8); PG8_WAIT_L(0); PG8_BAR; PG8_MMA(0, 0, At, B0); PG8_MMA(0, 1, At, B1); PG8_BAR; PG8_SCHED;
            PG8_LDA(At, 0, 1); PG8_STAGE(PG8_SB(0, 0), b2, voffB); PG8_STAGE(PG8_SB(0, 1), b2 + hstep, voffB); PG8_STAGE(PG8_SA(0, 0), a2, voffA);
            PG8_WAIT_V(8); PG8_WAIT_L(0); PG8_BAR; PG8_MMA(1, 0, At, B0); PG8_MMA(1, 1, At, B1); PG8_BAR; PG8_SCHED;
            PG8_LDB(B0, 1, 0); PG8_LDB(B1, 1, 1); PG8_SCHED; PG8_LDA(At, 1, 0); PG8_STAGE(PG8_SA(0, 1), a2 + hstep, voffA);
            PG8_WAIT_V(8); PG8_WAIT_L(0); PG8_BAR; PG8_MMA(0, 0, At, B0); PG8_MMA(0, 1, At, B1); PG8_BAR; PG8_SCHED;
            PG8_LDA(At, 1, 1); PG8_STAGE(PG8_SB(1, 0), b3, voffB); PG8_STAGE(PG8_SB(1, 1), b3 + hstep, voffB); PG8_STAGE(PG8_SA(1, 0), a3, voffA);
            PG8_WAIT_V(8); PG8_WAIT_L(0); PG8_BAR; PG8_MMA(1, 0, At, B0); PG8_MMA(1, 1, At, B1); PG8_BAR; PG8_SCHED;
            } else {
            PG8_LDB(B0, 0, 0); PG8_SCHED; PG8_LDA(At, 0, 0); PG8_STAGE(PG8_SA(1, 1), a1 + hstep, voffA);
            PG8_WAIT_L(8); PG8_BAR; PG8_WAIT_L(0); PG8_MMA(0, 0, At, B0); PG8_BAR; PG8_SCHED;
            PG8_LDB(B1, 0, 1); PG8_STAGE(PG8_SB(0, 0), b2, voffB);
            PG8_BAR; PG8_WAIT_L(0); PG8_MMA(0, 1, At, B1); PG8_BAR;
            PG8_LDA(At, 0, 1); PG8_STAGE(PG8_SA(0, 0), a2, voffA);
            PG8_BAR; PG8_WAIT_L(0); PG8_MMA(1, 0, At, B0); PG8_BAR; PG8_SCHED;
            PG8_STAGE(PG8_SB(0, 1), b2 + hstep, voffB);
            PG8_WAIT_V(6); PG8_BAR; PG8_MMA(1, 1, At, B1); PG8_BAR;
            PG8_LDB(B0, 1, 0); PG8_SCHED; PG8_LDA(At, 1, 0); PG8_STAGE(PG8_SA(0, 1), a2 + hstep, voffA);
            PG8_WAIT_L(8); PG8_BAR; PG8_WAIT_L(0); PG8_MMA(0, 0, At, B0); PG8_BAR; PG8_SCHED;
            PG8_LDB(B1, 1, 1); PG8_STAGE(PG8_SB(1, 0), b3, voffB);
            PG8_BAR; PG8_WAIT_L(0); PG8_MMA(0, 1, At, B1); PG8_BAR;
            PG8_LDA(At, 1, 1); PG8_STAGE(PG8_SA(1, 0), a3, voffA);
            PG8_BAR; PG8_WAIT_L(0); PG8_MMA(1, 0, At, B0); PG8_BAR; PG8_SCHED;
            PG8_STAGE(PG8_SB(1, 1), b3 + hstep, voffB);
            PG8_WAIT_V(6); PG8_BAR; PG8_MMA(1, 1, At, B1); PG8_BAR;
            }
        }
        if constexpr (ALIGN_EPI) { if (wr == 0) PG8_BAR; }
        if constexpr (!Epi::AFTER_DRAIN) { PG8_PF(8) E(acc, cur, wr, wc, fr, fq); S.done(cur); }
        if (!has_next) break;
#pragma unroll
        for (int a = 0; a < 2; ++a)
#pragma unroll
            for (int b = 0; b < 2; ++b)
#pragma unroll
                for (int m = 0; m < 4; ++m)
#pragma unroll
                    for (int n = 0; n < 2; ++n) acc[a][b][m][n] = (f32x4){0.f, 0.f, 0.f, 0.f};
        cur = nxt; cA = nA; cB = nB; ++ui;
        if constexpr (ALIGN_EPI) { if (wr == 1) PG8_BAR; }
    }
    PG8_WAIT_V(0);
    if constexpr (!ALIGN_EPI) { if (wr == 0) PG8_BAR; }
    PG8_BAR;
    if constexpr (Epi::AFTER_DRAIN) { E.fused(acc, cur, wr, wc, fr, fq, lds, wid, lane); S.done(cur); }
#undef PG8_SA
#undef PG8_SB
#undef PG8_STAGE
#undef PG8_LDA
#undef PG8_LDB
#undef PG8_MMA
#undef PG8_WAIT_V
#undef PG8_WAIT_L
#undef PG8_BAR
#undef PG8_SCHED
}
}

#ifndef PG8_SP2
#define PG8_SP2 true
#endif
#ifndef PG8_ALIGN
#define PG8_ALIGN true
#endif
constexpr size_t MiB = 1u << 20;
constexpr size_t WS_CTL = 0, CTL_ZERO_BYTES = 1 * MiB;
constexpr size_t WS_MOD = 2 * MiB;
constexpr size_t MOD_STRIDE = (size_t)33 * DM * 4;
constexpr size_t WS_WT2 = 4 * MiB;
constexpr size_t WS_WT1 = 38 * MiB;
constexpr size_t WS_H = 170 * MiB;
constexpr size_t WS_U = 310 * MiB, WS_G = 378 * MiB, WS_Q = 446 * MiB, WS_SZ = 514 * MiB;
constexpr size_t WS_KA = 582 * MiB, WS_VA = 718 * MiB, WS_END = 854 * MiB;
static_assert(WS_WT2 + (size_t)DM * LDK * 2 <= WS_WT1 && WS_WT1 + (size_t)NIN * LDK * 2 <= WS_H, "d_ws map (weights)");
static_assert(WS_MOD + 3 * MOD_STRIDE <= WS_WT2 && WS_H + (size_t)MT * LDK * 2 <= WS_U && WS_U + (size_t)MT * DC * 2 <= WS_G && WS_KA + (size_t)KROWS * DA * 2 <= WS_VA && WS_VA + (size_t)KROWS * DA * 2 <= WS_END, "d_ws map");
constexpr size_t WS_XN = WS_U;
constexpr size_t WS_PART = WS_Q;
static_assert(WS_XN + (size_t)MT * DM * 2 <= WS_Q && WS_PART + (size_t)4 * MS * DM * 4 <= WS_SZ, "d_ws overlays");
constexpr int CW_TMO = 0, CW_BAR = 4096;
constexpr int RING_OFF = 0, RING_BYTES = 131072;
constexpr int LDSCTL_OFF = RING_BYTES, MISC_OFF = LDSCTL_OFF + 320;
constexpr int LDS_BYTES = 147456;
constexpr int NWAVES = 8;

#define GAS __attribute__((address_space(1)))
#define LAS __attribute__((address_space(3)))
typedef unsigned short bf16;
typedef unsigned v4u __attribute__((ext_vector_type(4)));
typedef unsigned v2u __attribute__((ext_vector_type(2)));
typedef float f32x4 __attribute__((ext_vector_type(4)));
typedef float f32x16 __attribute__((ext_vector_type(16)));
typedef short bf16x8 __attribute__((ext_vector_type(8)));
typedef short s16x4 __attribute__((ext_vector_type(4)));
typedef GAS unsigned gu32;
#define RLX_AGENT __ATOMIC_RELAXED, __HIP_MEMORY_SCOPE_AGENT
#define LDS_WAIT() asm volatile("s_waitcnt lgkmcnt(0)" ::: "memory")
#define VM_WAIT() asm volatile("s_waitcnt vmcnt(0)" ::: "memory")
__device__ __forceinline__ unsigned cvtpk(float lo, float hi) { unsigned r; asm volatile("v_cvt_pk_bf16_f32 %0, %1, %2" : "=v"(r) : "v"(lo), "v"(hi)); return r; }
__device__ __forceinline__ float bf2f(unsigned short b) { return __uint_as_float(((unsigned)b) << 16); }
__device__ __forceinline__ float wave_sum(float v) {
#pragma unroll
    for (int o = 1; o < 64; o <<= 1) v += __shfl_xor(v, o);
    return v;
}
#define XB_TMO      128
#define XB_XCNT(j)  (256  + 64 * (j))
#define XB_XSUB(j)  (1280 + 64 * (j))
#define XB_XGEN(j)  (2304 + 64 * (j))
#define XB_TOP      3328
#define XB_TOPGEN   3392
#define XCD_BAR_WORDS 3456
#define XB_SPIN_CAP (1u << 18)

__device__ __forceinline__ unsigned xb_ld(unsigned* p)              { return __hip_atomic_load(p, __ATOMIC_RELAXED, __HIP_MEMORY_SCOPE_AGENT); }
__device__ __forceinline__ unsigned xb_add(unsigned* p, unsigned v) { return __hip_atomic_fetch_add(p, v, __ATOMIC_RELAXED, __HIP_MEMORY_SCOPE_AGENT); }
__device__ __forceinline__ unsigned xb_xcc_id() { return (unsigned)__builtin_amdgcn_s_getreg((3 << 11) | 20) & 0xFu; }
#define XB_SPIN(cond, bar) do { unsigned _sp = 0; while (cond) { __builtin_amdgcn_s_sleep(1); \
    if ((++_sp & 255u) == 0u) { if (xb_ld(&(bar)[XB_TMO])) break; if (_sp > XB_SPIN_CAP) { atomicAdd(&(bar)[XB_TMO], 1u); break; } } } } while (0)

struct XcdBarrier {
    unsigned* bar; unsigned x;
    volatile LAS unsigned* st;
};

__device__ __forceinline__ XcdBarrier xcd_barrier_post(unsigned* bar, volatile LAS unsigned* st) {
    XcdBarrier b; b.bar = bar; b.x = xb_xcc_id(); b.st = st;
    if (threadIdx.x == 0) (void)xb_add(&bar[XB_XCNT(b.x)], 1u);
    return b;
}
__device__ __forceinline__ void xcd_barrier_complete(unsigned* bar, unsigned x, unsigned& nloc, unsigned& nx) {
    const unsigned G = gridDim.x * gridDim.y * gridDim.z;
    unsigned sum, cnt, mine, sp = 0u;
    for (;;) {
        sum = 0u; cnt = 0u; mine = 0u;
#pragma unroll
        for (unsigned j = 0; j < 16; ++j) { const unsigned c = xb_ld(&bar[XB_XCNT(j)]); sum += c; cnt += (c > 0u) ? 1u : 0u; mine = (j == x) ? c : mine; }
        if (sum == G) break;
        __builtin_amdgcn_s_sleep(1);
        if ((++sp & 255u) == 0u) { if (xb_ld(&bar[XB_TMO])) break; if (sp > XB_SPIN_CAP) { atomicAdd(&bar[XB_TMO], 1u); break; } }
    }
    nloc = mine > 0u ? mine : 1u; nx = cnt > 0u ? cnt : 1u;
}

__device__ __forceinline__ void xcd_barrier(const XcdBarrier& b) {
    asm volatile("s_waitcnt vmcnt(0)" ::: "memory");
    __syncthreads();
    if (threadIdx.x == 0) {
        unsigned* bar = b.bar;
        __builtin_amdgcn_s_waitcnt(0);
        unsigned nloc = b.st[0], nx = b.st[1];
        if (nloc == 0u) { xcd_barrier_complete(bar, b.x, nloc, nx); b.st[0] = nloc; b.st[1] = nx; }
        const unsigned old = xb_add(&bar[XB_XSUB(b.x)], 1u);
        const unsigned gen = old / nloc;
        if (old + 1u == (gen + 1u) * nloc) {
            __builtin_amdgcn_fence(__ATOMIC_RELEASE, "agent");
            asm volatile("s_waitcnt vmcnt(0)" ::: "memory");
            const unsigned og = xb_add(&bar[XB_TOP], 1u);
            const unsigned tg = og / nx;
            if (og + 1u == (tg + 1u) * nx) xb_add(&bar[XB_TOPGEN], 1u);
            else XB_SPIN(xb_ld(&bar[XB_TOPGEN]) == tg, bar);
            __builtin_amdgcn_fence(__ATOMIC_ACQUIRE, "agent");
            xb_add(&bar[XB_XGEN(b.x)], 1u);
            asm volatile("s_waitcnt vmcnt(0)" ::: "memory");
        } else {
            XB_SPIN(xb_ld(&bar[XB_XGEN(b.x)]) == gen, bar);
            __builtin_amdgcn_fence(__ATOMIC_ACQUIRE, "agent");
            asm volatile("s_waitcnt vmcnt(0)" ::: "memory");
        }
    }
    __syncthreads();
}

struct Frame {
    LAS unsigned char* lds;
    volatile LAS unsigned* MISC;
    gu32* ctl;
    int tid, lane, wave, vcu, G;
    const float *x_prompt, *x_sample, *cache_k, *cache_v, *cache_conv, *c_prompt, *c_sample, *g_norm, *w_ada, *b_ada, *w_in, *conv_w, *conv_b, *rel_bias, *w_out, *g_final;
    float* out;
    float *modA, *modB, *gate;
    bf16 *WT1, *WT2, *H, *MIX, *U, *Gc, *Q, *SZ, *KA, *VA, *XN; float* PART;
};

__device__ __forceinline__ int win_src_col(int np) {
    const int tile = np >> 8, r = np & 255, half = r >> 7, c = r & 127;
    if (tile < 16) return (half ? 4096 : 0) + 128 * tile + c;
    if (tile < 32) return (half ? 6144 : 2048) + 128 * (tile - 16) + c;
    return np;
}
__device__ __forceinline__ void p0_transpose_item(const float* W, int K, int N, bf16* WT, int k0, int src_n0, int dst_n0, LAS float* scr, int lane) {
#pragma unroll 8
    for (int i = 0; i < 32; ++i) { const int kk = 2 * i + (lane >> 5); scr[kk * 33 + (lane & 31)] = W[(size_t)(k0 + kk) * N + src_n0 + (lane & 31)]; }
    LDS_WAIT(); asm volatile("" ::: "memory");
    const int c = lane & 7;
#pragma unroll
    for (int j = 0; j < 4; ++j) { const int n = (lane >> 3) + 8 * j; const LAS float* s = scr + (8 * c) * 33 + n;
        v4u o; o.x = cvtpk(s[0 * 33], s[1 * 33]); o.y = cvtpk(s[2 * 33], s[3 * 33]); o.z = cvtpk(s[4 * 33], s[5 * 33]); o.w = cvtpk(s[6 * 33], s[7 * 33]);
        *(GAS v4u*)(WT + (size_t)(dst_n0 + n) * LDK + k0 + 8 * c) = o; }
    LDS_WAIT(); asm volatile("" ::: "memory");
}
__device__ __forceinline__ void p0_ada_task(Frame& F, int task) {
    const int n0 = 64 * task, lane = F.lane, w = F.wave, b = lane & 31, kp = lane >> 5;
    LAS float* cs = (LAS float*)(F.lds + RING_OFF + w * 8704);
    f32x16 acc0 = {}, acc1 = {}; float ap0 = 0.f, ap1 = 0.f;
    const float* wbase = F.w_ada + n0 + 2 * b;
    for (int ch = 0; ch < 8; ++ch) {
        const int k0 = 512 * w + 64 * ch;
#pragma unroll
        for (int j = 0; j < 8; ++j) { const int idx = j * 64 + lane, row = idx >> 4, c4 = idx & 15;
            const f32x4 v = *(const f32x4*)(F.c_sample + (size_t)row * DM + k0 + 4 * c4);
            LAS float* d = cs + row * 65 + 4 * c4; d[0] = v[0]; d[1] = v[1]; d[2] = v[2]; d[3] = v[3]; }
        cs[32 * 65 + lane] = F.c_prompt[k0 + lane];
        LDS_WAIT(); asm volatile("" ::: "memory");
#pragma unroll 4
        for (int ks = 0; ks < 32; ++ks) {
            const int k = k0 + 2 * ks + kp;
            const v2u wv = *(const v2u*)(wbase + (size_t)k * (3 * DM));
            const float w0 = __uint_as_float(wv.x), w1 = __uint_as_float(wv.y);
            const float a = cs[b * 65 + 2 * ks + kp], cp = cs[32 * 65 + 2 * ks + kp];
            acc0 = __builtin_amdgcn_mfma_f32_32x32x2f32(a, w0, acc0, 0, 0, 0);
            acc1 = __builtin_amdgcn_mfma_f32_32x32x2f32(a, w1, acc1, 0, 0, 0);
            ap0 = fmaf(cp, w0, ap0); ap1 = fmaf(cp, w1, ap1);
        }
        LDS_WAIT(); asm volatile("" ::: "memory");
    }
    ap0 += __shfl_xor(ap0, 32); ap1 += __shfl_xor(ap1, 32);
#pragma unroll
    for (int i = 0; i < 16; ++i) { const int r = 8 * (i >> 2) + 4 * kp + (i & 3); cs[r * 64 + 2 * b] = acc0[i]; cs[r * 64 + 2 * b + 1] = acc1[i]; }
    if (kp == 0) { cs[32 * 64 + 2 * b] = ap0; cs[32 * 64 + 2 * b + 1] = ap1; }
    LDS_WAIT(); __syncthreads();
    for (int idx = F.tid; idx < 33 * 64; idx += NWAVES * 64) {
        float s = 0.f;
#pragma unroll
        for (int q = 0; q < 8; ++q) s += ((LAS float*)(F.lds + RING_OFF + q * 8704))[idx];
        const int r = idx >> 6, col = n0 + (idx & 63), bb = (r == 32) ? 0 : 1 + r;
        s += F.b_ada[col];
        if (col < DM) F.modB[(size_t)bb * DM + col] = s;
        else if (col < 2 * DM) F.modA[(size_t)bb * DM + col - DM] = F.g_norm[col - DM] * (1.f + s);
        else F.gate[(size_t)bb * DM + col - 2 * DM] = s;
    }
    __syncthreads();
}
__device__ __forceinline__ void p0_prologue(Frame& F) {
    constexpr int N_ADA = 3 * DM / 64;
    for (int t = F.vcu; t < N_ADA; t += F.G) p0_ada_task(F, t);
    LAS float* scr = (LAS float*)(F.lds + RING_OFF + F.wave * 16384);
    const int gw = F.vcu * NWAVES + F.wave, NGW = F.G * NWAVES, lane = F.lane;
    constexpr int I_IN = (DM / 64) * (NIN / 32), I_OUT = (DM / 64) * (DM / 32);
    constexpr int NITEMS = I_IN + I_OUT;
    for (int it = gw; it < NITEMS; it += NGW) {
        int r = it;
        if (r < I_IN) { const int nblk = NIN / 32, kb = r / nblk, nb = r % nblk; p0_transpose_item(F.w_in, DM, NIN, F.WT1, 64 * kb, win_src_col(32 * nb), 32 * nb, scr, lane); continue; } r -= I_IN;
        { const int nblk = DM / 32, kb = r / nblk, nb = r % nblk; p0_transpose_item(F.w_out, DM, DM, F.WT2, 64 * kb, 32 * nb, 32 * nb, scr, lane); }
    }
}
__device__ __forceinline__ void p1_hrows(Frame& F) {
    const int gw = F.vcu * NWAVES + F.wave, NGW = F.G * NWAVES, lane = F.lane;
    f32x4 A[16], B[16]; int cur_bb = -1;
    for (int m = gw; m < MT; m += NGW) {
        const float* xrow = m < MP ? F.x_prompt + (size_t)m * DM : F.x_sample + (size_t)(m - MP) * DM;
        const int bb = m < MP ? 0 : 1 + ((m - MP) >> 5);
        const GAS f32x4* xr = (const GAS f32x4*)xrow + lane;
        f32x4 v[16];
#pragma unroll
        for (int j = 0; j < 16; ++j) v[j] = xr[64 * j];
        if (bb != cur_bb) { cur_bb = bb;
            const GAS f32x4* ar = (const GAS f32x4*)(F.modA + (size_t)bb * DM) + lane; const GAS f32x4* br = (const GAS f32x4*)(F.modB + (size_t)bb * DM) + lane;
#pragma unroll
            for (int j = 0; j < 16; ++j) { A[j] = ar[64 * j]; B[j] = br[64 * j]; } }
        float s = 0.f;
#pragma unroll
        for (int j = 0; j < 16; ++j) s += (v[j].x * v[j].x + v[j].y * v[j].y) + (v[j].z * v[j].z + v[j].w * v[j].w);
        const float rstd = 1.0f / sqrtf(wave_sum(s) * (1.f / DM) + NORM_EPS);
        GAS v2u* o8 = (GAS v2u*)(F.H + (size_t)m * LDK) + lane;
#pragma unroll
        for (int j = 0; j < 16; ++j) { const f32x4 hv = (v[j] * rstd) * A[j] + B[j]; v2u o; o.x = cvtpk(hv.x, hv.y); o.y = cvtpk(hv.z, hv.w); o8[64 * j] = o; }
    }
}
__device__ __forceinline__ void p5_final(Frame& F, bool splitk) {
    const int gw = F.vcu * NWAVES + F.wave, NGW = F.G * NWAVES, lane = F.lane;
    f32x4 gf[16];
#pragma unroll
    for (int j = 0; j < 8; ++j) { gf[2 * j] = *(const GAS f32x4*)(F.g_final + 512 * j + 8 * lane); gf[2 * j + 1] = *(const GAS f32x4*)(F.g_final + 512 * j + 8 * lane + 4); }
    for (int m = gw; m < MT; m += NGW) {
        f32x4 v[16];
        if (m >= MP && splitk) {
            const float* xr = F.x_sample + (size_t)(m - MP) * DM + 8 * lane; const float* gr = F.gate + (size_t)(1 + ((m - MP) >> 5)) * DM + 8 * lane;
            const float* pr = F.PART + (size_t)(m - MP) * DM + 8 * lane;
#pragma unroll
            for (int j = 0; j < 16; ++j) { const int o = 512 * (j >> 1) + 4 * (j & 1);
                const f32x4 p0 = *(const GAS f32x4*)(pr + o), p1 = *(const GAS f32x4*)(pr + (size_t)MS * DM + o), p2 = *(const GAS f32x4*)(pr + (size_t)2 * MS * DM + o), p3 = *(const GAS f32x4*)(pr + (size_t)3 * MS * DM + o);
                v[j] = *(const GAS f32x4*)(xr + o) + *(const GAS f32x4*)(gr + o) * ((p0 + p1) + (p2 + p3)); }
        } else {
            const bf16* xn = F.XN + (size_t)m * DM + 8 * lane; v4u w[8];
#pragma unroll
            for (int j = 0; j < 8; ++j) w[j] = *(const GAS v4u*)(xn + 512 * j);
#pragma unroll
            for (int j = 0; j < 8; ++j) { v[2 * j] = (f32x4){__uint_as_float(w[j].x << 16), __uint_as_float(w[j].x & 0xffff0000u), __uint_as_float(w[j].y << 16), __uint_as_float(w[j].y & 0xffff0000u)};
                v[2 * j + 1] = (f32x4){__uint_as_float(w[j].z << 16), __uint_as_float(w[j].z & 0xffff0000u), __uint_as_float(w[j].w << 16), __uint_as_float(w[j].w & 0xffff0000u)}; }
        }
        float s = 0.f;
#pragma unroll
        for (int j = 0; j < 16; ++j) s += (v[j].x * v[j].x + v[j].y * v[j].y) + (v[j].z * v[j].z + v[j].w * v[j].w);
        const float rstd = 1.0f / sqrtf(wave_sum(s) * (1.f / DM) + NORM_EPS);
        float* yr = F.out + (size_t)m * DM + 8 * lane;
#pragma unroll
        for (int j = 0; j < 16; ++j) *(GAS f32x4*)(yr + 512 * (j >> 1) + 4 * (j & 1)) = (v[j] * rstd) * gf[j];
    }
}
namespace att {
constexpr int SHM_V = 16384, SHM_K = 16384, OFF_V = 0, OFF_K = 2 * SHM_V, OFF_WS = OFF_K + 2 * SHM_K, OFF_BT = OFF_WS + 8 * 256;
constexpr float THRL = 8.f * 1.4426950408889634f;
#define KSWZ(row, colB) ((row) * 256 + ((colB) ^ (((row) & 7) << 4)))
#define SBAR() __builtin_amdgcn_sched_barrier(0)
__device__ __forceinline__ int crow(int r, int hi) { return (r & 3) + 8 * (r >> 2) + 4 * hi; }
__device__ __forceinline__ int v_st(int k, int c) { const int kk = (k & ~0xC) | ((k & 4) << 1) | ((k & 8) >> 1); return ((kk >> 3) * 4 + (c >> 5)) * 512 + ((kk & 7) * 32 + (c & 31)) * 2; }
__device__ __forceinline__ int v_rd_base(int lane) { return ((lane & 3) << 3) | (((lane >> 2) & 3) << 6) | (((lane >> 4) & 1) << 5) | (((lane >> 5) & 1) << 8); }
constexpr int v_rd_off(int d0, int ks, int half) { return d0 * 512 + ks * 4096 + half * 2048; }
template <int OFF> __device__ __forceinline__ s16x4 tr_read(int vb) { s16x4 r; asm volatile("ds_read_b64_tr_b16 %0, %1 offset:%2" : "=&v"(r) : "v"(vb), "i"(OFF) : "memory"); return r; }
#define PK(L, H) (bf16x8){L[0], L[1], L[2], L[3], H[0], H[1], H[2], H[3]}
#define RD8(D0, X) const s16x4 X##l0 = tr_read<v_rd_off(D0, 0, 0)>(vb), X##h0 = tr_read<v_rd_off(D0, 0, 1)>(vb), X##l1 = tr_read<v_rd_off(D0, 1, 0)>(vb), X##h1 = tr_read<v_rd_off(D0, 1, 1)>(vb), \
                            X##l2 = tr_read<v_rd_off(D0, 2, 0)>(vb), X##h2 = tr_read<v_rd_off(D0, 2, 1)>(vb), X##l3 = tr_read<v_rd_off(D0, 3, 0)>(vb), X##h3 = tr_read<v_rd_off(D0, 3, 1)>(vb)
#define MM4(OD, X) do { OD = __builtin_amdgcn_mfma_f32_32x32x16_bf16(PK(X##l0, X##h0), pa0, OD, 0, 0, 0); OD = __builtin_amdgcn_mfma_f32_32x32x16_bf16(PK(X##l1, X##h1), pa1, OD, 0, 0, 0); \
                        OD = __builtin_amdgcn_mfma_f32_32x32x16_bf16(PK(X##l2, X##h2), pa2, OD, 0, 0, 0); OD = __builtin_amdgcn_mfma_f32_32x32x16_bf16(PK(X##l3, X##h3), pa3, OD, 0, 0, 0); } while (0)
__device__ __forceinline__ void pv_all(f32x16 (&o)[4], int vb, bf16x8 pa0, bf16x8 pa1, bf16x8 pa2, bf16x8 pa3) {
  RD8(0, a); RD8(1, b);
  asm volatile("s_waitcnt lgkmcnt(8)" ::: "memory"); SBAR(); MM4(o[0], a); SBAR();
  RD8(2, c);
  asm volatile("s_waitcnt lgkmcnt(8)" ::: "memory"); SBAR(); MM4(o[1], b); SBAR();
  RD8(3, d);
  asm volatile("s_waitcnt lgkmcnt(8)" ::: "memory"); SBAR(); MM4(o[2], c); SBAR();
  asm volatile("s_waitcnt lgkmcnt(0)" ::: "memory"); SBAR(); MM4(o[3], d);
}
#undef PK
#undef RD8
#undef MM4
struct AUnit { int h, qrow0, krow0, t0, T, sample, probe; };
__device__ __forceinline__ void attn_unit(Frame& F, char* lds, const AUnit u) {
  const int tid = F.tid, wid = F.wave, lane = F.lane, r32 = lane & 31, hi = lane >> 5;
  bf16* V_lds = (bf16*)(lds + OFF_V); bf16* K_lds = (bf16*)(lds + OFF_K);
  float* btab = (float*)(lds + OFF_BT);
  for (int i = tid; i < 640; i += 512) { const int bi = i + 192 < 512 ? i + 192 : 512; btab[i] = F.rel_bias[u.h * 513 + bi] * LOG2E; }
  const bool wact = u.sample ? (wid == 0) : true;
  const int lo = u.sample ? 0 : (wid >> 1), hi_t = lo + 8, ibase = u.sample ? 0 : 32 * (wid & 1);
  const int qrow = u.qrow0 + (u.sample ? 0 : 32 * wid);
  float m_reg = -1e30f, l_reg = 0.f; f32x16 o[4] = {}; bf16x8 qr[8];
  { const bf16* Qw = F.Q + (size_t)(qrow + r32) * DA + u.h * HD + hi * 8;
#pragma unroll
    for (int d0 = 0; d0 < 8; ++d0) qr[d0] = *(const bf16x8*)(Qw + d0 * 16); }
  const int sr = tid >> 4, sc = (tid & 15) * 8, vst0 = v_st(sr, sc), vst1 = v_st(32 + sr, sc);
  const int vb0 = (int)(uintptr_t)V_lds + v_rd_base(lane);
  bf16x8 xv0, xv1, xk0, xk1;
#define SLOAD(S, t) do { const size_t off_ = (size_t)(u.krow0 + 64 * (t) + sr) * DA + u.h * HD + sc; \
    S##v0 = *(const bf16x8*)(F.VA + off_); S##v1 = *(const bf16x8*)(F.VA + off_ + 32 * DA); S##k0 = *(const bf16x8*)(F.KA + off_); S##k1 = *(const bf16x8*)(F.KA + off_ + 32 * DA); } while (0)
#define SWRITE(b, S) do { *(bf16x8*)((char*)V_lds + (b) * SHM_V + vst0) = S##v0; *(bf16x8*)((char*)V_lds + (b) * SHM_V + vst1) = S##v1; const int kc = sc * 2; \
    *(bf16x8*)((char*)K_lds + (b) * SHM_K + KSWZ(sr, kc)) = S##k0; *(bf16x8*)((char*)K_lds + (b) * SHM_K + KSWZ(32 + sr, kc)) = S##k1; } while (0)
#define WGBAR() do { asm volatile("s_waitcnt lgkmcnt(0)" ::: "memory"); __builtin_amdgcn_s_barrier(); asm volatile("" ::: "memory"); } while (0)
  SLOAD(x, u.t0); SWRITE(0, x);
#define COMPUTE(t, cur) do { if (wact && (t) >= lo && (t) <= hi_t && !(u.probe & 1)) { \
      const int dt = (t) - lo; f32x16 p0, p1; \
      if (dt <= 3) { const float c = btab[639]; _Pragma("unroll") for (int r = 0; r < 16; ++r) { p0[r] = c; p1[r] = c; } } \
      else { const float* bp = btab + (517 - 64 * dt + ibase + r32 - 4 * hi); \
        _Pragma("unroll") for (int r = 0; r < 16; ++r) { const int kk = (r & 3) + 8 * (r >> 2); p0[r] = bp[59 - kk]; p1[r] = bp[27 - kk]; } } \
      if (u.sample && (t) == 8) { _Pragma("unroll") for (int r = 0; r < 16; ++r) p1[r] = -1e30f; } \
      { const bf16* Ks = (const bf16*)((const char*)K_lds + (cur) * SHM_K); \
        _Pragma("unroll") for (int d0 = 0; d0 < 8; ++d0) { const int cb = (d0 * 16 + hi * 8) * 2; \
          const bf16x8 b0 = *(const bf16x8*)((const char*)Ks + KSWZ(r32, cb)), b1 = *(const bf16x8*)((const char*)Ks + KSWZ(32 + r32, cb)); \
          p0 = __builtin_amdgcn_mfma_f32_32x32x16_bf16(b0, qr[d0], p0, 0, 0, 0); \
          p1 = __builtin_amdgcn_mfma_f32_32x32x16_bf16(b1, qr[d0], p1, 0, 0, 0); } } \
      float pmax = p0[0]; \
      _Pragma("unroll") for (int r = 1; r < 16; ++r) pmax = fmaxf(pmax, p0[r]); \
      _Pragma("unroll") for (int r = 0; r < 16; ++r) pmax = fmaxf(pmax, p1[r]); \
      { auto rr = __builtin_amdgcn_permlane32_swap(__float_as_uint(pmax), __float_as_uint(pmax), false, false); pmax = fmaxf(__uint_as_float(rr[0]), __uint_as_float(rr[1])); } \
      float mn, alpha; \
      if (__all(pmax - m_reg <= THRL)) { mn = m_reg; alpha = 1.f; } \
      else { mn = fmaxf(m_reg, pmax); alpha = __builtin_amdgcn_exp2f(m_reg - mn); m_reg = mn; } \
      float ps = 0.f; \
      _Pragma("unroll") for (int r = 0; r < 16; ++r) { p0[r] = __builtin_amdgcn_exp2f(p0[r] - mn); p1[r] = __builtin_amdgcn_exp2f(p1[r] - mn); ps += p0[r] + p1[r]; } \
      { auto rr = __builtin_amdgcn_permlane32_swap(__float_as_uint(ps), __float_as_uint(ps), false, false); ps = __uint_as_float(rr[0]) + __uint_as_float(rr[1]); } \
      if (__any(alpha < 1.f)) { _Pragma("unroll") for (int d = 0; d < 4; ++d) _Pragma("unroll") for (int r = 0; r < 16; ++r) o[d][r] *= alpha; } \
      l_reg = l_reg * alpha + ps; \
      bf16x8 pa0, pa1, pa2, pa3; \
      PK4(p0, 0, pa0); PK4(p0, 8, pa1); PK4(p1, 0, pa2); PK4(p1, 8, pa3); \
      pv_all(o, vb0 + (cur) * SHM_V, pa0, pa1, pa2, pa3); } } while (0)
#define PK4(P, BASE, OUT) do { unsigned a0 = cvtpk(P[BASE + 0], P[BASE + 1]), a1 = cvtpk(P[BASE + 2], P[BASE + 3]);   \
    unsigned b0 = cvtpk(P[BASE + 4], P[BASE + 5]), b1 = cvtpk(P[BASE + 6], P[BASE + 7]);                              \
    auto r0 = __builtin_amdgcn_permlane32_swap(a0, b0, false, false); auto r1 = __builtin_amdgcn_permlane32_swap(a1, b1, false, false); \
    v4u w_ = {r0[0], r1[0], r0[1], r1[1]}; OUT = *reinterpret_cast<bf16x8*>(&w_); } while (0)
#define STEP(t, cur) do { WGBAR(); const bool more_ = (t) + 1 < u.T && !(u.probe & 2); if (more_) SLOAD(x, (t) + 1); COMPUTE(t, cur); if (more_) SWRITE((cur) ^ 1, x); } while (0)
  for (int t = u.t0; t < u.T; t += 2) { STEP(t, 0); if (t + 1 < u.T) STEP(t + 1, 1); }
#undef STEP
#undef PK4
#undef COMPUTE
#undef WGBAR
#undef SLOAD
#undef SWRITE
  if (wact && !(u.probe & 4)) {
    const float rl = __builtin_amdgcn_rcpf(l_reg); const int orow = qrow + r32;
    const bf16* szr = F.SZ + (size_t)orow * DA + u.h * HD + 4 * hi; bf16* mr = F.MIX + (size_t)orow * LDK + DC + u.h * HD + 4 * hi;
    v2u sz[16];
#pragma unroll
    for (int d0 = 0; d0 < 4; ++d0)
#pragma unroll
      for (int g = 0; g < 4; ++g) sz[d0 * 4 + g] = *(const GAS v2u*)(szr + d0 * 32 + g * 8);
#pragma unroll
    for (int d0 = 0; d0 < 4; ++d0)
#pragma unroll
      for (int g = 0; g < 4; ++g) { const v2u z = sz[d0 * 4 + g];
        const float v0 = o[d0][4 * g + 0] * rl * __uint_as_float(z.x << 16), v1 = o[d0][4 * g + 1] * rl * __uint_as_float(z.x & 0xffff0000u);
        const float v2 = o[d0][4 * g + 2] * rl * __uint_as_float(z.y << 16), v3 = o[d0][4 * g + 3] * rl * __uint_as_float(z.y & 0xffff0000u);
        v2u w; w.x = cvtpk(v0, v1); w.y = cvtpk(v2, v3); *(GAS v2u*)(mr + d0 * 32 + g * 8) = w; }
  }
  __syncthreads();
}
}
namespace att {
constexpr int SOFF_ML = RING_BYTES + 1024, SOFF_BT = SOFF_ML + 8 * 256;
static_assert(SOFF_BT + 2 * 2560 <= LDS_BYTES && SOFF_ML >= MISC_OFF + 128, "sample attention LDS map");
__device__ __forceinline__ void sample_pairs(Frame& F, char* lds, int wg) {
  const int tid = F.tid, wid = F.wave, lane = F.lane, r32 = lane & 31, hi = lane >> 5, q4 = wid & 3, pr = wid >> 2;
  const int pair = 2 * wg + pr, b = pair >> 4, h = pair & 15;
  char* wreg = lds + wid * 16384;
  float* btab = (float*)(lds + SOFF_BT + pr * 2560);
  float* ml = (float*)(lds + SOFF_ML);
  { const int t4 = tid & 255; const int hh = (2 * wg + (tid >> 8)) & 15; float* bt = (float*)(lds + SOFF_BT + (tid >> 8) * 2560);
    for (int i = t4; i < 640; i += 256) { const int bi = i + 192 < 512 ? i + 192 : 512; bt[i] = F.rel_bias[hh * 513 + bi] * LOG2E; } }
  bf16x8 qr[8];
  { const bf16* Qw = F.Q + (size_t)(MP + 32 * b + r32) * DA + h * HD + hi * 8;
#pragma unroll
    for (int d0 = 0; d0 < 8; ++d0) qr[d0] = *(const bf16x8*)(Qw + d0 * 16); }
  float m_reg = -1e30f, l_reg = 0.f; f32x16 o[4] = {};
  const int vb = (int)(uintptr_t)(wreg + 8192) + v_rd_base(lane);
  __syncthreads();
  const int nsub = q4 == 3 ? 5 : 4;
  int kwf[4], kwb[2];
#pragma unroll
  for (int j = 0; j < 4; ++j) kwf[j] = hi * 256 + ((8 * r32) ^ (((2 * j + hi) & 7) << 4));
#pragma unroll
  for (int j = 0; j < 2; ++j) kwb[j] = (lane >> 4) * 256 + ((16 * (lane & 15)) ^ (((4 * j + (lane >> 4)) & 7) << 4));
  const int vwf = hi * 64 + ((4 * r32) >> 5) * 512 + ((4 * r32) & 31) * 2, vwb = (lane >> 4) * 64 + ((8 * (lane & 15)) >> 5) * 512 + ((8 * (lane & 15)) & 31) * 2;
  const unsigned lofs = (unsigned)(hi * (NH * HD) + 4 * r32) * 4u;
  const unsigned lofb = (unsigned)((lane >> 4) * DA + 8 * (lane & 15)) * 2u;
  for (int s = 0; s < nsub; ++s) {
    const int jbase = s < 4 ? 128 * q4 + 32 * s : 512;
    if (s < 4) { const char* kg = (const char*)(F.cache_k + ((size_t)(b * 512 + jbase) * NH + h) * HD);
#pragma unroll
      for (int hf = 0; hf < 2; ++hf) { f32x4 kv[8];
#pragma unroll
        for (int i = 0; i < 8; ++i) kv[i] = *(const GAS f32x4*)(kg + (size_t)(8 * hf + i) * (2 * NH * HD * 4) + lofs);
#pragma unroll
        for (int i = 0; i < 8; ++i) { v2u w; w.x = cvtpk(kv[i][0], kv[i][1]); w.y = cvtpk(kv[i][2], kv[i][3]); *(v2u*)(wreg + kwf[i & 3] + (8 * hf + i) * 512) = w; } } }
    else { const char* kg = (const char*)(F.KA + (size_t)(MP + 32 * b) * DA + h * HD); v4u kv[8];
#pragma unroll
      for (int i = 0; i < 8; ++i) kv[i] = *(const GAS v4u*)(kg + (size_t)i * (4 * DA * 2) + lofb);
#pragma unroll
      for (int i = 0; i < 8; ++i) *(v4u*)(wreg + kwb[i & 1] + i * 1024) = kv[i]; }
    asm volatile("s_waitcnt lgkmcnt(0)" ::: "memory");
    f32x16 p0;
    { const float* bp = btab + (549 + r32 - 4 * hi - jbase);
#pragma unroll
      for (int r = 0; r < 16; ++r) { const int kk = (r & 3) + 8 * (r >> 2); p0[r] = bp[27 - kk]; } }
#pragma unroll
    for (int d0 = 0; d0 < 8; ++d0) { const bf16x8 kf = *(const bf16x8*)(wreg + KSWZ(r32, (d0 * 16 + hi * 8) * 2)); p0 = __builtin_amdgcn_mfma_f32_32x32x16_bf16(kf, qr[d0], p0, 0, 0, 0); }
    float pmax = p0[0];
#pragma unroll
    for (int r = 1; r < 16; ++r) pmax = fmaxf(pmax, p0[r]);
    { auto rr = __builtin_amdgcn_permlane32_swap(__float_as_uint(pmax), __float_as_uint(pmax), false, false); pmax = fmaxf(__uint_as_float(rr[0]), __uint_as_float(rr[1])); }
    float mn, alpha;
    if (__all(pmax - m_reg <= THRL)) { mn = m_reg; alpha = 1.f; }
    else { mn = fmaxf(m_reg, pmax); alpha = __builtin_amdgcn_exp2f(m_reg - mn); m_reg = mn; }
    float ps = 0.f;
#pragma unroll
    for (int r = 0; r < 16; ++r) { p0[r] = __builtin_amdgcn_exp2f(p0[r] - mn); ps += p0[r]; }
    { auto rr = __builtin_amdgcn_permlane32_swap(__float_as_uint(ps), __float_as_uint(ps), false, false); ps = __uint_as_float(rr[0]) + __uint_as_float(rr[1]); }
    if (__any(alpha < 1.f)) {
#pragma unroll
      for (int d = 0; d < 4; ++d)
#pragma unroll
        for (int r = 0; r < 16; ++r) o[d][r] *= alpha; }
    l_reg = l_reg * alpha + ps;
    bf16x8 pa0, pa1;
#define PK4(P, BASE, OUT) do { unsigned a0 = cvtpk(P[BASE + 0], P[BASE + 1]), a1 = cvtpk(P[BASE + 2], P[BASE + 3]);   \
    unsigned b0 = cvtpk(P[BASE + 4], P[BASE + 5]), b1 = cvtpk(P[BASE + 6], P[BASE + 7]);                              \
    auto r0 = __builtin_amdgcn_permlane32_swap(a0, b0, false, false); auto r1 = __builtin_amdgcn_permlane32_swap(a1, b1, false, false); \
    v4u w_ = {r0[0], r1[0], r0[1], r1[1]}; OUT = *reinterpret_cast<bf16x8*>(&w_); } while (0)
    PK4(p0, 0, pa0); PK4(p0, 8, pa1);
#undef PK4
    if (s < 4) { const char* vg = (const char*)(F.cache_v + ((size_t)(b * 512 + jbase) * NH + h) * HD);
#pragma unroll
      for (int hf = 0; hf < 2; ++hf) { f32x4 vv[8];
#pragma unroll
        for (int i = 0; i < 8; ++i) vv[i] = *(const GAS f32x4*)(vg + (size_t)(8 * hf + i) * (2 * NH * HD * 4) + lofs);
#pragma unroll
        for (int i = 0; i < 8; ++i) { v2u w; w.x = cvtpk(vv[i][0], vv[i][1]); w.y = cvtpk(vv[i][2], vv[i][3]);
          *(v2u*)(wreg + 8192 + vwf + hf * 4096 + ((i >> 1) & 1) * 2048 + ((i >> 2) & 1) * 256 + (i & 1) * 128) = w; } } }
    else { const char* vg = (const char*)(F.VA + (size_t)(MP + 32 * b) * DA + h * HD); v4u vn[8];
#pragma unroll
      for (int i = 0; i < 8; ++i) vn[i] = *(const GAS v4u*)(vg + (size_t)i * (4 * DA * 2) + lofb);
#pragma unroll
      for (int i = 0; i < 8; ++i) *(v4u*)(wreg + 8192 + vwb + ((i >> 2) & 1) * 4096 + (i & 1) * 2048 + ((i >> 1) & 1) * 256) = vn[i]; }
    asm volatile("s_waitcnt lgkmcnt(0)" ::: "memory");
#define PK(L, H) (bf16x8){L[0], L[1], L[2], L[3], H[0], H[1], H[2], H[3]}
#define PVB(D0) do { const s16x4 l0 = tr_read<v_rd_off(D0, 0, 0)>(vb), h0 = tr_read<v_rd_off(D0, 0, 1)>(vb), l1 = tr_read<v_rd_off(D0, 1, 0)>(vb), h1 = tr_read<v_rd_off(D0, 1, 1)>(vb); \
      asm volatile("s_waitcnt lgkmcnt(0)" ::: "memory"); SBAR(); \
      o[D0] = __builtin_amdgcn_mfma_f32_32x32x16_bf16(PK(l0, h0), pa0, o[D0], 0, 0, 0); o[D0] = __builtin_amdgcn_mfma_f32_32x32x16_bf16(PK(l1, h1), pa1, o[D0], 0, 0, 0); } while (0)
    PVB(0); PVB(1); PVB(2); PVB(3);
#undef PVB
#undef PK
    asm volatile("s_waitcnt lgkmcnt(0)" ::: "memory");
  }
#pragma unroll
  for (int d0 = 0; d0 < 4; ++d0)
#pragma unroll
    for (int g = 0; g < 4; ++g) *(f32x4*)(wreg + d0 * 4096 + lane * 64 + g * 16) = (f32x4){o[d0][4 * g], o[d0][4 * g + 1], o[d0][4 * g + 2], o[d0][4 * g + 3]};
  if (hi == 0) { ml[wid * 64 + r32] = m_reg; ml[wid * 64 + 32 + r32] = l_reg; }
  asm volatile("s_waitcnt lgkmcnt(0)" ::: "memory"); __syncthreads();
  { float mj[4], lj[4], M = -1e30f;
#pragma unroll
    for (int j = 0; j < 4; ++j) { mj[j] = ml[(4 * pr + j) * 64 + r32]; lj[j] = ml[(4 * pr + j) * 64 + 32 + r32]; M = fmaxf(M, mj[j]); }
    float L = 0.f, wj[4];
#pragma unroll
    for (int j = 0; j < 4; ++j) { wj[j] = __builtin_amdgcn_exp2f(mj[j] - M); L += wj[j] * lj[j]; }
    const float rl = __builtin_amdgcn_rcpf(L);
    f32x4 acc[4];
#pragma unroll
    for (int g = 0; g < 4; ++g) acc[g] = (f32x4){0.f, 0.f, 0.f, 0.f};
#pragma unroll
    for (int j = 0; j < 4; ++j) { const char* pj = lds + (4 * pr + j) * 16384 + q4 * 4096 + lane * 64;
#pragma unroll
      for (int g = 0; g < 4; ++g) acc[g] += *(const f32x4*)(pj + g * 16) * wj[j]; }
    const int orow = MP + 32 * b + r32;
    const bf16* szr = F.SZ + (size_t)orow * DA + h * HD + 32 * q4 + 4 * hi; bf16* mr = F.MIX + (size_t)orow * LDK + DC + h * HD + 32 * q4 + 4 * hi;
    v2u sz[4];
#pragma unroll
    for (int g = 0; g < 4; ++g) sz[g] = *(const GAS v2u*)(szr + g * 8);
#pragma unroll
    for (int g = 0; g < 4; ++g) { const v2u z = sz[g];
      const float v0 = acc[g][0] * rl * __uint_as_float(z.x << 16), v1 = acc[g][1] * rl * __uint_as_float(z.x & 0xffff0000u);
      const float v2 = acc[g][2] * rl * __uint_as_float(z.y << 16), v3 = acc[g][3] * rl * __uint_as_float(z.y & 0xffff0000u);
      v2u w; w.x = cvtpk(v0, v1); w.y = cvtpk(v2, v3); *(GAS v2u*)(mr + g * 8) = w; }
  }
  __syncthreads();
}
}
__device__ __forceinline__ void p3_attention(Frame& F, char* lds, int probe) {
  for (int u = F.vcu; u < NH * (MP / 256); u += F.G) { const int h = u >> 6, qb = u & 63; const int t0 = 8 - 4 * qb > 0 ? 8 - 4 * qb : 0;
    att::attn_unit(F, lds, att::AUnit{h, 256 * qb, 256 * qb - 512, t0, 12, 0, probe}); }
  if (!(probe & 8)) for (int wg = F.vcu; wg < NSB * NH / 2; wg += F.G) att::sample_pairs(F, lds, wg);
}
__device__ __forceinline__ void unpack8(const v4u w, float (&f)[8]) {
  f[0] = __uint_as_float(w.x << 16); f[1] = __uint_as_float(w.x & 0xffff0000u); f[2] = __uint_as_float(w.y << 16); f[3] = __uint_as_float(w.y & 0xffff0000u);
  f[4] = __uint_as_float(w.z << 16); f[5] = __uint_as_float(w.z & 0xffff0000u); f[6] = __uint_as_float(w.w << 16); f[7] = __uint_as_float(w.w & 0xffff0000u); }
__device__ __forceinline__ void p3_convmix(Frame& F) {
  const int gw = F.vcu * NWAVES + F.wave, NGW = F.G * NWAVES, lane = F.lane;
  constexpr int RB = 34; static_assert(MT % RB == 0 && (MT / RB) * 4 == 2048, "conv items");
  for (int it = gw; it < (MT / RB) * 4; it += NGW) {
    const int rb = it >> 2, c = 512 * (it & 3) + 8 * lane, r0 = RB * rb;
    float w0[8], w1[8], w2[8], cb[8], um2[8], um1[8];
    { const f32x4 a0 = *(const GAS f32x4*)(F.conv_w + c), a1 = *(const GAS f32x4*)(F.conv_w + c + 4), b0 = *(const GAS f32x4*)(F.conv_w + DC + c), b1 = *(const GAS f32x4*)(F.conv_w + DC + c + 4);
      const f32x4 c0 = *(const GAS f32x4*)(F.conv_w + 2 * DC + c), c1 = *(const GAS f32x4*)(F.conv_w + 2 * DC + c + 4), d0 = *(const GAS f32x4*)(F.conv_b + c), d1 = *(const GAS f32x4*)(F.conv_b + c + 4);
#pragma unroll
      for (int j = 0; j < 4; ++j) { w0[j] = a0[j]; w0[4 + j] = a1[j]; w1[j] = b0[j]; w1[4 + j] = b1[j]; w2[j] = c0[j]; w2[4 + j] = c1[j]; cb[j] = d0[j]; cb[4 + j] = d1[j]; } }
    if (r0 == 0) {
#pragma unroll
      for (int j = 0; j < 8; ++j) { um2[j] = 0.f; um1[j] = 0.f; } }
    else if (r0 > MP && ((r0 - MP) & 31) == 1) { const float* cc = F.cache_conv + (size_t)((r0 - MP) >> 5) * 2 * DC + DC + c;
#pragma unroll
      for (int j = 0; j < 8; ++j) um2[j] = cc[j];
      unpack8(*(const GAS v4u*)(F.U + (size_t)(r0 - 1) * DC + c), um1); }
    else if (r0 >= MP && ((r0 - MP) & 31) == 0) {
#pragma unroll
      for (int j = 0; j < 8; ++j) { um2[j] = 0.f; um1[j] = 0.f; } }
    else { unpack8(*(const GAS v4u*)(F.U + (size_t)(r0 - 2) * DC + c), um2); unpack8(*(const GAS v4u*)(F.U + (size_t)(r0 - 1) * DC + c), um1); }
    for (int g0 = 0; g0 < RB; g0 += 8) {
      const int nr = RB - g0 < 8 ? RB - g0 : 8;
      v4u ur[8], gr[8];
#pragma unroll
      for (int i = 0; i < 8; ++i) if (i < nr) { const size_t ro = (size_t)(r0 + g0 + i) * DC + c; ur[i] = *(const GAS v4u*)(F.U + ro); gr[i] = *(const GAS v4u*)(F.Gc + ro); }
#pragma unroll
      for (int i = 0; i < 8; ++i) if (i < nr) { const int r = r0 + g0 + i; float uu[8], gg[8], ov[8];
        if (r >= MP && ((r - MP) & 31) == 0) { const float* cc = F.cache_conv + (size_t)((r - MP) >> 5) * 2 * DC + c;
#pragma unroll
          for (int j = 0; j < 8; ++j) { um2[j] = cc[j]; um1[j] = cc[DC + j]; } }
        unpack8(ur[i], uu); unpack8(gr[i], gg);
#pragma unroll
        for (int j = 0; j < 8; ++j) { ov[j] = (cb[j] + w0[j] * um2[j] + w1[j] * um1[j] + w2[j] * uu[j]) * gg[j]; um2[j] = um1[j]; um1[j] = uu[j]; }
        v4u o; o.x = cvtpk(ov[0], ov[1]); o.y = cvtpk(ov[2], ov[3]); o.z = cvtpk(ov[4], ov[5]); o.w = cvtpk(ov[6], ov[7]);
        *(GAS v4u*)(F.MIX + (size_t)r * LDK + c) = o; }
    }
  }
}
struct Args { const float* in[16]; float* out; unsigned char* ws; int ph_lo, ph_hi; };
__global__ void __launch_bounds__(NWAVES * 64, 2) fwd(Args args) {
    extern __shared__ __attribute__((aligned(16))) unsigned char lds[];
    Frame F;
    F.lds = (LAS unsigned char*)lds;
    F.MISC = (volatile LAS unsigned*)(F.lds + MISC_OFF);
    F.tid = threadIdx.x; F.lane = F.tid & 63; F.wave = __builtin_amdgcn_readfirstlane(F.tid >> 6);
    F.G = gridDim.x; { const int bx = blockIdx.x; F.vcu = (F.G % 8 == 0) ? (bx % 8) * (F.G / 8) + bx / 8 : bx; }
    unsigned char* ws = args.ws;
    F.ctl = (gu32*)(ws + WS_CTL);
    F.x_prompt = args.in[0]; F.x_sample = args.in[1]; F.cache_k = args.in[2]; F.cache_v = args.in[3]; F.cache_conv = args.in[4]; F.c_prompt = args.in[5]; F.c_sample = args.in[6];
    F.g_norm = args.in[7]; F.w_ada = args.in[8]; F.b_ada = args.in[9]; F.w_in = args.in[10]; F.conv_w = args.in[11]; F.conv_b = args.in[12]; F.rel_bias = args.in[13]; F.w_out = args.in[14]; F.g_final = args.in[15];
    F.out = args.out;
    F.modA = (float*)(ws + WS_MOD); F.modB = (float*)(ws + WS_MOD + MOD_STRIDE); F.gate = (float*)(ws + WS_MOD + 2 * MOD_STRIDE);
    F.WT1 = (bf16*)(ws + WS_WT1); F.WT2 = (bf16*)(ws + WS_WT2); F.H = (bf16*)(ws + WS_H); F.MIX = (bf16*)(ws + WS_H);
    F.U = (bf16*)(ws + WS_U); F.Gc = (bf16*)(ws + WS_G); F.Q = (bf16*)(ws + WS_Q); F.SZ = (bf16*)(ws + WS_SZ); F.KA = (bf16*)(ws + WS_KA); F.VA = (bf16*)(ws + WS_VA); F.XN = (bf16*)(ws + WS_XN); F.PART = (float*)(ws + WS_PART);
    for (int u = F.tid; u < (LDS_BYTES - LDSCTL_OFF) / 4; u += NWAVES * 64) ((LAS unsigned*)(F.lds + LDSCTL_OFF))[u] = 0u;
    __syncthreads();
    XcdBarrier bar; bar.bar = (unsigned*)(F.ctl + CW_BAR); bar.x = 0; bar.st = nullptr;
    if (N_LAUNCHES != PER_PHASE) bar = xcd_barrier_post((unsigned*)(F.ctl + CW_BAR), F.MISC + 8);
#define GRID_BAR() do { if (N_LAUNCHES != PER_PHASE) xcd_barrier(bar); } while (0)
    const int lo = args.ph_lo, hi = args.ph_hi;
    const bool splitk = (F.G == 256);
#define IN(k) (lo <= (k) && (k) < hi)
#define BOTH(k) (IN(k) && IN((k) + 1))
#ifndef PROBE_REPEAT
#define PROBE_REPEAT 0
#endif
#define REP(k) ((PROBE_REPEAT >> (4 * (k))) & 15)
    if (IN(0)) { for (int rep = 0; rep <= REP(0); ++rep) { p0_prologue(F); if (BOTH(0)) GRID_BAR(); } }
    if (IN(1)) { for (int rep = 0; rep <= REP(1); ++rep) { p1_hrows(F); if (BOTH(1)) GRID_BAR(); } }
#if defined(PROBE_MFMA)
    if (IN(2)) {
        const bf16* ha = F.H + (size_t)(blockIdx.x * 64 + F.lane) * LDK + F.wave * 64; const bf16* wb = F.WT1 + (size_t)(blockIdx.x * 64 + F.lane) * LDK + F.wave * 64;
        bf16x8 a[8], b[8];
#pragma unroll
        for (int j = 0; j < 8; ++j) { a[j] = *(const bf16x8*)(ha + 8 * j); b[j] = *(const bf16x8*)(wb + 8 * j); }
        f32x4 acc[16];
#pragma unroll
        for (int j = 0; j < 16; ++j) acc[j] = (f32x4){0.f, 0.f, 0.f, 0.f};
        for (int it = 0; it < 17 * 64 * 4 / PROBE_MFMA; ++it) {
#pragma unroll
            for (int j = 0; j < 16; ++j) acc[j] = __builtin_amdgcn_mfma_f32_16x16x32_bf16(a[j & 7], b[(j >> 1) & 7], acc[j], 0, 0, 0);
        }
        float sacc = 0.f;
#pragma unroll
        for (int j = 0; j < 16; ++j) sacc += acc[j][0] + acc[j][1] + acc[j][2] + acc[j][3];
        if (sacc == 12345.678f) F.ctl[64] = 1u;
        GRID_BAR();
    }
#endif
    for (int rep = 0; rep <= REP(2); ++rep)
    if (IN(2)) {
        pg8::Gemm g{F.H, F.WT1, MT, NIN, DM, LDK}; pg8::StaticOrder S; S.init(MT, NIN, DM, F.G, (int)blockIdx.x);
#if defined(PROBE_GEMM)
        g.probe = rep ? PROBE_GEMM : 0;
#endif
#if defined(PROBE_HOT)
        S.hot = rep;
#endif
        pg8::EpiIn E{F.U, F.Gc, F.Q, F.SZ, F.KA, F.VA, F.out};
        pg8::gemm_phase<pg8::EpiIn, pg8::StaticOrder, PG8_ALIGN, PG8_SP2>(F.lds + RING_OFF, g, S, E);
        if (BOTH(2)) GRID_BAR();
    }
    for (int rep = 0; rep <= REP(3); ++rep)
    if (IN(3)) {
#if defined(PROBE_P3) && PROBE_P3 == 1
        if (rep == 0) p3_convmix(F); p3_attention(F, (char*)lds + RING_OFF, rep ? PROBE_ATT : 0);
#elif defined(PROBE_P3) && PROBE_P3 == 2
        if (rep == 0) p3_attention(F, (char*)lds + RING_OFF, 0); p3_convmix(F);
#else
        p3_attention(F, (char*)lds + RING_OFF, 0); p3_convmix(F);
#endif
        if (BOTH(3)) GRID_BAR(); }
    for (int rep = 0; rep <= REP(4); ++rep)
    if (IN(4)) {
        pg8::Gemm g{F.MIX, F.WT2, MT, DM, DM, LDK};
#if defined(PROBE_GEMM)
        g.probe = 0;
#endif
        pg8::EpiOut E{F.x_prompt, F.x_sample, F.gate, F.XN, F.PART};
        if (splitk) { pg8::TailSplitOrder S; S.init(F.G, (int)blockIdx.x); pg8::gemm_phase<pg8::EpiOut, pg8::TailSplitOrder, PG8_ALIGN, PG8_SP2>(F.lds + RING_OFF, g, S, E); }
        else { pg8::StaticOrder S; S.init(MT, DM, DM, F.G, (int)blockIdx.x); pg8::gemm_phase<pg8::EpiOut, pg8::StaticOrder, PG8_ALIGN, PG8_SP2>(F.lds + RING_OFF, g, S, E); }
        if (BOTH(4)) GRID_BAR();
    }
    if (IN(5)) { p5_final(F, splitk); }
#undef IN
#undef BOTH
}

extern "C" void kernel_launch(void* const* d_in, const int* in_sizes, int n_in, void* d_out, int out_size, void* d_ws, size_t ws_size, hipStream_t stream) {
    static int grid = 0;
    if (grid == 0) {
        if (n_in != 16 || in_sizes[0] != MP * DM || out_size != (int)O_END || ws_size < WS_END) {
            fprintf(stderr, "kernel_launch: shape mismatch: n_in %d in0 %d out %d ws %zu (need >= %zu); nothing launched\n", n_in, n_in > 0 ? in_sizes[0] : -1, out_size, ws_size, (size_t)WS_END); grid = -1; return; }
        int dev = 0, cus = 0, per_cu = 0;
        if (hipGetDevice(&dev) != hipSuccess || hipDeviceGetAttribute(&cus, hipDeviceAttributeMultiprocessorCount, dev) != hipSuccess) { fprintf(stderr, "kernel_launch: device query failed\n"); grid = -1; return; }
        if (hipFuncSetAttribute((const void*)fwd, hipFuncAttributeMaxDynamicSharedMemorySize, LDS_BYTES) != hipSuccess) { fprintf(stderr, "kernel_launch: hipFuncSetAttribute failed\n"); grid = -1; return; }
        if (hipOccupancyMaxActiveBlocksPerMultiprocessor(&per_cu, (const void*)fwd, NWAVES * 64, LDS_BYTES) != hipSuccess || per_cu < 1)
            fprintf(stderr, "kernel_launch: note: occupancy query reports %d workgroups per CU\n", per_cu);
        (void)hipGetLastError();
        grid = cus;
    }
    if (grid < 0) return;
    if (hipMemsetAsync((char*)d_ws + WS_CTL, 0, CTL_ZERO_BYTES, stream) != hipSuccess) { fprintf(stderr, "kernel_launch: memset failed\n"); return; }
    Args a{};
    for (int i = 0; i < 16; ++i) a.in[i] = (const float*)d_in[i];
    a.out = (float*)d_out; a.ws = (unsigned char*)d_ws;
    const int nl = (N_LAUNCHES == PER_PHASE) ? PER_PHASE : 1;
    for (int li = 0; li < nl; ++li) {
        a.ph_lo = (N_LAUNCHES == PER_PHASE) ? li : 0; a.ph_hi = (N_LAUNCHES == PER_PHASE) ? li + 1 : PER_PHASE;
        hipLaunchKernelGGL(fwd, dim3(grid), dim3(NWAVES * 64), LDS_BYTES, stream, a);
        const hipError_t le = hipPeekAtLastError();
        if (le != hipSuccess) { fprintf(stderr, "kernel_launch: launch %d failed: %s\n", li, hipGetErrorName(le)); break; }
    }
}
```

```cpp
#include <hip/hip_runtime.h>
#include <cstdio>
#include <cstdint>

#ifndef MK_N_LAUNCHES
#define MK_N_LAUNCHES 1
#endif
constexpr int N_LAUNCHES = MK_N_LAUNCHES;
constexpr int PER_PHASE = 6;

constexpr int DM = 4096, MP = 16384, NSB = 32, NST = 32, MS = NSB * NST, MT = MP + MS;
constexpr int LDK = DM + 64;
constexpr int NIN = 16384, DC = 2048, DA = 2048, NH = 16, HD = 128;
constexpr int KROWS = MT;
constexpr float NORM_EPS = 1e-6f;
constexpr float LOG2E = 1.4426950408889634f;
constexpr float QSCALE = 0.08838834764831845f * LOG2E;
constexpr size_t O_YP = 0, O_YS = (size_t)MP * DM, O_KP = O_YS + (size_t)MS * DM, O_VP = O_KP + 512 * 2048, O_CP = O_VP + 512 * 2048, O_KS = O_CP + 2 * 2048,
                 O_VS = O_KS + (size_t)MS * 2048, O_CS = O_VS + (size_t)MS * 2048, O_END = O_CS + (size_t)NSB * 2 * 2048;
static_assert(O_END == 77729792, "output size");

namespace pg8 {
#define PG8_LAS __attribute__((address_space(3)))
typedef unsigned short bf16_t;
typedef short bf16x8 __attribute__((ext_vector_type(8)));
typedef float f32x4 __attribute__((ext_vector_type(4)));
typedef unsigned u32x4 __attribute__((ext_vector_type(4)));
constexpr int BM = 256, BK = 64, HALF = 128, HTB = HALF * BK * 2  , STAGE_BYTES = 8 * HTB, NXCD = 8, WGM = 8;

__host__ __device__ __forceinline__ int lds_byte(int r, int c) { const int st = (r >> 4) * 2 + (c >> 5), rr = r & 15, cc = c & 31, ob = rr * 64 + cc * 2; return st * 1024 + (ob ^ (((ob >> 9) & 1) << 5)); }
__host__ __device__ __forceinline__ void stage_rc(int b, int& R, int& C) { const int st = b / 1024, sb = b % 1024, swz = sb ^ (((sb >> 9) & 1) << 5); R = (st >> 1) * 16 + swz / 64; C = (st & 1) * 32 + (swz % 64) / 2; }
__host__ __device__ __forceinline__ int perm32(int rho) { const int n = rho >> 4, i = rho & 15; return 8 * (i >> 2) + 4 * n + (i & 3); }

struct Unit { int pm, pn, kb, nt, part; };
struct Gemm { const bf16_t* A; const bf16_t* Bt; int M, N, K, ld;
#if defined(PROBE_GEMM)
    int probe;
#endif
};

struct StaticOrder {
    int nM, nN, nwg, G, c, nK;
#if defined(PROBE_HOT)
    int hot;
#endif
    __host__ __device__ void init(int M, int N, int K, int G_, int c_) { nM = M / BM; nN = N / BM; nK = K / BK; nwg = nM * nN; G = G_; c = c_;
#if defined(PROBE_HOT)
        hot = 0;
#endif
    }
    __host__ __device__ bool next(int i, Unit& u) const {
        const long L = (long)i * G + c; if (L >= nwg) return false;
#if defined(PROBE_HOT)
        if (hot) { const int l = c >> 3; u.pm = l & 7; u.pn = (l >> 3) + PROBE_HOT - 1; return true; }
#endif
        int wgid = (int)L; { const int q = nwg / NXCD, r = nwg % NXCD, xcd = wgid % NXCD, off = wgid / NXCD; wgid = (xcd < r ? xcd * (q + 1) : r * (q + 1) + (xcd - r) * q) + off; }
        const int nig = WGM * nN, gid = wgid / nig, fm = gid * WGM, gsz = (nM - fm) < WGM ? (nM - fm) : WGM;
        u.pm = fm + ((wgid % nig) % gsz); u.pn = (wgid % nig) / gsz; u.kb = 0; u.nt = nK; u.part = -1; return true;
    }
    __device__ __forceinline__ void a_ready(const Unit&) const {}
    __device__ __forceinline__ void done(const Unit&) const {}
};
__device__ __forceinline__ unsigned cvt_pk_bf16(float lo, float hi) { unsigned r; asm volatile("v_cvt_pk_bf16_f32 %0, %1, %2" : "=v"(r) : "v"(lo), "v"(hi)); return r; }
typedef float f32x2 __attribute__((ext_vector_type(2)));
__device__ __forceinline__ float silu_f(float x) { return x * __builtin_amdgcn_rcpf(1.0f + __builtin_amdgcn_exp2f(-1.4426950408889634f * x)); }
__device__ __forceinline__ f32x4 silu4(f32x4 v) { f32x4 r; r[0] = silu_f(v[0]); r[1] = silu_f(v[1]); r[2] = silu_f(v[2]); r[3] = silu_f(v[3]); return r; }
__device__ __forceinline__ u32x4 pack8(f32x4 v0, f32x4 v1) { u32x4 w; w.x = cvt_pk_bf16(v0[0], v0[1]); w.y = cvt_pk_bf16(v0[2], v0[3]); w.z = cvt_pk_bf16(v1[0], v1[1]); w.w = cvt_pk_bf16(v1[2], v1[3]); return w; }
__device__ __forceinline__ int krow_of(int row) { return row; }

struct EpiIn {
    static constexpr bool PERM = true, AFTER_DRAIN = false;
    bf16_t *U, *G, *Q, *SZ, *KA, *VA; float* out;
    __device__ __forceinline__ void operator()(const f32x4 (&acc)[2][2][4][2], const Unit& u, int wr, int wc, int fr, int fq) const {
        const int pn = u.pn, row0 = u.pm * BM + wr * 64 + fr;
        if (pn < 32) {
            const int col = (pn & 15) * 128 + wc * 32 + 8 * fq;
            if (pn < 16) {
#pragma unroll
                for (int ai = 0; ai < 2; ++ai)
#pragma unroll
                    for (int m = 0; m < 4; ++m) { const int row = row0 + ai * HALF + m * 16;
                        const f32x4 v0 = acc[ai][0][m][0] * acc[ai][1][m][0], v1 = acc[ai][0][m][1] * acc[ai][1][m][1];
                        *(u32x4*)(U + (size_t)row * DC + col) = pack8(v0, v1);
                        if (u.pm >= 63) { long o = -1;
                            if (row >= MP) { const int t = row & 31; if (t >= 30) o = (long)O_CS + (long)((((row - MP) >> 5) * 2 + (t - 30)) * 2048); }
                            else if (row >= MP - 2) o = (long)O_CP + (long)((row - (MP - 2)) * 2048);
                            if (o >= 0) { *(f32x4*)(out + o + col) = v0; *(f32x4*)(out + o + col + 4) = v1; } } }
            } else {
#pragma unroll
                for (int ai = 0; ai < 2; ++ai)
#pragma unroll
                    for (int m = 0; m < 4; ++m) { const int row = row0 + ai * HALF + m * 16;
                        const f32x4 v0 = acc[ai][0][m][0] * silu4(acc[ai][1][m][0]), v1 = acc[ai][0][m][1] * silu4(acc[ai][1][m][1]);
                        *(u32x4*)(G + (size_t)row * DC + col) = pack8(v0, v1); }
            }
        } else {
            const int part = (pn - 32) >> 3, colp = ((pn - 32) & 7) * 256 + wc * 32 + 8 * fq;
            if (part == 0) {
#pragma unroll
                for (int ai = 0; ai < 2; ++ai)
#pragma unroll
                    for (int m = 0; m < 4; ++m) { const int row = row0 + ai * HALF + m * 16;
#pragma unroll
                        for (int bj = 0; bj < 2; ++bj) *(u32x4*)(Q + (size_t)row * DA + colp + bj * HALF) = pack8(acc[ai][bj][m][0] * QSCALE, acc[ai][bj][m][1] * QSCALE); }
            } else if (part == 3) {
#pragma unroll
                for (int ai = 0; ai < 2; ++ai)
#pragma unroll
                    for (int m = 0; m < 4; ++m) { const int row = row0 + ai * HALF + m * 16;
#pragma unroll
                        for (int bj = 0; bj < 2; ++bj) *(u32x4*)(SZ + (size_t)row * DA + colp + bj * HALF) = pack8(silu4(acc[ai][bj][m][0]), silu4(acc[ai][bj][m][1])); }
            } else {
                bf16_t* dst = part == 1 ? KA : VA;
                float* odp = out + (part == 1 ? O_KP : O_VP); float* ods = out + (part == 1 ? O_KS : O_VS);
#pragma unroll
                for (int ai = 0; ai < 2; ++ai)
#pragma unroll
                    for (int m = 0; m < 4; ++m) { const int row = row0 + ai * HALF + m * 16; const size_t kr = (size_t)krow_of(row);
#pragma unroll
                        for (int bj = 0; bj < 2; ++bj) { *(u32x4*)(dst + kr * DA + colp + bj * HALF) = pack8(acc[ai][bj][m][0], acc[ai][bj][m][1]);
                            if (u.pm >= 62) { float* o = row >= MP ? ods + (size_t)(row - MP) * DA : odp + (size_t)(row - (MP - 512)) * DA;
                                *(f32x4*)(o + colp + bj * HALF) = acc[ai][bj][m][0]; *(f32x4*)(o + colp + bj * HALF + 4) = acc[ai][bj][m][1]; } } }
            }
        }
    }
};
struct EpiOut {
    static constexpr bool PERM = true, AFTER_DRAIN = false;
    const float* gate; bf16_t* XN; float* PART;
    __device__ __forceinline__ void operator()(const f32x4 (&acc)[2][2][4][2], const Unit& u, int wr, int wc, int fr, int fq) const {
        const int row0 = u.pm * BM + wr * 64 + fr, col = u.pn * BM + wc * 32 + 8 * fq;
        if (u.part >= 0) {
            float* pb = PART + (size_t)u.part * MS * DM;
#pragma unroll
            for (int ai = 0; ai < 2; ++ai)
#pragma unroll
                for (int m = 0; m < 4; ++m) { float* pr = pb + (size_t)(row0 + ai * HALF + m * 16 - MP) * DM + col;
#pragma unroll
                    for (int bj = 0; bj < 2; ++bj) { *(f32x4*)(pr + bj * HALF) = acc[ai][bj][m][0]; *(f32x4*)(pr + bj * HALF + 4) = acc[ai][bj][m][1]; } }
            return;
        }
        if (u.pm < MP / BM) {
            f32x4 g[2][2];
#pragma unroll
            for (int bj = 0; bj < 2; ++bj) { g[bj][0] = *(const f32x4*)(gate + col + bj * HALF); g[bj][1] = *(const f32x4*)(gate + col + bj * HALF + 4); }
#pragma unroll
            for (int ai = 0; ai < 2; ++ai)
#pragma unroll
                for (int m = 0; m < 4; ++m) { bf16_t* yr = XN + (size_t)(row0 + ai * HALF + m * 16) * DM + col;
#pragma unroll
                    for (int bj = 0; bj < 2; ++bj) *(u32x4*)(yr + bj * HALF) = pack8(g[bj][0] * acc[ai][bj][m][0], g[bj][1] * acc[ai][bj][m][1]); }
        } else {
#pragma unroll
            for (int ai = 0; ai < 2; ++ai)
#pragma unroll
                for (int m = 0; m < 4; ++m) { const int row = row0 + ai * HALF + m * 16; const float* gr = gate + (size_t)(1 + ((row - MP) >> 5)) * DM + col; bf16_t* yr = XN + (size_t)row * DM + col;
#pragma unroll
                    for (int bj = 0; bj < 2; ++bj) *(u32x4*)(yr + bj * HALF) = pack8(*(const f32x4*)(gr + bj * HALF) * acc[ai][bj][m][0], *(const f32x4*)(gr + bj * HALF + 4) * acc[ai][bj][m][1]); }
        }
    }
};
template <int XM, int XN, int RM, int RN, bool MFIRST> struct GridOrderT {
    static_assert(XM * XN == 8 && RM * RN == 32, "GridOrderT geometry");
    int nM, nN, nK, c;
    __device__ void init(int M, int N, int K, int c_) { nM = M / BM; nN = N / BM; nK = K / BK; c = c_; }
    __device__ bool next(int i, Unit& u) const {
        constexpr int BMc = XM * RM, BNc = XN * RN;
        const int x = c & 7, k = c >> 3, nq = nN / BNc, ng = (nM & ~15) / BMc, full = ng * nq;
        u.kb = 0; u.nt = nK; u.part = -1;
        if (i < full) { const int g = MFIRST ? i % ng : i / nq, q = MFIRST ? i / ng : i % nq;
            u.pm = BMc * g + RM * (x / XN) + (k % RM); u.pn = BNc * q + RN * (x % XN) + (k / RM); return true; }
        if (i == full && (nM & 15) == 4 && nN == 64) { u.pm = (nM & ~15) + (k & 3); u.pn = 8 * x + (k >> 2); return true; }
        return false;
    }
    __device__ __forceinline__ void a_ready(const Unit&) const {}
    __device__ __forceinline__ void done(const Unit&) const {}
};
typedef GridOrderT<8, 1, 2, 16, false> GridOrder;
#ifndef G1_ORDER
#define G1_ORDER GridOrderT<2, 4, 4, 8, false>
#endif
struct TailSplitOrder {
    GridOrder so; int c;
    __device__ void init(int G, int c_) { so.init(MP, DM, DM, c_); c = c_; (void)G; }
    __device__ bool next(int i, Unit& u) const {
        if (i < 4) return so.next(i, u);
        if (i > 4) return false;
        const int kq = c & 3, r = c >> 2; u.pm = MP / BM + (r & 3); u.pn = r >> 2; u.kb = kq * (DM / 4) * 2; u.nt = DM / 4 / BK; u.part = kq; return true;
    }
    __device__ __forceinline__ void a_ready(const Unit&) const {}
    __device__ __forceinline__ void done(const Unit&) const {}
};
template <class Epi, class Sched, bool ALIGN_EPI = false, bool SP2 = false>
__device__ __forceinline__ void gemm_phase(PG8_LAS unsigned char* lds, const Gemm g, const Sched& S, const Epi& E) {
    int tid_ = threadIdx.x; asm volatile("" : "+v"(tid_));
    const int tid = tid_, wid = __builtin_amdgcn_readfirstlane(tid >> 6), lane = tid & 63, wr = wid >> 2, wc = wid & 3, fr = lane & 15, fq = lane >> 4;
    const int LD = g.ld;
    unsigned voffA[2], voffB[2];
#pragma unroll
    for (int i = 0; i < 2; ++i) { int R, C; stage_rc(tid * 16 + i * 8192, R, C); const int Rb = Epi::PERM ? ((R & ~31) + perm32(R & 31)) : R;
        voffA[i] = (unsigned)(R * LD + C) * 2u; voffB[i] = (unsigned)(Rb * LD + C) * 2u; }
    const size_t kstep = (size_t)(BK * 2);
    const size_t hstep = (size_t)HALF * LD * 2;
    const size_t tstep = 2 * hstep;
    const unsigned ldsw = (unsigned)wid * 1024u;
    const int aoff = lds_byte(wr * 64 + fr, fq * 8), boff = lds_byte(wc * 32 + fr, fq * 8);
#define PG8_SA(b, h) (((b) * 2 + (h)) * HTB)
#define PG8_SB(b, h) ((4 + (b) * 2 + (h)) * HTB)
#if defined(PROBE_GEMM)
    const int pf = g.probe;
#define PG8_PF(b) if (!(pf & (b)))
#else
#define PG8_PF(b)
#endif
#define PG8_STAGE(bufoff, gbase, voff) do { PG8_PF(2) _Pragma("unroll") for (int _i = 0; _i < 2; ++_i) \
        __builtin_amdgcn_global_load_lds((const unsigned*)((const char*)(gbase) + (voff)[_i]), (PG8_LAS unsigned*)(lds + (bufoff) + ldsw + _i * 8192), 16, 0, 0); } while (0)
#define PG8_LDA(dst, b, h) do { _Pragma("unroll") for (int m = 0; m < 4; ++m) _Pragma("unroll") for (int k = 0; k < 2; ++k) dst[m][k] = *(const PG8_LAS bf16x8*)(lds + PG8_SA(b, h) + aoff + m * 2048 + k * 1024); } while (0)
#define PG8_LDB(dst, b, h) do { _Pragma("unroll") for (int n = 0; n < 2; ++n) _Pragma("unroll") for (int k = 0; k < 2; ++k) dst[n][k] = *(const PG8_LAS bf16x8*)(lds + PG8_SB(b, h) + boff + n * 2048 + k * 1024); } while (0)
#define PG8_MMA(ai, bj, At, Bt) do { __builtin_amdgcn_s_setprio(1); PG8_PF(1) _Pragma("unroll") for (int m = 0; m < 4; ++m) _Pragma("unroll") for (int n = 0; n < 2; ++n) _Pragma("unroll") for (int k = 0; k < 2; ++k) \
        acc[ai][bj][m][n] = __builtin_amdgcn_mfma_f32_16x16x32_bf16(Bt[n][k], At[m][k], acc[ai][bj][m][n], 0, 0, 0); __builtin_amdgcn_s_setprio(0); } while (0)
#define PG8_WAIT_V(n) asm volatile("s_waitcnt vmcnt(" #n ")" ::: "memory")
#define PG8_WAIT_L(n) asm volatile("s_waitcnt lgkmcnt(" #n ")" ::: "memory")
#define PG8_BAR __builtin_amdgcn_s_barrier()
#define PG8_SCHED __builtin_amdgcn_sched_barrier(0)
    Unit cur, nxt; int ui = 0;
    if (!S.next(0, cur)) return;
    f32x4 acc[2][2][4][2];
#pragma unroll
    for (int a = 0; a < 2; ++a)
#pragma unroll
        for (int b = 0; b < 2; ++b)
#pragma unroll
            for (int m = 0; m < 4; ++m)
#pragma unroll
                for (int n = 0; n < 2; ++n) acc[a][b][m][n] = (f32x4){0.f, 0.f, 0.f, 0.f};
    bf16x8 At[4][2], B0[2][2], B1[2][2];
    const char* cA = (const char*)g.A + (size_t)cur.pm * tstep + cur.kb; const char* cB = (const char*)g.Bt + (size_t)cur.pn * tstep + cur.kb;
    S.a_ready(cur);
    if constexpr (SP2) {
        PG8_STAGE(PG8_SB(0, 0), cB, voffB); PG8_STAGE(PG8_SB(0, 1), cB + hstep, voffB); PG8_STAGE(PG8_SA(0, 0), cA, voffA); PG8_STAGE(PG8_SA(0, 1), cA + hstep, voffA);
        if (wr == 1) PG8_BAR;
        PG8_WAIT_V(2); PG8_BAR;
        PG8_STAGE(PG8_SB(1, 0), cB + kstep, voffB); PG8_STAGE(PG8_SA(1, 0), cA + kstep, voffA); PG8_STAGE(PG8_SB(1, 1), cB + hstep + kstep, voffB);
        PG8_WAIT_V(6); PG8_BAR;
    } else {
        PG8_STAGE(PG8_SB(0, 0), cB, voffB); PG8_STAGE(PG8_SA(0, 0), cA, voffA); PG8_STAGE(PG8_SB(0, 1), cB + hstep, voffB); PG8_STAGE(PG8_SA(0, 1), cA + hstep, voffA);
        if (wr == 1) PG8_BAR;
        PG8_WAIT_V(4); PG8_BAR;
        PG8_STAGE(PG8_SB(1, 0), cB + kstep, voffB); PG8_STAGE(PG8_SA(1, 0), cA + kstep, voffA); PG8_STAGE(PG8_SB(1, 1), cB + hstep + kstep, voffB);
        PG8_WAIT_V(6); PG8_BAR;
    }
    for (;;) {
        const bool has_next = S.next(ui + 1, nxt);
        const char* nA = has_next ? (const char*)g.A + (size_t)nxt.pm * tstep + nxt.kb : cA; const char* nB = has_next ? (const char*)g.Bt + (size_t)nxt.pn * tstep + nxt.kb : cB;
        const int nt = cur.nt;
        for (int t = 0; t < nt; t += 2) {
            const bool last = (t == nt - 2);
            const char* a1 = cA + (size_t)(t + 1) * kstep;
            const char* a2 = last ? nA : cA + (size_t)(t + 2) * kstep; const char* b2 = last ? nB : cB + (size_t)(t + 2) * kstep;
            const char* a3 = a2 + kstep; const char* b3 = b2 + kstep;
            if (last && has_next) S.a_ready(nxt);
            if constexpr (SP2) {
            PG8_LDB(B0, 0, 0); PG8_LDB(B1, 0, 1); PG8_SCHED; PG8_LDA(At, 0, 0); PG8_STAGE(PG8_SA(1, 1), a1 + hstep, voffA);
            PG8_WAIT_V(8); PG8_WAIT_L(0); PG8_BAR; PG8_MMA(0, 0, At, B0); PG8_MMA(0, 1, At, B1); PG8_BAR; PG8_SCHED;
            PG8_LDA(At, 0, 1); PG8_STAGE(PG8_SB(0, 0), b2, voffB); PG8_STAGE(PG8_SB(0, 1), b2 + hstep, voffB); PG8_STAGE(PG8_SA(0, 0), a2, voffA);
            PG8_WAIT_V(8); PG8_WAIT_L(0); PG8_BAR; PG8_MMA(1, 0, At, B0); PG8_MMA(1, 1, At, B1); PG8_BAR; PG8_SCHED;
            PG8_LDB(B0, 1, 0); PG8_LDB(B1, 1, 1); PG8_SCHED; PG8_LDA(At, 1, 0); PG8_STAGE(PG8_SA(0, 1), a2 + hstep, voffA);
            PG8_WAIT_V(8); PG8_WAIT_L(0); PG8_BAR; PG8_MMA(0, 0, At, B0); PG8_MMA(0, 1, At, B1); PG8_BAR; PG8_SCHED;
            PG8_LDA(At, 1, 1); PG8_STAGE(PG8_SB(1, 0), b3, voffB); PG8_STAGE(PG8_SB(1, 1), b3 + hstep, voffB); PG8_STAGE(PG8_SA(1, 0), a3, voffA);
            PG8_WAIT_V(8); PG8_WAIT_L(0); PG8_BAR; PG8_MMA(1, 0, At, B0); PG8_MMA(1, 1, At, B1); PG8_BAR; PG8_SCHED;
            } else {
            PG8_LDB(B0, 0, 0); PG8_SCHED; PG8_LDA(At, 0, 0); PG8_STAGE(PG8_SA(1, 1), a1 + hstep, voffA);
            PG8_WAIT_L(8); PG8_BAR; PG8_WAIT_L(0); PG8_MMA(0, 0, At, B0); PG8_BAR; PG8_SCHED;
            PG8_LDB(B1, 0, 1); PG8_STAGE(PG8_SB(0, 0), b2, voffB);
            PG8_BAR; PG8_WAIT_L(0); PG8_MMA(0, 1, At, B1); PG8_BAR;
            PG8_LDA(At, 0, 1); PG8_STAGE(PG8_SA(0, 0), a2, voffA);
            PG8_BAR; PG8_WAIT_L(0); PG8_MMA(1, 0, At, B0); PG8_BAR; PG8_SCHED;
            PG8_STAGE(PG8_SB(0, 1), b2 + hstep, voffB);
            PG8_WAIT_V(6); PG8_BAR; PG8_MMA(1, 1, At, B1); PG8_BAR;
            PG8_LDB(B0, 1, 0); PG8_SCHED; PG8_LDA(At, 1, 0); PG8_STAGE(PG8_SA(0, 1), a2 + hstep, voffA);
            PG8_WAIT_L(8); PG8_BAR; PG8_WAIT_L(0); PG8_MMA(0, 0, At, B0); PG8_BAR; PG8_SCHED;
            PG8_LDB(B1, 1, 1); PG8_STAGE(PG8_SB(1, 0), b3, voffB);
            PG8_BAR; PG8_WAIT_L(0); PG8_MMA(0, 1, At, B1); PG8_BAR;
            PG8_LDA(At, 1, 1); PG8_STAGE(PG8_SA(1, 0), a3, voffA);
            PG8_BAR; PG8_WAIT_L(0); PG8_MMA(1, 0, At, B0); PG8_BAR; PG8_SCHED;
            PG8_STAGE(PG8_SB(1, 1), b3 + hstep, voffB);
            PG8_WAIT_V(6); PG8_BAR; PG8_MMA(1, 1, At, B1); PG8_BAR;
            }
        }
        if constexpr (ALIGN_EPI) { if (wr == 0) PG8_BAR; }
        if constexpr (!Epi::AFTER_DRAIN) { PG8_PF(8) E(acc, cur, wr, wc, fr, fq); S.done(cur); }
        if (!has_next) break;
#pragma unroll
        for (int a = 0; a < 2; ++a)
#pragma unroll
            for (int b = 0; b < 2; ++b)
#pragma unroll
                for (int m = 0; m < 4; ++m)
#pragma unroll
                    for (int n = 0; n < 2; ++n) acc[a][b][m][n] = (f32x4){0.f, 0.f, 0.f, 0.f};
        cur = nxt; cA = nA; cB = nB; ++ui;
        if constexpr (ALIGN_EPI) { if (wr == 1) PG8_BAR; }
    }
    PG8_WAIT_V(0);
    if constexpr (!ALIGN_EPI) { if (wr == 0) PG8_BAR; }
    PG8_BAR;
    if constexpr (Epi::AFTER_DRAIN) { E.fused(acc, cur, wr, wc, fr, fq, lds, wid, lane); S.done(cur); }
#undef PG8_SA
#undef PG8_SB
#undef PG8_STAGE
#undef PG8_LDA
#undef PG8_LDB
#undef PG8_MMA
#undef PG8_WAIT_V
#undef PG8_WAIT_L
#undef PG8_BAR
#undef PG8_SCHED
}
}

#ifndef PG8_SP2
#define PG8_SP2 true
#endif
#ifndef PG8_ALIGN
#define PG8_ALIGN true
#endif
constexpr size_t MiB = 1u << 20;
constexpr size_t WS_CTL = 0, CTL_ZERO_BYTES = 32768;
constexpr size_t WS_MOD = 2 * MiB;
constexpr size_t MOD_STRIDE = (size_t)33 * DM * 4;
constexpr size_t WS_WT2 = 4 * MiB;
constexpr size_t WS_WT1 = 38 * MiB;
constexpr size_t WS_H = 170 * MiB;
constexpr size_t WS_U = 310 * MiB, WS_G = 378 * MiB, WS_Q = 446 * MiB, WS_SZ = 514 * MiB;
constexpr size_t WS_KA = 582 * MiB, WS_VA = 718 * MiB, WS_END = 854 * MiB;
static_assert(WS_WT2 + (size_t)DM * LDK * 2 <= WS_WT1 && WS_WT1 + (size_t)NIN * LDK * 2 <= WS_H, "d_ws map (weights)");
static_assert(WS_MOD + 3 * MOD_STRIDE <= WS_WT2 && WS_H + (size_t)MT * LDK * 2 <= WS_U && WS_U + (size_t)MT * DC * 2 <= WS_G && WS_KA + (size_t)KROWS * DA * 2 <= WS_VA && WS_VA + (size_t)KROWS * DA * 2 <= WS_END, "d_ws map");
constexpr size_t WS_XN = WS_U;
constexpr size_t WS_PART = WS_Q;
static_assert(WS_XN + (size_t)MT * DM * 2 <= WS_Q && WS_PART + (size_t)4 * MS * DM * 4 <= WS_SZ, "d_ws overlays");
constexpr int CW_TMO = 0, CW_BAR = 4096;
constexpr int RING_OFF = 0, RING_BYTES = 131072;
constexpr int LDSCTL_OFF = RING_BYTES, MISC_OFF = LDSCTL_OFF + 320;
constexpr int LDS_BYTES = 147456;
constexpr int NWAVES = 8;

#define GAS __attribute__((address_space(1)))
#define LAS __attribute__((address_space(3)))
typedef unsigned short bf16;
typedef unsigned v4u __attribute__((ext_vector_type(4)));
typedef unsigned v2u __attribute__((ext_vector_type(2)));
typedef float f32x4 __attribute__((ext_vector_type(4)));
typedef float f32x16 __attribute__((ext_vector_type(16)));
typedef short bf16x8 __attribute__((ext_vector_type(8)));
typedef short s16x4 __attribute__((ext_vector_type(4)));
typedef GAS unsigned gu32;
#define RLX_AGENT __ATOMIC_RELAXED, __HIP_MEMORY_SCOPE_AGENT
#define LDS_WAIT() asm volatile("s_waitcnt lgkmcnt(0)" ::: "memory")
#define VM_WAIT() asm volatile("s_waitcnt vmcnt(0)" ::: "memory")
__device__ __forceinline__ unsigned cvtpk(float lo, float hi) { unsigned r; asm volatile("v_cvt_pk_bf16_f32 %0, %1, %2" : "=v"(r) : "v"(lo), "v"(hi)); return r; }
__device__ __forceinline__ float bf2f(unsigned short b) { return __uint_as_float(((unsigned)b) << 16); }
__device__ __forceinline__ float wave_sum(float v) {
#pragma unroll
    for (int o = 1; o < 64; o <<= 1) v += __shfl_xor(v, o);
    return v;
}
#define XB_TMO      128
#define XB_XCNT(j)  (256  + 64 * (j))
#define XB_XSUB(j)  (1280 + 64 * (j))
#define XB_XGEN(j)  (2304 + 64 * (j))
#define XB_TOP      3328
#define XB_TOPGEN   3392
#define XCD_BAR_WORDS 3456
#define XB_SPIN_CAP (1u << 18)

__device__ __forceinline__ unsigned xb_ld(unsigned* p)              { return __hip_atomic_load(p, __ATOMIC_RELAXED, __HIP_MEMORY_SCOPE_AGENT); }
__device__ __forceinline__ unsigned xb_add(unsigned* p, unsigned v) { return __hip_atomic_fetch_add(p, v, __ATOMIC_RELAXED, __HIP_MEMORY_SCOPE_AGENT); }
__device__ __forceinline__ unsigned xb_xcc_id() { return (unsigned)__builtin_amdgcn_s_getreg((3 << 11) | 20) & 0xFu; }
#define XB_SPIN(cond, bar) do { unsigned _sp = 0; while (cond) { __builtin_amdgcn_s_sleep(1); \
    if ((++_sp & 255u) == 0u) { if (xb_ld(&(bar)[XB_TMO])) break; if (_sp > XB_SPIN_CAP) { atomicAdd(&(bar)[XB_TMO], 1u); break; } } } } while (0)

struct XcdBarrier {
    unsigned* bar; unsigned x;
    volatile LAS unsigned* st;
};

__device__ __forceinline__ XcdBarrier xcd_barrier_post(unsigned* bar, volatile LAS unsigned* st) {
    XcdBarrier b; b.bar = bar; b.x = xb_xcc_id(); b.st = st;
    if (threadIdx.x == 0) (void)xb_add(&bar[XB_XCNT(b.x)], 1u);
    return b;
}
__device__ __forceinline__ void xcd_barrier_complete(unsigned* bar, unsigned x, unsigned& nloc, unsigned& nx) {
    const unsigned G = gridDim.x * gridDim.y * gridDim.z;
    unsigned sum, cnt, mine, sp = 0u;
    for (;;) {
        sum = 0u; cnt = 0u; mine = 0u;
#pragma unroll
        for (unsigned j = 0; j < 16; ++j) { const unsigned c = xb_ld(&bar[XB_XCNT(j)]); sum += c; cnt += (c > 0u) ? 1u : 0u; mine = (j == x) ? c : mine; }
        if (sum == G) break;
        __builtin_amdgcn_s_sleep(1);
        if ((++sp & 255u) == 0u) { if (xb_ld(&bar[XB_TMO])) break; if (sp > XB_SPIN_CAP) { atomicAdd(&bar[XB_TMO], 1u); break; } }
    }
    nloc = mine > 0u ? mine : 1u; nx = cnt > 0u ? cnt : 1u;
}

__device__ __forceinline__ void xcd_barrier(const XcdBarrier& b) {
    asm volatile("s_waitcnt vmcnt(0)" ::: "memory");
    __syncthreads();
    if (threadIdx.x == 0) {
        unsigned* bar = b.bar;
        __builtin_amdgcn_s_waitcnt(0);
        unsigned nloc = b.st[0], nx = b.st[1];
        if (nloc == 0u) { xcd_barrier_complete(bar, b.x, nloc, nx); b.st[0] = nloc; b.st[1] = nx; }
        const unsigned old = xb_add(&bar[XB_XSUB(b.x)], 1u);
        const unsigned gen = old / nloc;
        if (old + 1u == (gen + 1u) * nloc) {
            __builtin_amdgcn_fence(__ATOMIC_RELEASE, "agent");
            asm volatile("s_waitcnt vmcnt(0)" ::: "memory");
            const unsigned og = xb_add(&bar[XB_TOP], 1u);
            const unsigned tg = og / nx;
            if (og + 1u == (tg + 1u) * nx) xb_add(&bar[XB_TOPGEN], 1u);
            else XB_SPIN(xb_ld(&bar[XB_TOPGEN]) == tg, bar);
            __builtin_amdgcn_fence(__ATOMIC_ACQUIRE, "agent");
            xb_add(&bar[XB_XGEN(b.x)], 1u);
            asm volatile("s_waitcnt vmcnt(0)" ::: "memory");
        } else {
            XB_SPIN(xb_ld(&bar[XB_XGEN(b.x)]) == gen, bar);
            __builtin_amdgcn_fence(__ATOMIC_ACQUIRE, "agent");
            asm volatile("s_waitcnt vmcnt(0)" ::: "memory");
        }
    }
    __syncthreads();
}

struct Frame {
    LAS unsigned char* lds;
    volatile LAS unsigned* MISC;
    gu32* ctl;
    int tid, lane, wave, vcu, G;
    const float *x_prompt, *x_sample, *cache_k, *cache_v, *cache_conv, *c_prompt, *c_sample, *g_norm, *w_ada, *b_ada, *w_in, *conv_w, *conv_b, *rel_bias, *w_out, *g_final;
    float* out;
    float *modA, *modB, *gate;
    bf16 *WT1, *WT2, *H, *MIX, *U, *Gc, *Q, *SZ, *KA, *VA, *XN; float* PART;
};

__device__ __forceinline__ int win_src_col(int np) {
    const int tile = np >> 8, r = np & 255, half = r >> 7, c = r & 127;
    if (tile < 16) return (half ? 4096 : 0) + 128 * tile + c;
    if (tile < 32) return (half ? 6144 : 2048) + 128 * (tile - 16) + c;
    return np;
}
__device__ __forceinline__ void p0_transpose_item(const float* W, int K, int N, bf16* WT, int k0, int src_n0, int dst_n0, LAS float* scr, int lane) {
    const float* wp = W + (size_t)(k0 + (lane >> 3)) * N + src_n0 + 4 * (lane & 7); f32x4 v[8];
#pragma unroll
    for (int i = 0; i < 8; ++i) v[i] = *(const GAS f32x4*)(wp + (size_t)(8 * i) * N);
#pragma unroll
    for (int i = 0; i < 8; ++i) { LAS float* d = scr + (8 * i + (lane >> 3)) * 33 + 4 * (lane & 7); d[0] = v[i][0]; d[1] = v[i][1]; d[2] = v[i][2]; d[3] = v[i][3]; }
    LDS_WAIT(); asm volatile("" ::: "memory");
    const int c = lane & 7;
#pragma unroll
    for (int j = 0; j < 4; ++j) { const int n = (lane >> 3) + 8 * j; const LAS float* s = scr + (8 * c) * 33 + n;
        v4u o; o.x = cvtpk(s[0 * 33], s[1 * 33]); o.y = cvtpk(s[2 * 33], s[3 * 33]); o.z = cvtpk(s[4 * 33], s[5 * 33]); o.w = cvtpk(s[6 * 33], s[7 * 33]);
        *(GAS v4u*)(WT + (size_t)(dst_n0 + n) * LDK + k0 + 8 * c) = o; }
    LDS_WAIT(); asm volatile("" ::: "memory");
}
__device__ __forceinline__ void p0_ada_task(Frame& F, int task) {
    int tid_ = F.tid; asm volatile("" : "+v"(tid_));
    const int n0 = 64 * task, lane = tid_ & 63, w = F.wave, q = lane & 15, r = lane >> 4;
    LAS float* cs = (LAS float*)(F.lds + RING_OFF + w * 8704);
    f32x4 acc[2][4]; float ap[4] = {0.f, 0.f, 0.f, 0.f};
#pragma unroll
    for (int h = 0; h < 2; ++h)
#pragma unroll
        for (int e = 0; e < 4; ++e) acc[h][e] = (f32x4){0.f, 0.f, 0.f, 0.f};
    const float* wbase = F.w_ada + (size_t)r * (3 * DM) + n0 + 4 * q;
#define ADA_LOADW(WV, bt) do { _Pragma("unroll") for (int i = 0; i < 8; ++i) WV[i] = *(const GAS f32x4*)(wbase + (size_t)(512 * w + 32 * (bt) + 4 * i) * (3 * DM)); } while (0)
#define ADA_LOADC(ch) do { const int k0_ = 512 * w + 64 * (ch); _Pragma("unroll") for (int j = 0; j < 8; ++j) { const int idx = j * 64 + lane; \
        cr[j] = *(const GAS f32x4*)(F.c_sample + (size_t)(idx >> 4) * DM + k0_ + 4 * (idx & 15)); } cpr = F.c_prompt[k0_ + lane]; } while (0)
#define ADA_MMA(WV, hb) do { _Pragma("unroll") for (int i = 0; i < 8; ++i) { const int kk = 4 * (8 * (hb) + i) + r; \
        const float a0 = cs[q * 65 + kk], a1 = cs[(q + 16) * 65 + kk], cp = cs[32 * 65 + kk]; \
        _Pragma("unroll") for (int e = 0; e < 4; ++e) { acc[0][e] = __builtin_amdgcn_mfma_f32_16x16x4f32(a0, WV[i][e], acc[0][e], 0, 0, 0); \
            acc[1][e] = __builtin_amdgcn_mfma_f32_16x16x4f32(a1, WV[i][e], acc[1][e], 0, 0, 0); ap[e] = fmaf(cp, WV[i][e], ap[e]); } } } while (0)
    f32x4 wvA[8], wvB[8], cr[8]; float cpr;
    ADA_LOADC(0); ADA_LOADW(wvA, 0);
    for (int ch = 0; ch < 8; ++ch) {
#pragma unroll
        for (int j = 0; j < 8; ++j) { const int idx = j * 64 + lane; LAS float* d = cs + (idx >> 4) * 65 + 4 * (idx & 15); d[0] = cr[j][0]; d[1] = cr[j][1]; d[2] = cr[j][2]; d[3] = cr[j][3]; }
        cs[32 * 65 + lane] = cpr;
        LDS_WAIT(); asm volatile("" ::: "memory");
        if (ch + 1 < 8) ADA_LOADC(ch + 1);
        ADA_LOADW(wvB, 2 * ch + 1);
        ADA_MMA(wvA, 0);
        if (ch + 1 < 8) ADA_LOADW(wvA, 2 * ch + 2);
        ADA_MMA(wvB, 1);
        LDS_WAIT(); asm volatile("" ::: "memory");
    }
#undef ADA_LOADW
#undef ADA_LOADC
#undef ADA_MMA
#pragma unroll
    for (int e = 0; e < 4; ++e) { ap[e] += __shfl_xor(ap[e], 16); ap[e] += __shfl_xor(ap[e], 32); }
#pragma unroll
    for (int h = 0; h < 2; ++h)
#pragma unroll
        for (int e = 0; e < 4; ++e)
#pragma unroll
            for (int i = 0; i < 4; ++i) cs[(16 * h + 4 * r + i) * 64 + 4 * q + e] = acc[h][e][i];
    if (r == 0) {
#pragma unroll
        for (int e = 0; e < 4; ++e) cs[32 * 64 + 4 * q + e] = ap[e]; }
    LDS_WAIT(); __syncthreads();
    for (int idx = F.tid; idx < 33 * 64; idx += NWAVES * 64) {
        float s = 0.f;
#pragma unroll
        for (int qq = 0; qq < 8; ++qq) s += ((LAS float*)(F.lds + RING_OFF + qq * 8704))[idx];
        const int rr = idx >> 6, col = n0 + (idx & 63), bb = (rr == 32) ? 0 : 1 + rr;
        s += F.b_ada[col];
        if (col < DM) F.modB[(size_t)bb * DM + col] = s;
        else if (col < 2 * DM) F.modA[(size_t)bb * DM + col - DM] = F.g_norm[col - DM] * (1.f + s);
        else F.gate[(size_t)bb * DM + col - 2 * DM] = s;
    }
    __syncthreads();
}
__device__ __forceinline__ void p0_prologue(Frame& F, int mode) {
    constexpr int N_ADA = 3 * DM / 64;
    if (mode != 2) for (int t = F.vcu; t < N_ADA; t += F.G) p0_ada_task(F, t);
    if (mode == 1) return;
    LAS float* scr = (LAS float*)(F.lds + RING_OFF + F.wave * 16384);
    int tid_ = F.tid; asm volatile("" : "+v"(tid_));
    const int gw = F.vcu * NWAVES + F.wave, NGW = F.G * NWAVES, lane = tid_ & 63;
    constexpr int I_IN = (DM / 64) * (NIN / 32), I_OUT = (DM / 64) * (DM / 32);
    constexpr int NITEMS = I_IN + I_OUT;
    for (int it = gw; it < NITEMS; it += NGW) {
        int r = it;
        if (r < I_IN) { const int nblk = NIN / 32, kb = r / nblk, nb = r % nblk; p0_transpose_item(F.w_in, DM, NIN, F.WT1, 64 * kb, win_src_col(32 * nb), 32 * nb, scr, lane); continue; } r -= I_IN;
        { const int nblk = DM / 32, kb = r / nblk, nb = r % nblk; p0_transpose_item(F.w_out, DM, DM, F.WT2, 64 * kb, 32 * nb, 32 * nb, scr, lane); }
    }
}
__device__ __forceinline__ void p1_hrows(Frame& F) {
    int tid_ = F.tid; asm volatile("" : "+v"(tid_));
    const int gw = F.vcu * NWAVES + F.wave, NGW = F.G * NWAVES, lane = tid_ & 63;
    f32x4 A[16], B[16]; int cur_bb = -1;
    for (int m = gw; m < MT; m += NGW) {
        const float* xrow = m < MP ? F.x_prompt + (size_t)m * DM : F.x_sample + (size_t)(m - MP) * DM;
        const int bb = m < MP ? 0 : 1 + ((m - MP) >> 5);
        const GAS f32x4* xr = (const GAS f32x4*)xrow + lane;
        f32x4 v[16];
#pragma unroll
        for (int j = 0; j < 16; ++j) v[j] = xr[64 * j];
        if (bb != cur_bb) { cur_bb = bb;
            const GAS f32x4* ar = (const GAS f32x4*)(F.modA + (size_t)bb * DM) + lane; const GAS f32x4* br = (const GAS f32x4*)(F.modB + (size_t)bb * DM) + lane;
#pragma unroll
            for (int j = 0; j < 16; ++j) { A[j] = ar[64 * j]; B[j] = br[64 * j]; } }
        float s = 0.f;
#pragma unroll
        for (int j = 0; j < 16; ++j) s += (v[j].x * v[j].x + v[j].y * v[j].y) + (v[j].z * v[j].z + v[j].w * v[j].w);
        const float rstd = 1.0f / sqrtf(wave_sum(s) * (1.f / DM) + NORM_EPS);
        GAS v2u* o8 = (GAS v2u*)(F.H + (size_t)m * LDK) + lane;
#pragma unroll
        for (int j = 0; j < 16; ++j) { const f32x4 hv = (v[j] * rstd) * A[j] + B[j]; v2u o; o.x = cvtpk(hv.x, hv.y); o.y = cvtpk(hv.z, hv.w); o8[64 * j] = o; }
    }
}
__device__ __forceinline__ void p5_final(Frame& F, bool splitk) {
    int tid_ = F.tid; asm volatile("" : "+v"(tid_));
    const int gw = F.vcu * NWAVES + F.wave, NGW = F.G * NWAVES, lane = tid_ & 63;
    f32x4 gf[16];
#pragma unroll
    for (int j = 0; j < 8; ++j) { gf[2 * j] = *(const GAS f32x4*)(F.g_final + 512 * j + 8 * lane); gf[2 * j + 1] = *(const GAS f32x4*)(F.g_final + 512 * j + 8 * lane + 4); }
    for (int m = gw; m < MT; m += NGW) {
        f32x4 v[16];
        if (m >= MP && splitk) {
            const float* xr = F.x_sample + (size_t)(m - MP) * DM + 8 * lane; const float* gr = F.gate + (size_t)(1 + ((m - MP) >> 5)) * DM + 8 * lane;
            const float* pr = F.PART + (size_t)(m - MP) * DM + 8 * lane;
#pragma unroll
            for (int j = 0; j < 16; ++j) { const int o = 512 * (j >> 1) + 4 * (j & 1);
                const f32x4 p0 = *(const GAS f32x4*)(pr + o), p1 = *(const GAS f32x4*)(pr + (size_t)MS * DM + o), p2 = *(const GAS f32x4*)(pr + (size_t)2 * MS * DM + o), p3 = *(const GAS f32x4*)(pr + (size_t)3 * MS * DM + o);
                v[j] = *(const GAS f32x4*)(xr + o) + *(const GAS f32x4*)(gr + o) * ((p0 + p1) + (p2 + p3)); }
        } else {
            const bf16* xn = F.XN + (size_t)m * DM + 8 * lane; v4u w[8];
            const float* xr = (m < MP ? F.x_prompt + (size_t)m * DM : F.x_sample + (size_t)(m - MP) * DM) + 8 * lane;
#pragma unroll
            for (int j = 0; j < 8; ++j) w[j] = *(const GAS v4u*)(xn + 512 * j);
#pragma unroll
            for (int j = 0; j < 16; ++j) v[j] = *(const GAS f32x4*)(xr + 512 * (j >> 1) + 4 * (j & 1));
#pragma unroll
            for (int j = 0; j < 8; ++j) { v[2 * j] += (f32x4){__uint_as_float(w[j].x << 16), __uint_as_float(w[j].x & 0xffff0000u), __uint_as_float(w[j].y << 16), __uint_as_float(w[j].y & 0xffff0000u)};
                v[2 * j + 1] += (f32x4){__uint_as_float(w[j].z << 16), __uint_as_float(w[j].z & 0xffff0000u), __uint_as_float(w[j].w << 16), __uint_as_float(w[j].w & 0xffff0000u)}; }
        }
        float s = 0.f;
#pragma unroll
        for (int j = 0; j < 16; ++j) s += (v[j].x * v[j].x + v[j].y * v[j].y) + (v[j].z * v[j].z + v[j].w * v[j].w);
        const float rstd = 1.0f / sqrtf(wave_sum(s) * (1.f / DM) + NORM_EPS);
        float* yr = F.out + (size_t)m * DM + 8 * lane;
#pragma unroll
        for (int j = 0; j < 16; ++j) *(GAS f32x4*)(yr + 512 * (j >> 1) + 4 * (j & 1)) = (v[j] * rstd) * gf[j];
    }
}
namespace att {
constexpr int SHM_V = 16384, SHM_K = 16384, OFF_V = 0, OFF_K = 2 * SHM_V, OFF_WS = OFF_K + 2 * SHM_K, OFF_BT = OFF_WS + 8 * 256;
constexpr float THRL = 8.f * 1.4426950408889634f;
#define KSWZ(row, colB) ((row) * 256 + ((colB) ^ (((row) & 7) << 4)))
#define SBAR() __builtin_amdgcn_sched_barrier(0)
__device__ __forceinline__ int crow(int r, int hi) { return (r & 3) + 8 * (r >> 2) + 4 * hi; }
__device__ __forceinline__ int v_st(int k, int c) { const int kk = (k & ~0xC) | ((k & 4) << 1) | ((k & 8) >> 1); return ((kk >> 3) * 4 + (c >> 5)) * 512 + ((kk & 7) * 32 + (c & 31)) * 2; }
__device__ __forceinline__ int v_rd_base(int lane) { return ((lane & 3) << 3) | (((lane >> 2) & 3) << 6) | (((lane >> 4) & 1) << 5) | (((lane >> 5) & 1) << 8); }
constexpr int v_rd_off(int d0, int ks, int half) { return d0 * 512 + ks * 4096 + half * 2048; }
template <int OFF> __device__ __forceinline__ s16x4 tr_read(int vb) { s16x4 r; asm volatile("ds_read_b64_tr_b16 %0, %1 offset:%2" : "=&v"(r) : "v"(vb), "i"(OFF) : "memory"); return r; }
#define PK(L, H) (bf16x8){L[0], L[1], L[2], L[3], H[0], H[1], H[2], H[3]}
#define RD8(D0, X) const s16x4 X##l0 = tr_read<v_rd_off(D0, 0, 0)>(vb), X##h0 = tr_read<v_rd_off(D0, 0, 1)>(vb), X##l1 = tr_read<v_rd_off(D0, 1, 0)>(vb), X##h1 = tr_read<v_rd_off(D0, 1, 1)>(vb), \
                            X##l2 = tr_read<v_rd_off(D0, 2, 0)>(vb), X##h2 = tr_read<v_rd_off(D0, 2, 1)>(vb), X##l3 = tr_read<v_rd_off(D0, 3, 0)>(vb), X##h3 = tr_read<v_rd_off(D0, 3, 1)>(vb)
#define MM4(OD, X) do { OD = __builtin_amdgcn_mfma_f32_32x32x16_bf16(PK(X##l0, X##h0), pa0, OD, 0, 0, 0); OD = __builtin_amdgcn_mfma_f32_32x32x16_bf16(PK(X##l1, X##h1), pa1, OD, 0, 0, 0); \
                        OD = __builtin_amdgcn_mfma_f32_32x32x16_bf16(PK(X##l2, X##h2), pa2, OD, 0, 0, 0); OD = __builtin_amdgcn_mfma_f32_32x32x16_bf16(PK(X##l3, X##h3), pa3, OD, 0, 0, 0); } while (0)
__device__ __forceinline__ void pv_all(f32x16 (&o)[4], int vb, bf16x8 pa0, bf16x8 pa1, bf16x8 pa2, bf16x8 pa3) {
  RD8(0, a); RD8(1, b);
  asm volatile("s_waitcnt lgkmcnt(8)" ::: "memory"); SBAR(); MM4(o[0], a); SBAR();
  RD8(2, c);
  asm volatile("s_waitcnt lgkmcnt(8)" ::: "memory"); SBAR(); MM4(o[1], b); SBAR();
  RD8(3, d);
  asm volatile("s_waitcnt lgkmcnt(8)" ::: "memory"); SBAR(); MM4(o[2], c); SBAR();
  asm volatile("s_waitcnt lgkmcnt(0)" ::: "memory"); SBAR(); MM4(o[3], d);
}
#undef PK
#undef RD8
#undef MM4
struct AUnit { int h, qrow0, krow0, t0, T, ts, sample, probe; };
__device__ __forceinline__ void attn_unit(Frame& F, char* lds, const AUnit u) {
  int tid_ = F.tid; asm volatile("" : "+v"(tid_));
  const int tid = tid_, wid = F.wave, lane = tid & 63, r32 = lane & 31, hi = lane >> 5;
  bf16* V_lds = (bf16*)(lds + OFF_V); bf16* K_lds = (bf16*)(lds + OFF_K);
  float* btab = (float*)(lds + OFF_BT);
  for (int i = tid; i < 640; i += 512) { const int bi = i + 192 < 512 ? i + 192 : 512; btab[i] = F.rel_bias[u.h * 513 + bi] * LOG2E; }
  const bool wact = u.sample ? (wid == 0) : true;
  const int lo = u.sample ? 0 : (wid >> 1), hi_t = lo + 8, ibase = u.sample ? 0 : 32 * (wid & 1);
  const int qrow = u.qrow0 + (u.sample ? 0 : 32 * wid);
  float m_reg = -1e30f, l_reg = 0.f; f32x16 o[4] = {}; bf16x8 qr[8];
  { const bf16* Qw = F.Q + (size_t)(qrow + r32) * DA + u.h * HD + hi * 8;
#pragma unroll
    for (int d0 = 0; d0 < 8; ++d0) qr[d0] = *(const bf16x8*)(Qw + d0 * 16); }
  const int sr = tid >> 4, sc = (tid & 15) * 8, vst0 = v_st(sr, sc), vst1 = v_st(32 + sr, sc);
  const int vb0 = (int)(uintptr_t)V_lds + v_rd_base(lane);
  bf16x8 xv0, xv1, xk0, xk1;
#define SLOAD(S, t) do { const size_t off_ = (size_t)(u.krow0 + 64 * (t) + sr) * DA + u.h * HD + sc; \
    S##v0 = *(const bf16x8*)(F.VA + off_); S##v1 = *(const bf16x8*)(F.VA + off_ + 32 * DA); S##k0 = *(const bf16x8*)(F.KA + off_); S##k1 = *(const bf16x8*)(F.KA + off_ + 32 * DA); } while (0)
#define SWRITE(b, S) do { *(bf16x8*)((char*)V_lds + (b) * SHM_V + vst0) = S##v0; *(bf16x8*)((char*)V_lds + (b) * SHM_V + vst1) = S##v1; const int kc = sc * 2; \
    *(bf16x8*)((char*)K_lds + (b) * SHM_K + KSWZ(sr, kc)) = S##k0; *(bf16x8*)((char*)K_lds + (b) * SHM_K + KSWZ(32 + sr, kc)) = S##k1; } while (0)
#define WGBAR() do { asm volatile("s_waitcnt lgkmcnt(0)" ::: "memory"); __builtin_amdgcn_s_barrier(); asm volatile("" ::: "memory"); } while (0)
  const int ns = u.T - u.t0;
#define TILE_AT(s_) (u.ts + (s_) < u.T ? u.ts + (s_) : u.ts + (s_) - ns)
  SLOAD(x, u.ts); SWRITE(0, x);
#define COMPUTE(t, cur) do { if (wact && (t) >= lo && (t) <= hi_t && !(u.probe & 1)) { \
      const int dt = (t) - lo; f32x16 p0, p1; \
      if (dt <= 3) { const float c = btab[639]; _Pragma("unroll") for (int r = 0; r < 16; ++r) { p0[r] = c; p1[r] = c; } } \
      else { const float* bp = btab + (517 - 64 * dt + ibase + r32 - 4 * hi); \
        _Pragma("unroll") for (int r = 0; r < 16; ++r) { const int kk = (r & 3) + 8 * (r >> 2); p0[r] = bp[59 - kk]; p1[r] = bp[27 - kk]; } } \
      if (u.sample && (t) == 8) { _Pragma("unroll") for (int r = 0; r < 16; ++r) p1[r] = -1e30f; } \
      { const bf16* Ks = (const bf16*)((const char*)K_lds + (cur) * SHM_K); \
        _Pragma("unroll") for (int d0 = 0; d0 < 8; ++d0) { const int cb = (d0 * 16 + hi * 8) * 2; \
          const bf16x8 b0 = *(const bf16x8*)((const char*)Ks + KSWZ(r32, cb)), b1 = *(const bf16x8*)((const char*)Ks + KSWZ(32 + r32, cb)); \
          p0 = __builtin_amdgcn_mfma_f32_32x32x16_bf16(b0, qr[d0], p0, 0, 0, 0); \
          p1 = __builtin_amdgcn_mfma_f32_32x32x16_bf16(b1, qr[d0], p1, 0, 0, 0); } } \
      float pmax = p0[0]; \
      _Pragma("unroll") for (int r = 1; r < 16; ++r) pmax = fmaxf(pmax, p0[r]); \
      _Pragma("unroll") for (int r = 0; r < 16; ++r) pmax = fmaxf(pmax, p1[r]); \
      { auto rr = __builtin_amdgcn_permlane32_swap(__float_as_uint(pmax), __float_as_uint(pmax), false, false); pmax = fmaxf(__uint_as_float(rr[0]), __uint_as_float(rr[1])); } \
      float mn, alpha; \
      if (__all(pmax - m_reg <= THRL)) { mn = m_reg; alpha = 1.f; } \
      else { mn = fmaxf(m_reg, pmax); alpha = __builtin_amdgcn_exp2f(m_reg - mn); m_reg = mn; } \
      float ps = 0.f; \
      _Pragma("unroll") for (int r = 0; r < 16; ++r) { p0[r] = __builtin_amdgcn_exp2f(p0[r] - mn); p1[r] = __builtin_amdgcn_exp2f(p1[r] - mn); ps += p0[r] + p1[r]; } \
      { auto rr = __builtin_amdgcn_permlane32_swap(__float_as_uint(ps), __float_as_uint(ps), false, false); ps = __uint_as_float(rr[0]) + __uint_as_float(rr[1]); } \
      if (__any(alpha < 1.f)) { _Pragma("unroll") for (int d = 0; d < 4; ++d) _Pragma("unroll") for (int r = 0; r < 16; ++r) o[d][r] *= alpha; } \
      l_reg = l_reg * alpha + ps; \
      bf16x8 pa0, pa1, pa2, pa3; \
      PK4(p0, 0, pa0); PK4(p0, 8, pa1); PK4(p1, 0, pa2); PK4(p1, 8, pa3); \
      pv_all(o, vb0 + (cur) * SHM_V, pa0, pa1, pa2, pa3); } } while (0)
#define PK4(P, BASE, OUT) do { unsigned a0 = cvtpk(P[BASE + 0], P[BASE + 1]), a1 = cvtpk(P[BASE + 2], P[BASE + 3]);   \
    unsigned b0 = cvtpk(P[BASE + 4], P[BASE + 5]), b1 = cvtpk(P[BASE + 6], P[BASE + 7]);                              \
    auto r0 = __builtin_amdgcn_permlane32_swap(a0, b0, false, false); auto r1 = __builtin_amdgcn_permlane32_swap(a1, b1, false, false); \
    v4u w_ = {r0[0], r1[0], r0[1], r1[1]}; OUT = *reinterpret_cast<bf16x8*>(&w_); } while (0)
#define STEP(s_, cur) do { WGBAR(); const int t_ = TILE_AT(s_); const bool more_ = (s_) + 1 < ns && !(u.probe & 2); if (more_) SLOAD(x, TILE_AT((s_) + 1)); COMPUTE(t_, cur); if (more_) SWRITE((cur) ^ 1, x); } while (0)
  for (int s = 0; s < ns; s += 2) { STEP(s, 0); if (s + 1 < ns) STEP(s + 1, 1); }
#undef TILE_AT
#undef STEP
#undef PK4
#undef COMPUTE
#undef WGBAR
#undef SLOAD
#undef SWRITE
  if (wact && !(u.probe & 4)) {
    const float rl = __builtin_amdgcn_rcpf(l_reg); const int orow = qrow + r32;
    const bf16* szr = F.SZ + (size_t)orow * DA + u.h * HD + 4 * hi; bf16* mr = F.MIX + (size_t)orow * LDK + DC + u.h * HD + 4 * hi;
    v2u sz[16];
#pragma unroll
    for (int d0 = 0; d0 < 4; ++d0)
#pragma unroll
      for (int g = 0; g < 4; ++g) sz[d0 * 4 + g] = *(const GAS v2u*)(szr + d0 * 32 + g * 8);
#pragma unroll
    for (int d0 = 0; d0 < 4; ++d0)
#pragma unroll
      for (int g = 0; g < 4; ++g) { const v2u z = sz[d0 * 4 + g];
        const float v0 = o[d0][4 * g + 0] * rl * __uint_as_float(z.x << 16), v1 = o[d0][4 * g + 1] * rl * __uint_as_float(z.x & 0xffff0000u);
        const float v2 = o[d0][4 * g + 2] * rl * __uint_as_float(z.y << 16), v3 = o[d0][4 * g + 3] * rl * __uint_as_float(z.y & 0xffff0000u);
        v2u w; w.x = cvtpk(v0, v1); w.y = cvtpk(v2, v3); *(GAS v2u*)(mr + d0 * 32 + g * 8) = w; }
  }
  __syncthreads();
}
}
namespace att {
constexpr int SOFF_ML = RING_BYTES + 1024, SOFF_BT = SOFF_ML + 8 * 256;
static_assert(SOFF_BT + 2 * 2560 <= LDS_BYTES && SOFF_ML >= MISC_OFF + 128, "sample attention LDS map");
__device__ __forceinline__ void sample_pairs(Frame& F, char* lds, int wg) {
  int tid_ = F.tid; asm volatile("" : "+v"(tid_));
  const int tid = tid_, wid = F.wave, lane = tid & 63, r32 = lane & 31, hi = lane >> 5, q4 = wid & 3, pr = wid >> 2;
  const int pair = 2 * wg + pr, b = pair >> 4, h = pair & 15;
  char* wreg = lds + wid * 16384;
  float* btab = (float*)(lds + SOFF_BT + pr * 2560);
  float* ml = (float*)(lds + SOFF_ML);
  { const int t4 = tid & 255; const int hh = (2 * wg + (tid >> 8)) & 15; float* bt = (float*)(lds + SOFF_BT + (tid >> 8) * 2560);
    for (int i = t4; i < 640; i += 256) { const int bi = i + 192 < 512 ? i + 192 : 512; bt[i] = F.rel_bias[hh * 513 + bi] * LOG2E; } }
  bf16x8 qr[8];
  { const bf16* Qw = F.Q + (size_t)(MP + 32 * b + r32) * DA + h * HD + hi * 8;
#pragma unroll
    for (int d0 = 0; d0 < 8; ++d0) qr[d0] = *(const bf16x8*)(Qw + d0 * 16); }
  float m_reg = -1e30f, l_reg = 0.f; f32x16 o[4] = {};
  const int vb = (int)(uintptr_t)(wreg + 8192) + v_rd_base(lane);
  __syncthreads();
  const int nsub = q4 == 3 ? 5 : 4;
  int kwf[4], kwb[2];
#pragma unroll
  for (int j = 0; j < 4; ++j) kwf[j] = hi * 256 + ((8 * r32) ^ (((2 * j + hi) & 7) << 4));
#pragma unroll
  for (int j = 0; j < 2; ++j) kwb[j] = (lane >> 4) * 256 + ((16 * (lane & 15)) ^ (((4 * j + (lane >> 4)) & 7) << 4));
  const int vwf = hi * 64 + ((4 * r32) >> 5) * 512 + ((4 * r32) & 31) * 2, vwb = (lane >> 4) * 64 + ((8 * (lane & 15)) >> 5) * 512 + ((8 * (lane & 15)) & 31) * 2;
  const unsigned lofs = (unsigned)(hi * (NH * HD) + 4 * r32) * 4u;
  const unsigned lofb = (unsigned)((lane >> 4) * DA + 8 * (lane & 15)) * 2u;
  for (int s = 0; s < nsub; ++s) {
    const int jbase = s < 4 ? 128 * q4 + 32 * s : 512;
    if (s < 4) { const char* kg = (const char*)(F.cache_k + ((size_t)(b * 512 + jbase) * NH + h) * HD);
#pragma unroll
      for (int hf = 0; hf < 2; ++hf) { f32x4 kv[8];
#pragma unroll
        for (int i = 0; i < 8; ++i) kv[i] = *(const GAS f32x4*)(kg + (size_t)(8 * hf + i) * (2 * NH * HD * 4) + lofs);
#pragma unroll
        for (int i = 0; i < 8; ++i) { v2u w; w.x = cvtpk(kv[i][0], kv[i][1]); w.y = cvtpk(kv[i][2], kv[i][3]); *(v2u*)(wreg + kwf[i & 3] + (8 * hf + i) * 512) = w; } } }
    else { const char* kg = (const char*)(F.KA + (size_t)(MP + 32 * b) * DA + h * HD); v4u kv[8];
#pragma unroll
      for (int i = 0; i < 8; ++i) kv[i] = *(const GAS v4u*)(kg + (size_t)i * (4 * DA * 2) + lofb);
#pragma unroll
      for (int i = 0; i < 8; ++i) *(v4u*)(wreg + kwb[i & 1] + i * 1024) = kv[i]; }
    asm volatile("s_waitcnt lgkmcnt(0)" ::: "memory");
    f32x16 p0;
    { const float* bp = btab + (549 + r32 - 4 * hi - jbase);
#pragma unroll
      for (int r = 0; r < 16; ++r) { const int kk = (r & 3) + 8 * (r >> 2); p0[r] = bp[27 - kk]; } }
#pragma unroll
    for (int d0 = 0; d0 < 8; ++d0) { const bf16x8 kf = *(const bf16x8*)(wreg + KSWZ(r32, (d0 * 16 + hi * 8) * 2)); p0 = __builtin_amdgcn_mfma_f32_32x32x16_bf16(kf, qr[d0], p0, 0, 0, 0); }
    float pmax = p0[0];
#pragma unroll
    for (int r = 1; r < 16; ++r) pmax = fmaxf(pmax, p0[r]);
    { auto rr = __builtin_amdgcn_permlane32_swap(__float_as_uint(pmax), __float_as_uint(pmax), false, false); pmax = fmaxf(__uint_as_float(rr[0]), __uint_as_float(rr[1])); }
    float mn, alpha;
    if (__all(pmax - m_reg <= THRL)) { mn = m_reg; alpha = 1.f; }
    else { mn = fmaxf(m_reg, pmax); alpha = __builtin_amdgcn_exp2f(m_reg - mn); m_reg = mn; }
    float ps = 0.f;
#pragma unroll
    for (int r = 0; r < 16; ++r) { p0[r] = __builtin_amdgcn_exp2f(p0[r] - mn); ps += p0[r]; }
    { auto rr = __builtin_amdgcn_permlane32_swap(__float_as_uint(ps), __float_as_uint(ps), false, false); ps = __uint_as_float(rr[0]) + __uint_as_float(rr[1]); }
    if (__any(alpha < 1.f)) {
#pragma unroll
      for (int d = 0; d < 4; ++d)
#pragma unroll
        for (int r = 0; r < 16; ++r) o[d][r] *= alpha; }
    l_reg = l_reg * alpha + ps;
    bf16x8 pa0, pa1;
#define PK4(P, BASE, OUT) do { unsigned a0 = cvtpk(P[BASE + 0], P[BASE + 1]), a1 = cvtpk(P[BASE + 2], P[BASE + 3]);   \
    unsigned b0 = cvtpk(P[BASE + 4], P[BASE + 5]), b1 = cvtpk(P[BASE + 6], P[BASE + 7]);                              \
    auto r0 = __builtin_amdgcn_permlane32_swap(a0, b0, false, false); auto r1 = __builtin_amdgcn_permlane32_swap(a1, b1, false, false); \
    v4u w_ = {r0[0], r1[0], r0[1], r1[1]}; OUT = *reinterpret_cast<bf16x8*>(&w_); } while (0)
    PK4(p0, 0, pa0); PK4(p0, 8, pa1);
#undef PK4
    if (s < 4) { const char* vg = (const char*)(F.cache_v + ((size_t)(b * 512 + jbase) * NH + h) * HD);
#pragma unroll
      for (int hf = 0; hf < 2; ++hf) { f32x4 vv[8];
#pragma unroll
        for (int i = 0; i < 8; ++i) vv[i] = *(const GAS f32x4*)(vg + (size_t)(8 * hf + i) * (2 * NH * HD * 4) + lofs);
#pragma unroll
        for (int i = 0; i < 8; ++i) { v2u w; w.x = cvtpk(vv[i][0], vv[i][1]); w.y = cvtpk(vv[i][2], vv[i][3]);
          *(v2u*)(wreg + 8192 + vwf + hf * 4096 + ((i >> 1) & 1) * 2048 + ((i >> 2) & 1) * 256 + (i & 1) * 128) = w; } } }
    else { const char* vg = (const char*)(F.VA + (size_t)(MP + 32 * b) * DA + h * HD); v4u vn[8];
#pragma unroll
      for (int i = 0; i < 8; ++i) vn[i] = *(const GAS v4u*)(vg + (size_t)i * (4 * DA * 2) + lofb);
#pragma unroll
      for (int i = 0; i < 8; ++i) *(v4u*)(wreg + 8192 + vwb + ((i >> 2) & 1) * 4096 + (i & 1) * 2048 + ((i >> 1) & 1) * 256) = vn[i]; }
    asm volatile("s_waitcnt lgkmcnt(0)" ::: "memory");
#define PK(L, H) (bf16x8){L[0], L[1], L[2], L[3], H[0], H[1], H[2], H[3]}
#define PVB(D0) do { const s16x4 l0 = tr_read<v_rd_off(D0, 0, 0)>(vb), h0 = tr_read<v_rd_off(D0, 0, 1)>(vb), l1 = tr_read<v_rd_off(D0, 1, 0)>(vb), h1 = tr_read<v_rd_off(D0, 1, 1)>(vb); \
      asm volatile("s_waitcnt lgkmcnt(0)" ::: "memory"); SBAR(); \
      o[D0] = __builtin_amdgcn_mfma_f32_32x32x16_bf16(PK(l0, h0), pa0, o[D0], 0, 0, 0); o[D0] = __builtin_amdgcn_mfma_f32_32x32x16_bf16(PK(l1, h1), pa1, o[D0], 0, 0, 0); } while (0)
    PVB(0); PVB(1); PVB(2); PVB(3);
#undef PVB
#undef PK
    asm volatile("s_waitcnt lgkmcnt(0)" ::: "memory");
  }
#pragma unroll
  for (int d0 = 0; d0 < 4; ++d0)
#pragma unroll
    for (int g = 0; g < 4; ++g) *(f32x4*)(wreg + d0 * 4096 + lane * 64 + g * 16) = (f32x4){o[d0][4 * g], o[d0][4 * g + 1], o[d0][4 * g + 2], o[d0][4 * g + 3]};
  if (hi == 0) { ml[wid * 64 + r32] = m_reg; ml[wid * 64 + 32 + r32] = l_reg; }
  asm volatile("s_waitcnt lgkmcnt(0)" ::: "memory"); __syncthreads();
  { float mj[4], lj[4], M = -1e30f;
#pragma unroll
    for (int j = 0; j < 4; ++j) { mj[j] = ml[(4 * pr + j) * 64 + r32]; lj[j] = ml[(4 * pr + j) * 64 + 32 + r32]; M = fmaxf(M, mj[j]); }
    float L = 0.f, wj[4];
#pragma unroll
    for (int j = 0; j < 4; ++j) { wj[j] = __builtin_amdgcn_exp2f(mj[j] - M); L += wj[j] * lj[j]; }
    const float rl = __builtin_amdgcn_rcpf(L);
    f32x4 acc[4];
#pragma unroll
    for (int g = 0; g < 4; ++g) acc[g] = (f32x4){0.f, 0.f, 0.f, 0.f};
#pragma unroll
    for (int j = 0; j < 4; ++j) { const char* pj = lds + (4 * pr + j) * 16384 + q4 * 4096 + lane * 64;
#pragma unroll
      for (int g = 0; g < 4; ++g) acc[g] += *(const f32x4*)(pj + g * 16) * wj[j]; }
    const int orow = MP + 32 * b + r32;
    const bf16* szr = F.SZ + (size_t)orow * DA + h * HD + 32 * q4 + 4 * hi; bf16* mr = F.MIX + (size_t)orow * LDK + DC + h * HD + 32 * q4 + 4 * hi;
    v2u sz[4];
#pragma unroll
    for (int g = 0; g < 4; ++g) sz[g] = *(const GAS v2u*)(szr + g * 8);
#pragma unroll
    for (int g = 0; g < 4; ++g) { const v2u z = sz[g];
      const float v0 = acc[g][0] * rl * __uint_as_float(z.x << 16), v1 = acc[g][1] * rl * __uint_as_float(z.x & 0xffff0000u);
      const float v2 = acc[g][2] * rl * __uint_as_float(z.y << 16), v3 = acc[g][3] * rl * __uint_as_float(z.y & 0xffff0000u);
      v2u w; w.x = cvtpk(v0, v1); w.y = cvtpk(v2, v3); *(GAS v2u*)(mr + g * 8) = w; }
  }
  __syncthreads();
}
}
__device__ __forceinline__ void p3_attention(Frame& F, char* lds, int probe) {
  if (!(probe & 16)) for (int u = F.vcu; u < NH * (MP / 256); u += F.G) { const int h = u >> 6, qb = u & 63; const int t0 = 8 - 4 * qb > 0 ? 8 - 4 * qb : 0;
    const int ts = qb < 2 ? t0 : (20 - 4 * (qb % 3)) % 12;
    att::attn_unit(F, lds, att::AUnit{h, 256 * qb, 256 * qb - 512, t0, 12, ts, 0, probe}); }
  if (!(probe & 8)) for (int wg = F.vcu; wg < NSB * NH / 2; wg += F.G) att::sample_pairs(F, lds, wg);
}
__device__ __forceinline__ void unpack8(const v4u w, float (&f)[8]) {
  f[0] = __uint_as_float(w.x << 16); f[1] = __uint_as_float(w.x & 0xffff0000u); f[2] = __uint_as_float(w.y << 16); f[3] = __uint_as_float(w.y & 0xffff0000u);
  f[4] = __uint_as_float(w.z << 16); f[5] = __uint_as_float(w.z & 0xffff0000u); f[6] = __uint_as_float(w.w << 16); f[7] = __uint_as_float(w.w & 0xffff0000u); }
__device__ __forceinline__ void p3_convmix(Frame& F) {
  const int gw = F.vcu * NWAVES + F.wave, NGW = F.G * NWAVES, lane = F.lane;
  constexpr int RB = 34; static_assert(MT % RB == 0 && (MT / RB) * 4 == 2048, "conv items");
  for (int it = gw; it < (MT / RB) * 4; it += NGW) {
    const int rb = it >> 2, c = 512 * (it & 3) + 8 * lane, r0 = RB * rb;
    float w0[8], w1[8], w2[8], cb[8], um2[8], um1[8];
    { const f32x4 a0 = *(const GAS f32x4*)(F.conv_w + c), a1 = *(const GAS f32x4*)(F.conv_w + c + 4), b0 = *(const GAS f32x4*)(F.conv_w + DC + c), b1 = *(const GAS f32x4*)(F.conv_w + DC + c + 4);
      const f32x4 c0 = *(const GAS f32x4*)(F.conv_w + 2 * DC + c), c1 = *(const GAS f32x4*)(F.conv_w + 2 * DC + c + 4), d0 = *(const GAS f32x4*)(F.conv_b + c), d1 = *(const GAS f32x4*)(F.conv_b + c + 4);
#pragma unroll
      for (int j = 0; j < 4; ++j) { w0[j] = a0[j]; w0[4 + j] = a1[j]; w1[j] = b0[j]; w1[4 + j] = b1[j]; w2[j] = c0[j]; w2[4 + j] = c1[j]; cb[j] = d0[j]; cb[4 + j] = d1[j]; } }
    if (r0 == 0) {
#pragma unroll
      for (int j = 0; j < 8; ++j) { um2[j] = 0.f; um1[j] = 0.f; } }
    else if (r0 > MP && ((r0 - MP) & 31) == 1) { const float* cc = F.cache_conv + (size_t)((r0 - MP) >> 5) * 2 * DC + DC + c;
#pragma unroll
      for (int j = 0; j < 8; ++j) um2[j] = cc[j];
      unpack8(*(const GAS v4u*)(F.U + (size_t)(r0 - 1) * DC + c), um1); }
    else if (r0 >= MP && ((r0 - MP) & 31) == 0) {
#pragma unroll
      for (int j = 0; j < 8; ++j) { um2[j] = 0.f; um1[j] = 0.f; } }
    else { unpack8(*(const GAS v4u*)(F.U + (size_t)(r0 - 2) * DC + c), um2); unpack8(*(const GAS v4u*)(F.U + (size_t)(r0 - 1) * DC + c), um1); }
    for (int g0 = 0; g0 < RB; g0 += 8) {
      const int nr = RB - g0 < 8 ? RB - g0 : 8;
      v4u ur[8], gr[8];
#pragma unroll
      for (int i = 0; i < 8; ++i) if (i < nr) { const size_t ro = (size_t)(r0 + g0 + i) * DC + c; ur[i] = *(const GAS v4u*)(F.U + ro); gr[i] = *(const GAS v4u*)(F.Gc + ro); }
#pragma unroll
      for (int i = 0; i < 8; ++i) if (i < nr) { const int r = r0 + g0 + i; float uu[8], gg[8], ov[8];
        if (r >= MP && ((r - MP) & 31) == 0) { const float* cc = F.cache_conv + (size_t)((r - MP) >> 5) * 2 * DC + c;
#pragma unroll
          for (int j = 0; j < 8; ++j) { um2[j] = cc[j]; um1[j] = cc[DC + j]; } }
        unpack8(ur[i], uu); unpack8(gr[i], gg);
#pragma unroll
        for (int j = 0; j < 8; ++j) { ov[j] = (cb[j] + w0[j] * um2[j] + w1[j] * um1[j] + w2[j] * uu[j]) * gg[j]; um2[j] = um1[j]; um1[j] = uu[j]; }
        v4u o; o.x = cvtpk(ov[0], ov[1]); o.y = cvtpk(ov[2], ov[3]); o.z = cvtpk(ov[4], ov[5]); o.w = cvtpk(ov[6], ov[7]);
        *(GAS v4u*)(F.MIX + (size_t)r * LDK + c) = o; }
    }
  }
}
struct Args { const float* in[16]; float* out; unsigned char* ws; int ph_lo, ph_hi; };
__global__ void __launch_bounds__(NWAVES * 64, 2) fwd(Args args) {
    extern __shared__ __attribute__((aligned(16))) unsigned char lds[];
    Frame F;
    F.lds = (LAS unsigned char*)lds;
    F.MISC = (volatile LAS unsigned*)(F.lds + MISC_OFF);
    F.tid = threadIdx.x; F.lane = F.tid & 63; F.wave = __builtin_amdgcn_readfirstlane(F.tid >> 6);
    F.G = gridDim.x; { const int bx = blockIdx.x; F.vcu = (F.G % 8 == 0) ? (bx % 8) * (F.G / 8) + bx / 8 : bx; }
    unsigned char* ws = args.ws;
    F.ctl = (gu32*)(ws + WS_CTL);
    F.x_prompt = args.in[0]; F.x_sample = args.in[1]; F.cache_k = args.in[2]; F.cache_v = args.in[3]; F.cache_conv = args.in[4]; F.c_prompt = args.in[5]; F.c_sample = args.in[6];
    F.g_norm = args.in[7]; F.w_ada = args.in[8]; F.b_ada = args.in[9]; F.w_in = args.in[10]; F.conv_w = args.in[11]; F.conv_b = args.in[12]; F.rel_bias = args.in[13]; F.w_out = args.in[14]; F.g_final = args.in[15];
    F.out = args.out;
    F.modA = (float*)(ws + WS_MOD); F.modB = (float*)(ws + WS_MOD + MOD_STRIDE); F.gate = (float*)(ws + WS_MOD + 2 * MOD_STRIDE);
    F.WT1 = (bf16*)(ws + WS_WT1); F.WT2 = (bf16*)(ws + WS_WT2); F.H = (bf16*)(ws + WS_H); F.MIX = (bf16*)(ws + WS_H);
    F.U = (bf16*)(ws + WS_U); F.Gc = (bf16*)(ws + WS_G); F.Q = (bf16*)(ws + WS_Q); F.SZ = (bf16*)(ws + WS_SZ); F.KA = (bf16*)(ws + WS_KA); F.VA = (bf16*)(ws + WS_VA); F.XN = (bf16*)(ws + WS_XN); F.PART = (float*)(ws + WS_PART);
    for (int u = F.tid; u < (LDS_BYTES - LDSCTL_OFF) / 4; u += NWAVES * 64) ((LAS unsigned*)(F.lds + LDSCTL_OFF))[u] = 0u;
    __syncthreads();
    XcdBarrier bar; bar.bar = (unsigned*)(F.ctl + CW_BAR); bar.x = 0; bar.st = nullptr;
    if (N_LAUNCHES != PER_PHASE) bar = xcd_barrier_post((unsigned*)(F.ctl + CW_BAR), F.MISC + 8);
#if defined(PROBE_STAMP)
    unsigned long long ta = 0, tb = 0;
#define STAMP(i) do { if ((i) == PROBE_STAMP || (PROBE_STAMP == 100 && (i) == 0)) ta = __builtin_amdgcn_s_memrealtime(); if ((i) == PROBE_STAMP + 1) tb = __builtin_amdgcn_s_memrealtime(); } while (0)
#define GRID_BAR(i) do { if (N_LAUNCHES != PER_PHASE) xcd_barrier(bar); STAMP(i); } while (0)
    STAMP(0);
#else
#define GRID_BAR(i) do { if (N_LAUNCHES != PER_PHASE) xcd_barrier(bar); } while (0)
#endif
    const int lo = args.ph_lo, hi = args.ph_hi;
    const bool splitk = (F.G == 256);
#define IN(k) (lo <= (k) && (k) < hi)
#define BOTH(k) (IN(k) && IN((k) + 1))
#ifndef PROBE_REPEAT
#define PROBE_REPEAT 0
#endif
#define REP(k) ((PROBE_REPEAT >> (4 * (k))) & 15)
#if defined(PROBE_P0SPLIT)
    if (IN(0)) { STAMP(20); p0_prologue(F, 1); xcd_barrier(bar); STAMP(21); p0_prologue(F, 2); GRID_BAR(1); STAMP(22); }
#else
    if (IN(0)) { for (int rep = 0; rep <= REP(0); ++rep) { p0_prologue(F, 0); if (BOTH(0)) GRID_BAR(1); } }
#endif
    if (IN(1)) { for (int rep = 0; rep <= REP(1); ++rep) { p1_hrows(F); if (BOTH(1)) GRID_BAR(2); } }
#if defined(PROBE_MFMA)
    if (IN(2)) {
        const bf16* ha = F.H + (size_t)(blockIdx.x * 64 + F.lane) * LDK + F.wave * 64; const bf16* wb = F.WT1 + (size_t)(blockIdx.x * 64 + F.lane) * LDK + F.wave * 64;
        bf16x8 a[8], b[8];
#pragma unroll
        for (int j = 0; j < 8; ++j) { a[j] = *(const bf16x8*)(ha + 8 * j); b[j] = *(const bf16x8*)(wb + 8 * j); }
        f32x4 acc[16];
#pragma unroll
        for (int j = 0; j < 16; ++j) acc[j] = (f32x4){0.f, 0.f, 0.f, 0.f};
        for (int it = 0; it < 17 * 64 * 4 / PROBE_MFMA; ++it) {
#pragma unroll
            for (int j = 0; j < 16; ++j) acc[j] = __builtin_amdgcn_mfma_f32_16x16x32_bf16(a[j & 7], b[(j >> 1) & 7], acc[j], 0, 0, 0);
        }
        float sacc = 0.f;
#pragma unroll
        for (int j = 0; j < 16; ++j) sacc += acc[j][0] + acc[j][1] + acc[j][2] + acc[j][3];
        if (sacc == 12345.678f) F.ctl[64] = 1u;
        GRID_BAR();
    }
#endif
    for (int rep = 0; rep <= REP(2); ++rep)
    if (IN(2)) {
        pg8::Gemm g{F.H, F.WT1, MT, NIN, DM, LDK};
#if defined(PROBE_GEMM)
        g.probe = rep ? PROBE_GEMM : 0;
#endif
        pg8::EpiIn E{F.U, F.Gc, F.Q, F.SZ, F.KA, F.VA, F.out};
        if (splitk) { typedef pg8::G1_ORDER G1; G1 S; S.init(MT, NIN, DM, (int)blockIdx.x); pg8::gemm_phase<pg8::EpiIn, G1, PG8_ALIGN, PG8_SP2>(F.lds + RING_OFF, g, S, E); }
        else { pg8::StaticOrder S; S.init(MT, NIN, DM, F.G, (int)blockIdx.x); pg8::gemm_phase<pg8::EpiIn, pg8::StaticOrder, PG8_ALIGN, PG8_SP2>(F.lds + RING_OFF, g, S, E); }
        if (BOTH(2)) GRID_BAR(3);
#if defined(PROBE_ADA_LATE)
        STAMP(30); p0_prologue(F, PROBE_ADA_LATE); xcd_barrier(bar); STAMP(31);
#endif
    }
    for (int rep = 0; rep <= REP(3); ++rep)
    if (IN(3)) {
#if defined(PROBE_P3) && PROBE_P3 == 1
        if (rep == 0) p3_convmix(F); p3_attention(F, (char*)lds + RING_OFF, rep ? PROBE_ATT : 0);
#elif defined(PROBE_P3) && PROBE_P3 == 2
        if (rep == 0) p3_attention(F, (char*)lds + RING_OFF, 0); p3_convmix(F);
#elif defined(PROBE_STAMP) && PROBE_STAMP >= 10
#if defined(PROBE_HOTKV)
        p3_attention(F, (char*)lds + RING_OFF, 8); xcd_barrier(bar);
        STAMP(10); p3_attention(F, (char*)lds + RING_OFF, 8 + 4 + PROBE_HOTKV); xcd_barrier(bar); STAMP(11);
#else
        STAMP(10); p3_attention(F, (char*)lds + RING_OFF, 8); xcd_barrier(bar); STAMP(11);
#endif
        p3_attention(F, (char*)lds + RING_OFF, 16); xcd_barrier(bar); STAMP(12); p3_convmix(F); xcd_barrier(bar); STAMP(13);
#else
        p3_attention(F, (char*)lds + RING_OFF, 0); p3_convmix(F);
#endif
        if (BOTH(3)) GRID_BAR(4); }
    for (int rep = 0; rep <= REP(4); ++rep)
    if (IN(4)) {
        pg8::Gemm g{F.MIX, F.WT2, MT, DM, DM, LDK};
#if defined(PROBE_GEMM)
        g.probe = 0;
#endif
        pg8::EpiOut E{F.gate, F.XN, F.PART};
        if (splitk) { pg8::TailSplitOrder S; S.init(F.G, (int)blockIdx.x); pg8::gemm_phase<pg8::EpiOut, pg8::TailSplitOrder, PG8_ALIGN, PG8_SP2>(F.lds + RING_OFF, g, S, E); }
        else { pg8::StaticOrder S; S.init(MT, DM, DM, F.G, (int)blockIdx.x); pg8::gemm_phase<pg8::EpiOut, pg8::StaticOrder, PG8_ALIGN, PG8_SP2>(F.lds + RING_OFF, g, S, E); }
        if (BOTH(4)) GRID_BAR(5);
    }
    if (IN(5)) { p5_final(F, splitk); }
#if defined(PROBE_STAMP)
    STAMP(6);
#if PROBE_STAMP == 100
    tb = __builtin_amdgcn_s_memrealtime();
#endif
    if (blockIdx.x == 0 && F.tid == 0) { const unsigned long long d = tb - ta, te = __builtin_amdgcn_s_memrealtime();
        while (__builtin_amdgcn_s_memrealtime() - te < 4ull * d) __builtin_amdgcn_s_sleep(32); }
#endif
#undef IN
#undef BOTH
}

extern "C" void kernel_launch(void* const* d_in, const int* in_sizes, int n_in, void* d_out, int out_size, void* d_ws, size_t ws_size, hipStream_t stream) {
    static int grid = 0;
    if (grid == 0) {
        if (n_in != 16 || in_sizes[0] != MP * DM || out_size != (int)O_END || ws_size < WS_END) {
            fprintf(stderr, "kernel_launch: shape mismatch: n_in %d in0 %d out %d ws %zu (need >= %zu); nothing launched\n", n_in, n_in > 0 ? in_sizes[0] : -1, out_size, ws_size, (size_t)WS_END); grid = -1; return; }
        int dev = 0, cus = 0, per_cu = 0;
        if (hipGetDevice(&dev) != hipSuccess || hipDeviceGetAttribute(&cus, hipDeviceAttributeMultiprocessorCount, dev) != hipSuccess) { fprintf(stderr, "kernel_launch: device query failed\n"); grid = -1; return; }
        if (hipFuncSetAttribute((const void*)fwd, hipFuncAttributeMaxDynamicSharedMemorySize, LDS_BYTES) != hipSuccess) { fprintf(stderr, "kernel_launch: hipFuncSetAttribute failed\n"); grid = -1; return; }
        if (hipOccupancyMaxActiveBlocksPerMultiprocessor(&per_cu, (const void*)fwd, NWAVES * 64, LDS_BYTES) != hipSuccess || per_cu < 1)
            fprintf(stderr, "kernel_launch: note: occupancy query reports %d workgroups per CU\n", per_cu);
        (void)hipGetLastError();
        grid = cus;
    }
    if (grid < 0) return;
    if (hipMemsetAsync((char*)d_ws + WS_CTL, 0, CTL_ZERO_BYTES, stream) != hipSuccess) { fprintf(stderr, "kernel_launch: memset failed\n"); return; }
    Args a{};
    for (int i = 0; i < 16; ++i) a.in[i] = (const float*)d_in[i];
    a.out = (float*)d_out; a.ws = (unsigned char*)d_ws;
    const int nl = (N_LAUNCHES == PER_PHASE) ? PER_PHASE : 1;
    for (int li = 0; li < nl; ++li) {
        a.ph_lo = (N_LAUNCHES == PER_PHASE) ? li : 0; a.ph_hi = (N_LAUNCHES == PER_PHASE) ? li + 1 : PER_PHASE;
        hipLaunchKernelGGL(fwd, dim3(grid), dim3(NWAVES * 64), LDS_BYTES, stream, a);
        const hipError_t le = hipPeekAtLastError();
        if (le != hipSuccess) { fprintf(stderr, "kernel_launch: launch %d failed: %s\n", li, hipGetErrorName(le)); break; }
    }
}
```

```cpp
#include <hip/hip_runtime.h>
#include <cstdio>
#include <cstdint>

#ifndef MK_N_LAUNCHES
#define MK_N_LAUNCHES 1
#endif
constexpr int N_LAUNCHES = MK_N_LAUNCHES;
constexpr int PER_PHASE = 6;

constexpr int DM = 4096, MP = 16384, NSB = 32, NST = 32, MS = NSB * NST, MT = MP + MS;
constexpr int LDK = DM + 64;
constexpr int NIN = 16384, DC = 2048, DA = 2048, NH = 16, HD = 128;
constexpr int KROWS = MT;
constexpr float NORM_EPS = 1e-6f;
constexpr float LOG2E = 1.4426950408889634f;
constexpr float QSCALE = 0.08838834764831845f * LOG2E;
constexpr size_t O_YP = 0, O_YS = (size_t)MP * DM, O_KP = O_YS + (size_t)MS * DM, O_VP = O_KP + 512 * 2048, O_CP = O_VP + 512 * 2048, O_KS = O_CP + 2 * 2048,
                 O_VS = O_KS + (size_t)MS * 2048, O_CS = O_VS + (size_t)MS * 2048, O_END = O_CS + (size_t)NSB * 2 * 2048;
static_assert(O_END == 77729792, "output size");

namespace pg8 {
#define PG8_LAS __attribute__((address_space(3)))
typedef unsigned short bf16_t;
typedef short bf16x8 __attribute__((ext_vector_type(8)));
typedef float f32x4 __attribute__((ext_vector_type(4)));
typedef unsigned u32x4 __attribute__((ext_vector_type(4)));
constexpr int BM = 256, BK = 64, HALF = 128, HTB = HALF * BK * 2  , STAGE_BYTES = 8 * HTB, NXCD = 8, WGM = 8;

__host__ __device__ __forceinline__ int lds_byte(int r, int c) { const int st = (r >> 4) * 2 + (c >> 5), rr = r & 15, cc = c & 31, ob = rr * 64 + cc * 2; return st * 1024 + (ob ^ (((ob >> 9) & 1) << 5)); }
__host__ __device__ __forceinline__ void stage_rc(int b, int& R, int& C) { const int st = b / 1024, sb = b % 1024, swz = sb ^ (((sb >> 9) & 1) << 5); R = (st >> 1) * 16 + swz / 64; C = (st & 1) * 32 + (swz % 64) / 2; }
__host__ __device__ __forceinline__ int perm32(int rho) { const int n = rho >> 4, i = rho & 15; return 8 * (i >> 2) + 4 * n + (i & 3); }

struct Unit { int pm, pn, kb, nt, part; };
struct Gemm { const bf16_t* A; const bf16_t* Bt; int M, N, K, ld;
#if defined(PROBE_GEMM)
    int probe;
#endif
};

struct StaticOrder {
    int nM, nN, nwg, G, c, nK;
#if defined(PROBE_HOT)
    int hot;
#endif
    __host__ __device__ void init(int M, int N, int K, int G_, int c_) { nM = M / BM; nN = N / BM; nK = K / BK; nwg = nM * nN; G = G_; c = c_;
#if defined(PROBE_HOT)
        hot = 0;
#endif
    }
    __host__ __device__ bool next(int i, Unit& u) const {
        const long L = (long)i * G + c; if (L >= nwg) return false;
#if defined(PROBE_HOT)
        if (hot) { const int l = c >> 3; u.pm = l & 7; u.pn = (l >> 3) + PROBE_HOT - 1; return true; }
#endif
        int wgid = (int)L; { const int q = nwg / NXCD, r = nwg % NXCD, xcd = wgid % NXCD, off = wgid / NXCD; wgid = (xcd < r ? xcd * (q + 1) : r * (q + 1) + (xcd - r) * q) + off; }
        const int nig = WGM * nN, gid = wgid / nig, fm = gid * WGM, gsz = (nM - fm) < WGM ? (nM - fm) : WGM;
        u.pm = fm + ((wgid % nig) % gsz); u.pn = (wgid % nig) / gsz; u.kb = 0; u.nt = nK; u.part = -1; return true;
    }
    __device__ __forceinline__ void a_ready(const Unit&) const {}
    __device__ __forceinline__ void done(const Unit&) const {}
};
__device__ __forceinline__ unsigned cvt_pk_bf16(float lo, float hi) { unsigned r; asm volatile("v_cvt_pk_bf16_f32 %0, %1, %2" : "=v"(r) : "v"(lo), "v"(hi)); return r; }
typedef float f32x2 __attribute__((ext_vector_type(2)));
__device__ __forceinline__ float silu_f(float x) { return x * __builtin_amdgcn_rcpf(1.0f + __builtin_amdgcn_exp2f(-1.4426950408889634f * x)); }
__device__ __forceinline__ f32x4 silu4(f32x4 v) { f32x4 r; r[0] = silu_f(v[0]); r[1] = silu_f(v[1]); r[2] = silu_f(v[2]); r[3] = silu_f(v[3]); return r; }
__device__ __forceinline__ u32x4 pack8(f32x4 v0, f32x4 v1) { u32x4 w; w.x = cvt_pk_bf16(v0[0], v0[1]); w.y = cvt_pk_bf16(v0[2], v0[3]); w.z = cvt_pk_bf16(v1[0], v1[1]); w.w = cvt_pk_bf16(v1[2], v1[3]); return w; }
__device__ __forceinline__ int krow_of(int row) { return row; }

struct EpiIn {
    static constexpr bool PERM = true, AFTER_DRAIN = false;
    bf16_t *U, *G, *Q, *SZ, *KA, *VA; float* out;
    __device__ __forceinline__ void operator()(const f32x4 (&acc)[2][2][4][2], const Unit& u, int wr, int wc, int fr, int fq) const {
        const int pn = u.pn, row0 = u.pm * BM + wr * 64 + fr;
        if (pn < 32) {
            const int col = (pn & 15) * 128 + wc * 32 + 8 * fq;
            if (pn < 16) {
#pragma unroll
                for (int ai = 0; ai < 2; ++ai)
#pragma unroll
                    for (int m = 0; m < 4; ++m) { const int row = row0 + ai * HALF + m * 16;
                        const f32x4 v0 = acc[ai][0][m][0] * acc[ai][1][m][0], v1 = acc[ai][0][m][1] * acc[ai][1][m][1];
                        *(u32x4*)(U + (size_t)row * DC + col) = pack8(v0, v1);
                        if (u.pm >= 63) { long o = -1;
                            if (row >= MP) { const int t = row & 31; if (t >= 30) o = (long)O_CS + (long)((((row - MP) >> 5) * 2 + (t - 30)) * 2048); }
                            else if (row >= MP - 2) o = (long)O_CP + (long)((row - (MP - 2)) * 2048);
                            if (o >= 0) { *(f32x4*)(out + o + col) = v0; *(f32x4*)(out + o + col + 4) = v1; } } }
            } else {
#pragma unroll
                for (int ai = 0; ai < 2; ++ai)
#pragma unroll
                    for (int m = 0; m < 4; ++m) { const int row = row0 + ai * HALF + m * 16;
                        const f32x4 v0 = acc[ai][0][m][0] * silu4(acc[ai][1][m][0]), v1 = acc[ai][0][m][1] * silu4(acc[ai][1][m][1]);
                        *(u32x4*)(G + (size_t)row * DC + col) = pack8(v0, v1); }
            }
        } else {
            const int part = (pn - 32) >> 3, colp = ((pn - 32) & 7) * 256 + wc * 32 + 8 * fq;
            if (part == 0) {
#pragma unroll
                for (int ai = 0; ai < 2; ++ai)
#pragma unroll
                    for (int m = 0; m < 4; ++m) { const int row = row0 + ai * HALF + m * 16;
#pragma unroll
                        for (int bj = 0; bj < 2; ++bj) *(u32x4*)(Q + (size_t)row * DA + colp + bj * HALF) = pack8(acc[ai][bj][m][0] * QSCALE, acc[ai][bj][m][1] * QSCALE); }
            } else if (part == 3) {
#pragma unroll
                for (int ai = 0; ai < 2; ++ai)
#pragma unroll
                    for (int m = 0; m < 4; ++m) { const int row = row0 + ai * HALF + m * 16;
#pragma unroll
                        for (int bj = 0; bj < 2; ++bj) *(u32x4*)(SZ + (size_t)row * DA + colp + bj * HALF) = pack8(silu4(acc[ai][bj][m][0]), silu4(acc[ai][bj][m][1])); }
            } else {
                bf16_t* dst = part == 1 ? KA : VA;
                float* odp = out + (part == 1 ? O_KP : O_VP); float* ods = out + (part == 1 ? O_KS : O_VS);
#pragma unroll
                for (int ai = 0; ai < 2; ++ai)
#pragma unroll
                    for (int m = 0; m < 4; ++m) { const int row = row0 + ai * HALF + m * 16; const size_t kr = (size_t)krow_of(row);
#pragma unroll
                        for (int bj = 0; bj < 2; ++bj) { *(u32x4*)(dst + kr * DA + colp + bj * HALF) = pack8(acc[ai][bj][m][0], acc[ai][bj][m][1]);
                            if (u.pm >= 62) { float* o = row >= MP ? ods + (size_t)(row - MP) * DA : odp + (size_t)(row - (MP - 512)) * DA;
                                *(f32x4*)(o + colp + bj * HALF) = acc[ai][bj][m][0]; *(f32x4*)(o + colp + bj * HALF + 4) = acc[ai][bj][m][1]; } } }
            }
        }
    }
};
struct EpiOut {
    static constexpr bool PERM = true, AFTER_DRAIN = false;
    const float* gate; bf16_t* XN; float* PART;
    __device__ __forceinline__ void operator()(const f32x4 (&acc)[2][2][4][2], const Unit& u, int wr, int wc, int fr, int fq) const {
        const int row0 = u.pm * BM + wr * 64 + fr, col = u.pn * BM + wc * 32 + 8 * fq;
        if (u.part >= 0) {
            float* pb = PART + (size_t)u.part * MS * DM;
#pragma unroll
            for (int ai = 0; ai < 2; ++ai)
#pragma unroll
                for (int m = 0; m < 4; ++m) { float* pr = pb + (size_t)(row0 + ai * HALF + m * 16 - MP) * DM + col;
#pragma unroll
                    for (int bj = 0; bj < 2; ++bj) { *(f32x4*)(pr + bj * HALF) = acc[ai][bj][m][0]; *(f32x4*)(pr + bj * HALF + 4) = acc[ai][bj][m][1]; } }
            return;
        }
        if (u.pm < MP / BM) {
            f32x4 g[2][2];
#pragma unroll
            for (int bj = 0; bj < 2; ++bj) { g[bj][0] = *(const f32x4*)(gate + col + bj * HALF); g[bj][1] = *(const f32x4*)(gate + col + bj * HALF + 4); }
#pragma unroll
            for (int ai = 0; ai < 2; ++ai)
#pragma unroll
                for (int m = 0; m < 4; ++m) { bf16_t* yr = XN + (size_t)(row0 + ai * HALF + m * 16) * DM + col;
#pragma unroll
                    for (int bj = 0; bj < 2; ++bj) *(u32x4*)(yr + bj * HALF) = pack8(g[bj][0] * acc[ai][bj][m][0], g[bj][1] * acc[ai][bj][m][1]); }
        } else {
#pragma unroll
            for (int ai = 0; ai < 2; ++ai)
#pragma unroll
                for (int m = 0; m < 4; ++m) { const int row = row0 + ai * HALF + m * 16; const float* gr = gate + (size_t)(1 + ((row - MP) >> 5)) * DM + col; bf16_t* yr = XN + (size_t)row * DM + col;
#pragma unroll
                    for (int bj = 0; bj < 2; ++bj) *(u32x4*)(yr + bj * HALF) = pack8(*(const f32x4*)(gr + bj * HALF) * acc[ai][bj][m][0], *(const f32x4*)(gr + bj * HALF + 4) * acc[ai][bj][m][1]); }
        }
    }
};
template <int XM, int XN, int RM, int RN, bool MFIRST> struct GridOrderT {
    static_assert(XM * XN == 8 && RM * RN == 32, "GridOrderT geometry");
    int nM, nN, nK, c;
    __device__ void init(int M, int N, int K, int c_) { nM = M / BM; nN = N / BM; nK = K / BK; c = c_; }
    __device__ bool next(int i, Unit& u) const {
        constexpr int BMc = XM * RM, BNc = XN * RN;
        const int x = c & 7, k = c >> 3, nq = nN / BNc, ng = (nM & ~15) / BMc, full = ng * nq;
        u.kb = 0; u.nt = nK; u.part = -1;
        if (i < full) { const int g = MFIRST ? i % ng : i / nq, q = MFIRST ? i / ng : i % nq;
            u.pm = BMc * g + RM * (x / XN) + (k % RM); u.pn = BNc * q + RN * (x % XN) + (k / RM); return true; }
        if (i == full && (nM & 15) == 4 && nN == 64) { u.pm = (nM & ~15) + (k & 3); u.pn = 8 * x + (k >> 2); return true; }
        return false;
    }
    __device__ __forceinline__ void a_ready(const Unit&) const {}
    __device__ __forceinline__ void done(const Unit&) const {}
};
typedef GridOrderT<4, 2, 4, 8, false> GridOrder;
#ifndef G1_ORDER
#define G1_ORDER GridOrderT<2, 4, 4, 8, false>
#endif
struct TailSplitOrder {
    GridOrder so; int c;
    __device__ void init(int G, int c_) { so.init(MP, DM, DM, c_); c = c_; (void)G; }
    __device__ bool next(int i, Unit& u) const {
        if (i < 4) return so.next(i, u);
        if (i > 4) return false;
        const int kq = c & 3, r = c >> 2; u.pm = MP / BM + (r & 3); u.pn = r >> 2; u.kb = kq * (DM / 4) * 2; u.nt = DM / 4 / BK; u.part = kq; return true;
    }
    __device__ __forceinline__ void a_ready(const Unit&) const {}
    __device__ __forceinline__ void done(const Unit&) const {}
};
template <class Epi, class Sched, bool ALIGN_EPI = false, bool SP2 = false>
__device__ __forceinline__ void gemm_phase(PG8_LAS unsigned char* lds, const Gemm g, const Sched& S, const Epi& E) {
    int tid_ = threadIdx.x; asm volatile("" : "+v"(tid_));
    const int tid = tid_, wid = __builtin_amdgcn_readfirstlane(tid >> 6), lane = tid & 63, wr = wid >> 2, wc = wid & 3, fr = lane & 15, fq = lane >> 4;
    const int LD = g.ld;
    unsigned voffA[2], voffB[2];
#pragma unroll
    for (int i = 0; i < 2; ++i) { int R, C; stage_rc(tid * 16 + i * 8192, R, C); const int Rb = Epi::PERM ? ((R & ~31) + perm32(R & 31)) : R;
        voffA[i] = (unsigned)(R * LD + C) * 2u; voffB[i] = (unsigned)(Rb * LD + C) * 2u; }
    const size_t kstep = (size_t)(BK * 2);
    const size_t hstep = (size_t)HALF * LD * 2;
    const size_t tstep = 2 * hstep;
    const unsigned ldsw = (unsigned)wid * 1024u;
    const int aoff = lds_byte(wr * 64 + fr, fq * 8), boff = lds_byte(wc * 32 + fr, fq * 8);
#define PG8_SA(b, h) (((b) * 2 + (h)) * HTB)
#define PG8_SB(b, h) ((4 + (b) * 2 + (h)) * HTB)
#if defined(PROBE_GEMM)
    const int pf = g.probe;
#define PG8_PF(b) if (!(pf & (b)))
#else
#define PG8_PF(b)
#endif
#define PG8_STAGE(bufoff, gbase, voff) do { PG8_PF(2) _Pragma("unroll") for (int _i = 0; _i < 2; ++_i) \
        __builtin_amdgcn_global_load_lds((const unsigned*)((const char*)(gbase) + (voff)[_i]), (PG8_LAS unsigned*)(lds + (bufoff) + ldsw + _i * 8192), 16, 0, 0); } while (0)
#define PG8_LDA(dst, b, h) do { _Pragma("unroll") for (int m = 0; m < 4; ++m) _Pragma("unroll") for (int k = 0; k < 2; ++k) dst[m][k] = *(const PG8_LAS bf16x8*)(lds + PG8_SA(b, h) + aoff + m * 2048 + k * 1024); } while (0)
#define PG8_LDB(dst, b, h) do { _Pragma("unroll") for (int n = 0; n < 2; ++n) _Pragma("unroll") for (int k = 0; k < 2; ++k) dst[n][k] = *(const PG8_LAS bf16x8*)(lds + PG8_SB(b, h) + boff + n * 2048 + k * 1024); } while (0)
#define PG8_MMA(ai, bj, At, Bt) do { __builtin_amdgcn_s_setprio(1); PG8_PF(1) _Pragma("unroll") for (int m = 0; m < 4; ++m) _Pragma("unroll") for (int n = 0; n < 2; ++n) _Pragma("unroll") for (int k = 0; k < 2; ++k) \
        acc[ai][bj][m][n] = __builtin_amdgcn_mfma_f32_16x16x32_bf16(Bt[n][k], At[m][k], acc[ai][bj][m][n], 0, 0, 0); __builtin_amdgcn_s_setprio(0); } while (0)
#define PG8_WAIT_V(n) asm volatile("s_waitcnt vmcnt(" #n ")" ::: "memory")
#define PG8_WAIT_L(n) asm volatile("s_waitcnt lgkmcnt(" #n ")" ::: "memory")
#define PG8_BAR __builtin_amdgcn_s_barrier()
#define PG8_SCHED __builtin_amdgcn_sched_barrier(0)
    Unit cur, nxt; int ui = 0;
    if (!S.next(0, cur)) return;
    f32x4 acc[2][2][4][2];
#pragma unroll
    for (int a = 0; a < 2; ++a)
#pragma unroll
        for (int b = 0; b < 2; ++b)
#pragma unroll
            for (int m = 0; m < 4; ++m)
#pragma unroll
                for (int n = 0; n < 2; ++n) acc[a][b][m][n] = (f32x4){0.f, 0.f, 0.f, 0.f};
    bf16x8 At[4][2], B0[2][2], B1[2][2];
    const char* cA = (const char*)g.A + (size_t)cur.pm * tstep + cur.kb; const char* cB = (const char*)g.Bt + (size_t)cur.pn * tstep + cur.kb;
    S.a_ready(cur);
    if constexpr (SP2) {
        PG8_STAGE(PG8_SB(0, 0), cB, voffB); PG8_STAGE(PG8_SB(0, 1), cB + hstep, voffB); PG8_STAGE(PG8_SA(0, 0), cA, voffA); PG8_STAGE(PG8_SA(0, 1), cA + hstep, voffA);
        if (wr == 1) PG8_BAR;
        PG8_WAIT_V(2); PG8_BAR;
        PG8_STAGE(PG8_SB(1, 0), cB + kstep, voffB); PG8_STAGE(PG8_SA(1, 0), cA + kstep, voffA); PG8_STAGE(PG8_SB(1, 1), cB + hstep + kstep, voffB);
        PG8_WAIT_V(6); PG8_BAR;
    } else {
        PG8_STAGE(PG8_SB(0, 0), cB, voffB); PG8_STAGE(PG8_SA(0, 0), cA, voffA); PG8_STAGE(PG8_SB(0, 1), cB + hstep, voffB); PG8_STAGE(PG8_SA(0, 1), cA + hstep, voffA);
        if (wr == 1) PG8_BAR;
        PG8_WAIT_V(4); PG8_BAR;
        PG8_STAGE(PG8_SB(1, 0), cB + kstep, voffB); PG8_STAGE(PG8_SA(1, 0), cA + kstep, voffA); PG8_STAGE(PG8_SB(1, 1), cB + hstep + kstep, voffB);
        PG8_WAIT_V(6); PG8_BAR;
    }
    for (;;) {
        const bool has_next = S.next(ui + 1, nxt);
        const char* nA = has_next ? (const char*)g.A + (size_t)nxt.pm * tstep + nxt.kb : cA; const char* nB = has_next ? (const char*)g.Bt + (size_t)nxt.pn * tstep + nxt.kb : cB;
        const int nt = cur.nt;
        for (int t = 0; t < nt; t += 2) {
            const bool last = (t == nt - 2);
            const char* a1 = cA + (size_t)(t + 1) * kstep;
            const char* a2 = last ? nA : cA + (size_t)(t + 2) * kstep; const char* b2 = last ? nB : cB + (size_t)(t + 2) * kstep;
            const char* a3 = a2 + kstep; const char* b3 = b2 + kstep;
            if (last && has_next) S.a_ready(nxt);
            if constexpr (SP2) {
            PG8_LDB(B0, 0, 0); PG8_LDB(B1, 0, 1); PG8_SCHED; PG8_LDA(At, 0, 0); PG8_STAGE(PG8_SA(1, 1), a1 + hstep, voffA);
            PG8_WAIT_V(8); PG8_WAIT_L(0); PG8_BAR; PG8_MMA(0, 0, At, B0); PG8_MMA(0, 1, At, B1); PG8_BAR; PG8_SCHED;
            PG8_LDA(At, 0, 1); PG8_STAGE(PG8_SB(0, 0), b2, voffB); PG8_STAGE(PG8_SB(0, 1), b2 + hstep, voffB); PG8_STAGE(PG8_SA(0, 0), a2, voffA);
            PG8_WAIT_V(8); PG8_WAIT_L(0); PG8_BAR; PG8_MMA(1, 0, At, B0); PG8_MMA(1, 1, At, B1); PG8_BAR; PG8_SCHED;
            PG8_LDB(B0, 1, 0); PG8_LDB(B1, 1, 1); PG8_SCHED; PG8_LDA(At, 1, 0); PG8_STAGE(PG8_SA(0, 1), a2 + hstep, voffA);
            PG8_WAIT_V(8); PG8_WAIT_L(0); PG8_BAR; PG8_MMA(0, 0, At, B0); PG8_MMA(0, 1, At, B1); PG8_BAR; PG8_SCHED;
            PG8_LDA(At, 1, 1); PG8_STAGE(PG8_SB(1, 0), b3, voffB); PG8_STAGE(PG8_SB(1, 1), b3 + hstep, voffB); PG8_STAGE(PG8_SA(1, 0), a3, voffA);
            PG8_WAIT_V(8); PG8_WAIT_L(0); PG8_BAR; PG8_MMA(1, 0, At, B0); PG8_MMA(1, 1, At, B1); PG8_BAR; PG8_SCHED;
            } else {
            PG8_LDB(B0, 0, 0); PG8_SCHED; PG8_LDA(At, 0, 0); PG8_STAGE(PG8_SA(1, 1), a1 + hstep, voffA);
            PG8_WAIT_L(8); PG8_BAR; PG8_WAIT_L(0); PG8_MMA(0, 0, At, B0); PG8_BAR; PG8_SCHED;
            PG8_LDB(B1, 0, 1); PG8_STAGE(PG8_SB(0, 0), b2, voffB);
            PG8_BAR; PG8_WAIT_L(0); PG8_MMA(0, 1, At, B1); PG8_BAR;
            PG8_LDA(At, 0, 1); PG8_STAGE(PG8_SA(0, 0), a2, voffA);
            PG8_BAR; PG8_WAIT_L(0); PG8_MMA(1, 0, At, B0); PG8_BAR; PG8_SCHED;
            PG8_STAGE(PG8_SB(0, 1), b2 + hstep, voffB);
            PG8_WAIT_V(6); PG8_BAR; PG8_MMA(1, 1, At, B1); PG8_BAR;
            PG8_LDB(B0, 1, 0); PG8_SCHED; PG8_LDA(At, 1, 0); PG8_STAGE(PG8_SA(0, 1), a2 + hstep, voffA);
            PG8_WAIT_L(8); PG8_BAR; PG8_WAIT_L(0); PG8_MMA(0, 0, At, B0); PG8_BAR; PG8_SCHED;
            PG8_LDB(B1, 1, 1); PG8_STAGE(PG8_SB(1, 0), b3, voffB);
            PG8_BAR; PG8_WAIT_L(0); PG8_MMA(0, 1, At, B1); PG8_BAR;
            PG8_LDA(At, 1, 1); PG8_STAGE(PG8_SA(1, 0), a3, voffA);
            PG8_BAR; PG8_WAIT_L(0); PG8_MMA(1, 0, At, B0); PG8_BAR; PG8_SCHED;
            PG8_STAGE(PG8_SB(1, 1), b3 + hstep, voffB);
            PG8_WAIT_V(6); PG8_BAR; PG8_MMA(1, 1, At, B1); PG8_BAR;
            }
        }
        if constexpr (ALIGN_EPI) { if (wr == 0) PG8_BAR; }
        if constexpr (!Epi::AFTER_DRAIN) { PG8_PF(8) E(acc, cur, wr, wc, fr, fq); S.done(cur); }
        if (!has_next) break;
#pragma unroll
        for (int a = 0; a < 2; ++a)
#pragma unroll
            for (int b = 0; b < 2; ++b)
#pragma unroll
                for (int m = 0; m < 4; ++m)
#pragma unroll
                    for (int n = 0; n < 2; ++n) acc[a][b][m][n] = (f32x4){0.f, 0.f, 0.f, 0.f};
        cur = nxt; cA = nA; cB = nB; ++ui;
        if constexpr (ALIGN_EPI) { if (wr == 1) PG8_BAR; }
    }
    PG8_WAIT_V(0);
    if constexpr (!ALIGN_EPI) { if (wr == 0) PG8_BAR; }
    PG8_BAR;
    if constexpr (Epi::AFTER_DRAIN) { E.fused(acc, cur, wr, wc, fr, fq, lds, wid, lane); S.done(cur); }
#undef PG8_SA
#undef PG8_SB
#undef PG8_STAGE
#undef PG8_LDA
#undef PG8_LDB
#undef PG8_MMA
#undef PG8_WAIT_V
#undef PG8_WAIT_L
#undef PG8_BAR
#undef PG8_SCHED
}
}

#ifndef PG8_SP2
#define PG8_SP2 true
#endif
#ifndef PG8_ALIGN
#define PG8_ALIGN true
#endif
constexpr size_t MiB = 1u << 20;
constexpr size_t WS_CTL = 0, CTL_ZERO_BYTES = 32768;
constexpr size_t WS_MOD = 2 * MiB;
constexpr size_t MOD_STRIDE = (size_t)33 * DM * 4;
constexpr size_t WS_WT2 = 4 * MiB;
constexpr size_t WS_WT1 = 38 * MiB;
constexpr size_t WS_H = 170 * MiB;
constexpr size_t WS_U = 310 * MiB, WS_G = 378 * MiB, WS_Q = 446 * MiB, WS_SZ = 514 * MiB;
constexpr size_t WS_KA = 582 * MiB, WS_VA = 718 * MiB, WS_END = 854 * MiB;
static_assert(WS_WT2 + (size_t)DM * LDK * 2 <= WS_WT1 && WS_WT1 + (size_t)NIN * LDK * 2 <= WS_H, "d_ws map (weights)");
static_assert(WS_MOD + 3 * MOD_STRIDE <= WS_WT2 && WS_H + (size_t)MT * LDK * 2 <= WS_U && WS_U + (size_t)MT * DC * 2 <= WS_G && WS_KA + (size_t)KROWS * DA * 2 <= WS_VA && WS_VA + (size_t)KROWS * DA * 2 <= WS_END, "d_ws map");
constexpr size_t WS_XN = WS_U;
constexpr size_t WS_PART = WS_Q;
static_assert(WS_XN + (size_t)MT * DM * 2 <= WS_Q && WS_PART + (size_t)4 * MS * DM * 4 <= WS_SZ, "d_ws overlays");
constexpr int CW_TMO = 0, CW_BAR = 4096;
constexpr int RING_OFF = 0, RING_BYTES = 131072;
constexpr int LDSCTL_OFF = RING_BYTES, MISC_OFF = LDSCTL_OFF + 320;
constexpr int LDS_BYTES = 147456;
constexpr int NWAVES = 8;

#define GAS __attribute__((address_space(1)))
#define LAS __attribute__((address_space(3)))
typedef unsigned short bf16;
typedef unsigned v4u __attribute__((ext_vector_type(4)));
typedef unsigned v2u __attribute__((ext_vector_type(2)));
typedef float f32x4 __attribute__((ext_vector_type(4)));
typedef float f32x16 __attribute__((ext_vector_type(16)));
typedef short bf16x8 __attribute__((ext_vector_type(8)));
typedef short s16x4 __attribute__((ext_vector_type(4)));
typedef GAS unsigned gu32;
#define RLX_AGENT __ATOMIC_RELAXED, __HIP_MEMORY_SCOPE_AGENT
#define LDS_WAIT() asm volatile("s_waitcnt lgkmcnt(0)" ::: "memory")
#define VM_WAIT() asm volatile("s_waitcnt vmcnt(0)" ::: "memory")
__device__ __forceinline__ unsigned cvtpk(float lo, float hi) { unsigned r; asm volatile("v_cvt_pk_bf16_f32 %0, %1, %2" : "=v"(r) : "v"(lo), "v"(hi)); return r; }
__device__ __forceinline__ float bf2f(unsigned short b) { return __uint_as_float(((unsigned)b) << 16); }
__device__ __forceinline__ float wave_sum(float v) {
#pragma unroll
    for (int o = 1; o < 64; o <<= 1) v += __shfl_xor(v, o);
    return v;
}
#define XB_TMO      128
#define XB_XCNT(j)  (256  + 64 * (j))
#define XB_XSUB(j)  (1280 + 64 * (j))
#define XB_XGEN(j)  (2304 + 64 * (j))
#define XB_TOP      3328
#define XB_TOPGEN   3392
#define XCD_BAR_WORDS 3456
#define XB_SPIN_CAP (1u << 18)

__device__ __forceinline__ unsigned xb_ld(unsigned* p)              { return __hip_atomic_load(p, __ATOMIC_RELAXED, __HIP_MEMORY_SCOPE_AGENT); }
__device__ __forceinline__ unsigned xb_add(unsigned* p, unsigned v) { return __hip_atomic_fetch_add(p, v, __ATOMIC_RELAXED, __HIP_MEMORY_SCOPE_AGENT); }
__device__ __forceinline__ unsigned xb_xcc_id() { return (unsigned)__builtin_amdgcn_s_getreg((3 << 11) | 20) & 0xFu; }
#define XB_SPIN(cond, bar) do { unsigned _sp = 0; while (cond) { __builtin_amdgcn_s_sleep(1); \
    if ((++_sp & 255u) == 0u) { if (xb_ld(&(bar)[XB_TMO])) break; if (_sp > XB_SPIN_CAP) { atomicAdd(&(bar)[XB_TMO], 1u); break; } } } } while (0)

struct XcdBarrier {
    unsigned* bar; unsigned x;
    volatile LAS unsigned* st;
};

__device__ __forceinline__ XcdBarrier xcd_barrier_post(unsigned* bar, volatile LAS unsigned* st) {
    XcdBarrier b; b.bar = bar; b.x = xb_xcc_id(); b.st = st;
    if (threadIdx.x == 0) (void)xb_add(&bar[XB_XCNT(b.x)], 1u);
    return b;
}
__device__ __forceinline__ void xcd_barrier_complete(unsigned* bar, unsigned x, unsigned& nloc, unsigned& nx) {
    const unsigned G = gridDim.x * gridDim.y * gridDim.z;
    unsigned sum, cnt, mine, sp = 0u;
    for (;;) {
        sum = 0u; cnt = 0u; mine = 0u;
#pragma unroll
        for (unsigned j = 0; j < 16; ++j) { const unsigned c = xb_ld(&bar[XB_XCNT(j)]); sum += c; cnt += (c > 0u) ? 1u : 0u; mine = (j == x) ? c : mine; }
        if (sum == G) break;
        __builtin_amdgcn_s_sleep(1);
        if ((++sp & 255u) == 0u) { if (xb_ld(&bar[XB_TMO])) break; if (sp > XB_SPIN_CAP) { atomicAdd(&bar[XB_TMO], 1u); break; } }
    }
    nloc = mine > 0u ? mine : 1u; nx = cnt > 0u ? cnt : 1u;
}

__device__ __forceinline__ void xcd_barrier(const XcdBarrier& b) {
    asm volatile("s_waitcnt vmcnt(0)" ::: "memory");
    __syncthreads();
    if (threadIdx.x == 0) {
        unsigned* bar = b.bar;
        __builtin_amdgcn_s_waitcnt(0);
        unsigned nloc = b.st[0], nx = b.st[1];
        if (nloc == 0u) { xcd_barrier_complete(bar, b.x, nloc, nx); b.st[0] = nloc; b.st[1] = nx; }
        const unsigned old = xb_add(&bar[XB_XSUB(b.x)], 1u);
        const unsigned gen = old / nloc;
        if (old + 1u == (gen + 1u) * nloc) {
            __builtin_amdgcn_fence(__ATOMIC_RELEASE, "agent");
            asm volatile("s_waitcnt vmcnt(0)" ::: "memory");
            const unsigned og = xb_add(&bar[XB_TOP], 1u);
            const unsigned tg = og / nx;
            if (og + 1u == (tg + 1u) * nx) xb_add(&bar[XB_TOPGEN], 1u);
            else XB_SPIN(xb_ld(&bar[XB_TOPGEN]) == tg, bar);
            __builtin_amdgcn_fence(__ATOMIC_ACQUIRE, "agent");
            xb_add(&bar[XB_XGEN(b.x)], 1u);
            asm volatile("s_waitcnt vmcnt(0)" ::: "memory");
        } else {
            XB_SPIN(xb_ld(&bar[XB_XGEN(b.x)]) == gen, bar);
            __builtin_amdgcn_fence(__ATOMIC_ACQUIRE, "agent");
            asm volatile("s_waitcnt vmcnt(0)" ::: "memory");
        }
    }
    __syncthreads();
}

struct Frame {
    LAS unsigned char* lds;
    volatile LAS unsigned* MISC;
    gu32* ctl;
    int tid, lane, wave, vcu, G;
    const float *x_prompt, *x_sample, *cache_k, *cache_v, *cache_conv, *c_prompt, *c_sample, *g_norm, *w_ada, *b_ada, *w_in, *conv_w, *conv_b, *rel_bias, *w_out, *g_final;
    float* out;
    float *modA, *modB, *gate;
    bf16 *WT1, *WT2, *H, *MIX, *U, *Gc, *Q, *SZ, *KA, *VA, *XN; float* PART;
};

__device__ __forceinline__ int win_src_col(int np) {
    const int tile = np >> 8, r = np & 255, half = r >> 7, c = r & 127;
    if (tile < 16) return (half ? 4096 : 0) + 128 * tile + c;
    if (tile < 32) return (half ? 6144 : 2048) + 128 * (tile - 16) + c;
    return np;
}
__device__ __forceinline__ void p0_transpose_item(const float* W, int K, int N, bf16* WT, int k0, int src_n0, int dst_n0, LAS float* scr, int lane) {
    const float* wp = W + (size_t)(k0 + (lane >> 3)) * N + src_n0 + 4 * (lane & 7); f32x4 v[8];
#pragma unroll
    for (int i = 0; i < 8; ++i) v[i] = *(const GAS f32x4*)(wp + (size_t)(8 * i) * N);
#pragma unroll
    for (int i = 0; i < 8; ++i) { LAS float* d = scr + (8 * i + (lane >> 3)) * 33 + 4 * (lane & 7); d[0] = v[i][0]; d[1] = v[i][1]; d[2] = v[i][2]; d[3] = v[i][3]; }
    LDS_WAIT(); asm volatile("" ::: "memory");
    const int c = lane & 7;
#pragma unroll
    for (int j = 0; j < 4; ++j) { const int n = (lane >> 3) + 8 * j; const LAS float* s = scr + (8 * c) * 33 + n;
        v4u o; o.x = cvtpk(s[0 * 33], s[1 * 33]); o.y = cvtpk(s[2 * 33], s[3 * 33]); o.z = cvtpk(s[4 * 33], s[5 * 33]); o.w = cvtpk(s[6 * 33], s[7 * 33]);
        *(GAS v4u*)(WT + (size_t)(dst_n0 + n) * LDK + k0 + 8 * c) = o; }
    LDS_WAIT(); asm volatile("" ::: "memory");
}
__device__ __forceinline__ void p0_ada_task(Frame& F, int task) {
    int tid_ = F.tid; asm volatile("" : "+v"(tid_));
    const int n0 = 64 * task, lane = tid_ & 63, w = F.wave, q = lane & 15, r = lane >> 4;
    LAS float* cs = (LAS float*)(F.lds + RING_OFF + w * 8704);
    f32x4 acc[2][4]; float ap[4] = {0.f, 0.f, 0.f, 0.f};
#pragma unroll
    for (int h = 0; h < 2; ++h)
#pragma unroll
        for (int e = 0; e < 4; ++e) acc[h][e] = (f32x4){0.f, 0.f, 0.f, 0.f};
    const float* wbase = F.w_ada + (size_t)r * (3 * DM) + n0 + 4 * q;
#define ADA_LOADW(WV, bt) do { _Pragma("unroll") for (int i = 0; i < 8; ++i) WV[i] = *(const GAS f32x4*)(wbase + (size_t)(512 * w + 32 * (bt) + 4 * i) * (3 * DM)); } while (0)
#define ADA_LOADC(ch) do { const int k0_ = 512 * w + 64 * (ch); _Pragma("unroll") for (int j = 0; j < 8; ++j) { const int idx = j * 64 + lane; \
        cr[j] = *(const GAS f32x4*)(F.c_sample + (size_t)(idx >> 4) * DM + k0_ + 4 * (idx & 15)); } cpr = F.c_prompt[k0_ + lane]; } while (0)
#define ADA_MMA(WV, hb) do { _Pragma("unroll") for (int i = 0; i < 8; ++i) { const int kk = 4 * (8 * (hb) + i) + r; \
        const float a0 = cs[q * 65 + kk], a1 = cs[(q + 16) * 65 + kk], cp = cs[32 * 65 + kk]; \
        _Pragma("unroll") for (int e = 0; e < 4; ++e) { acc[0][e] = __builtin_amdgcn_mfma_f32_16x16x4f32(a0, WV[i][e], acc[0][e], 0, 0, 0); \
            acc[1][e] = __builtin_amdgcn_mfma_f32_16x16x4f32(a1, WV[i][e], acc[1][e], 0, 0, 0); ap[e] = fmaf(cp, WV[i][e], ap[e]); } } } while (0)
    f32x4 wvA[8], wvB[8], cr[8]; float cpr;
    ADA_LOADC(0); ADA_LOADW(wvA, 0);
    for (int ch = 0; ch < 8; ++ch) {
#pragma unroll
        for (int j = 0; j < 8; ++j) { const int idx = j * 64 + lane; LAS float* d = cs + (idx >> 4) * 65 + 4 * (idx & 15); d[0] = cr[j][0]; d[1] = cr[j][1]; d[2] = cr[j][2]; d[3] = cr[j][3]; }
        cs[32 * 65 + lane] = cpr;
        LDS_WAIT(); asm volatile("" ::: "memory");
        if (ch + 1 < 8) ADA_LOADC(ch + 1);
        ADA_LOADW(wvB, 2 * ch + 1);
        ADA_MMA(wvA, 0);
        if (ch + 1 < 8) ADA_LOADW(wvA, 2 * ch + 2);
        ADA_MMA(wvB, 1);
        LDS_WAIT(); asm volatile("" ::: "memory");
    }
#undef ADA_LOADW
#undef ADA_LOADC
#undef ADA_MMA
#pragma unroll
    for (int e = 0; e < 4; ++e) { ap[e] += __shfl_xor(ap[e], 16); ap[e] += __shfl_xor(ap[e], 32); }
#pragma unroll
    for (int h = 0; h < 2; ++h)
#pragma unroll
        for (int e = 0; e < 4; ++e)
#pragma unroll
            for (int i = 0; i < 4; ++i) cs[(16 * h + 4 * r + i) * 64 + 4 * q + e] = acc[h][e][i];
    if (r == 0) {
#pragma unroll
        for (int e = 0; e < 4; ++e) cs[32 * 64 + 4 * q + e] = ap[e]; }
    LDS_WAIT(); __syncthreads();
    for (int idx = F.tid; idx < 33 * 64; idx += NWAVES * 64) {
        float s = 0.f;
#pragma unroll
        for (int qq = 0; qq < 8; ++qq) s += ((LAS float*)(F.lds + RING_OFF + qq * 8704))[idx];
        const int rr = idx >> 6, col = n0 + (idx & 63), bb = (rr == 32) ? 0 : 1 + rr;
        s += F.b_ada[col];
        if (col < DM) F.modB[(size_t)bb * DM + col] = s;
        else if (col < 2 * DM) F.modA[(size_t)bb * DM + col - DM] = F.g_norm[col - DM] * (1.f + s);
        else F.gate[(size_t)bb * DM + col - 2 * DM] = s;
    }
    __syncthreads();
}
__device__ __forceinline__ void p0_prologue(Frame& F, int mode) {
    constexpr int N_ADA = 3 * DM / 64;
    if (mode != 2) for (int t = F.vcu; t < N_ADA; t += F.G) p0_ada_task(F, t);
    if (mode == 1) return;
    LAS float* scr = (LAS float*)(F.lds + RING_OFF + F.wave * 16384);
    int tid_ = F.tid; asm volatile("" : "+v"(tid_));
    const int gw = F.vcu * NWAVES + F.wave, NGW = F.G * NWAVES, lane = tid_ & 63;
    constexpr int I_IN = (DM / 64) * (NIN / 32), I_OUT = (DM / 64) * (DM / 32);
    constexpr int NITEMS = I_IN + I_OUT;
    for (int it = gw; it < NITEMS; it += NGW) {
        int r = it;
        if (r < I_IN) { const int nblk = NIN / 32, kb = r / nblk, nb = r % nblk; p0_transpose_item(F.w_in, DM, NIN, F.WT1, 64 * kb, win_src_col(32 * nb), 32 * nb, scr, lane); continue; } r -= I_IN;
        { const int nblk = DM / 32, kb = r / nblk, nb = r % nblk; p0_transpose_item(F.w_out, DM, DM, F.WT2, 64 * kb, 32 * nb, 32 * nb, scr, lane); }
    }
}
__device__ __forceinline__ void p1_hrows(Frame& F) {
    int tid_ = F.tid; asm volatile("" : "+v"(tid_));
    const int gw = F.vcu * NWAVES + F.wave, NGW = F.G * NWAVES, lane = tid_ & 63;
    f32x4 A[16], B[16]; int cur_bb = -1;
    for (int m = gw; m < MT; m += NGW) {
        const float* xrow = m < MP ? F.x_prompt + (size_t)m * DM : F.x_sample + (size_t)(m - MP) * DM;
        const int bb = m < MP ? 0 : 1 + ((m - MP) >> 5);
        const GAS f32x4* xr = (const GAS f32x4*)xrow + lane;
        f32x4 v[16];
#pragma unroll
        for (int j = 0; j < 16; ++j) v[j] = xr[64 * j];
        if (bb != cur_bb) { cur_bb = bb;
            const GAS f32x4* ar = (const GAS f32x4*)(F.modA + (size_t)bb * DM) + lane; const GAS f32x4* br = (const GAS f32x4*)(F.modB + (size_t)bb * DM) + lane;
#pragma unroll
            for (int j = 0; j < 16; ++j) { A[j] = ar[64 * j]; B[j] = br[64 * j]; } }
        float s = 0.f;
#pragma unroll
        for (int j = 0; j < 16; ++j) s += (v[j].x * v[j].x + v[j].y * v[j].y) + (v[j].z * v[j].z + v[j].w * v[j].w);
        const float rstd = 1.0f / sqrtf(wave_sum(s) * (1.f / DM) + NORM_EPS);
        GAS v2u* o8 = (GAS v2u*)(F.H + (size_t)m * LDK) + lane;
#pragma unroll
        for (int j = 0; j < 16; ++j) { const f32x4 hv = (v[j] * rstd) * A[j] + B[j]; v2u o; o.x = cvtpk(hv.x, hv.y); o.y = cvtpk(hv.z, hv.w); o8[64 * j] = o; }
    }
}
__device__ __forceinline__ void p5_final(Frame& F, bool splitk) {
    int tid_ = F.tid; asm volatile("" : "+v"(tid_));
    const int gw = F.vcu * NWAVES + F.wave, NGW = F.G * NWAVES, lane = tid_ & 63;
    f32x4 gf[16];
#pragma unroll
    for (int j = 0; j < 8; ++j) { gf[2 * j] = *(const GAS f32x4*)(F.g_final + 512 * j + 8 * lane); gf[2 * j + 1] = *(const GAS f32x4*)(F.g_final + 512 * j + 8 * lane + 4); }
    for (int m = gw; m < MT; m += NGW) {
        f32x4 v[16];
        if (m >= MP && splitk) {
            const float* xr = F.x_sample + (size_t)(m - MP) * DM + 8 * lane; const float* gr = F.gate + (size_t)(1 + ((m - MP) >> 5)) * DM + 8 * lane;
            const float* pr = F.PART + (size_t)(m - MP) * DM + 8 * lane;
#pragma unroll
            for (int j = 0; j < 16; ++j) { const int o = 512 * (j >> 1) + 4 * (j & 1);
                const f32x4 p0 = *(const GAS f32x4*)(pr + o), p1 = *(const GAS f32x4*)(pr + (size_t)MS * DM + o), p2 = *(const GAS f32x4*)(pr + (size_t)2 * MS * DM + o), p3 = *(const GAS f32x4*)(pr + (size_t)3 * MS * DM + o);
                v[j] = *(const GAS f32x4*)(xr + o) + *(const GAS f32x4*)(gr + o) * ((p0 + p1) + (p2 + p3)); }
        } else {
            const bf16* xn = F.XN + (size_t)m * DM + 8 * lane; v4u w[8];
            const float* xr = (m < MP ? F.x_prompt + (size_t)m * DM : F.x_sample + (size_t)(m - MP) * DM) + 8 * lane;
#pragma unroll
            for (int j = 0; j < 8; ++j) w[j] = *(const GAS v4u*)(xn + 512 * j);
#pragma unroll
            for (int j = 0; j < 16; ++j) v[j] = *(const GAS f32x4*)(xr + 512 * (j >> 1) + 4 * (j & 1));
#pragma unroll
            for (int j = 0; j < 8; ++j) { v[2 * j] += (f32x4){__uint_as_float(w[j].x << 16), __uint_as_float(w[j].x & 0xffff0000u), __uint_as_float(w[j].y << 16), __uint_as_float(w[j].y & 0xffff0000u)};
                v[2 * j + 1] += (f32x4){__uint_as_float(w[j].z << 16), __uint_as_float(w[j].z & 0xffff0000u), __uint_as_float(w[j].w << 16), __uint_as_float(w[j].w & 0xffff0000u)}; }
        }
        float s = 0.f;
#pragma unroll
        for (int j = 0; j < 16; ++j) s += (v[j].x * v[j].x + v[j].y * v[j].y) + (v[j].z * v[j].z + v[j].w * v[j].w);
        const float rstd = 1.0f / sqrtf(wave_sum(s) * (1.f / DM) + NORM_EPS);
        float* yr = F.out + (size_t)m * DM + 8 * lane;
#pragma unroll
        for (int j = 0; j < 16; ++j) *(GAS f32x4*)(yr + 512 * (j >> 1) + 4 * (j & 1)) = (v[j] * rstd) * gf[j];
    }
}
namespace att {
constexpr int SHM_V = 16384, SHM_K = 16384, OFF_V = 0, OFF_K = 2 * SHM_V, OFF_WS = OFF_K + 2 * SHM_K, OFF_BT = OFF_WS + 8 * 256;
constexpr float THRL = 8.f * 1.4426950408889634f;
#define KSWZ(row, colB) ((row) * 256 + ((colB) ^ (((row) & 7) << 4)))
#define SBAR() __builtin_amdgcn_sched_barrier(0)
__device__ __forceinline__ int crow(int r, int hi) { return (r & 3) + 8 * (r >> 2) + 4 * hi; }
__device__ __forceinline__ int v_st(int k, int c) { const int kk = (k & ~0xC) | ((k & 4) << 1) | ((k & 8) >> 1); return ((kk >> 3) * 4 + (c >> 5)) * 512 + ((kk & 7) * 32 + (c & 31)) * 2; }
__device__ __forceinline__ int v_rd_base(int lane) { return ((lane & 3) << 3) | (((lane >> 2) & 3) << 6) | (((lane >> 4) & 1) << 5) | (((lane >> 5) & 1) << 8); }
constexpr int v_rd_off(int d0, int ks, int half) { return d0 * 512 + ks * 4096 + half * 2048; }
template <int OFF> __device__ __forceinline__ s16x4 tr_read(int vb) { s16x4 r; asm volatile("ds_read_b64_tr_b16 %0, %1 offset:%2" : "=&v"(r) : "v"(vb), "i"(OFF) : "memory"); return r; }
#define PK(L, H) (bf16x8){L[0], L[1], L[2], L[3], H[0], H[1], H[2], H[3]}
#define RD8(D0, X) const s16x4 X##l0 = tr_read<v_rd_off(D0, 0, 0)>(vb), X##h0 = tr_read<v_rd_off(D0, 0, 1)>(vb), X##l1 = tr_read<v_rd_off(D0, 1, 0)>(vb), X##h1 = tr_read<v_rd_off(D0, 1, 1)>(vb), \
                            X##l2 = tr_read<v_rd_off(D0, 2, 0)>(vb), X##h2 = tr_read<v_rd_off(D0, 2, 1)>(vb), X##l3 = tr_read<v_rd_off(D0, 3, 0)>(vb), X##h3 = tr_read<v_rd_off(D0, 3, 1)>(vb)
#define MM4(OD, X) do { OD = __builtin_amdgcn_mfma_f32_32x32x16_bf16(PK(X##l0, X##h0), pa0, OD, 0, 0, 0); OD = __builtin_amdgcn_mfma_f32_32x32x16_bf16(PK(X##l1, X##h1), pa1, OD, 0, 0, 0); \
                        OD = __builtin_amdgcn_mfma_f32_32x32x16_bf16(PK(X##l2, X##h2), pa2, OD, 0, 0, 0); OD = __builtin_amdgcn_mfma_f32_32x32x16_bf16(PK(X##l3, X##h3), pa3, OD, 0, 0, 0); } while (0)
__device__ __forceinline__ void pv_all(f32x16 (&o)[4], int vb, bf16x8 pa0, bf16x8 pa1, bf16x8 pa2, bf16x8 pa3) {
  RD8(0, a); RD8(1, b);
  asm volatile("s_waitcnt lgkmcnt(8)" ::: "memory"); SBAR(); MM4(o[0], a); SBAR();
  RD8(2, c);
  asm volatile("s_waitcnt lgkmcnt(8)" ::: "memory"); SBAR(); MM4(o[1], b); SBAR();
  RD8(3, d);
  asm volatile("s_waitcnt lgkmcnt(8)" ::: "memory"); SBAR(); MM4(o[2], c); SBAR();
  asm volatile("s_waitcnt lgkmcnt(0)" ::: "memory"); SBAR(); MM4(o[3], d);
}
#undef PK
#undef RD8
#undef MM4
struct AUnit { int h, qrow0, krow0, t0, T, ts, sample, probe; };
__device__ __forceinline__ void attn_unit(Frame& F, char* lds, const AUnit u) {
  int tid_ = F.tid; asm volatile("" : "+v"(tid_));
  const int tid = tid_, wid = F.wave, lane = tid & 63, r32 = lane & 31, hi = lane >> 5;
  bf16* V_lds = (bf16*)(lds + OFF_V); bf16* K_lds = (bf16*)(lds + OFF_K);
  float* btab = (float*)(lds + OFF_BT);
  for (int i = tid; i < 640; i += 512) { const int bi = i + 192 < 512 ? i + 192 : 512; btab[i] = F.rel_bias[u.h * 513 + bi] * LOG2E; }
  const bool wact = u.sample ? (wid == 0) : true;
  const int lo = u.sample ? 0 : (wid >> 1), hi_t = lo + 8, ibase = u.sample ? 0 : 32 * (wid & 1);
  const int qrow = u.qrow0 + (u.sample ? 0 : 32 * wid);
  float m_reg = -1e30f, l_reg = 0.f; f32x16 o[4] = {}; bf16x8 qr[8];
  { const bf16* Qw = F.Q + (size_t)(qrow + r32) * DA + u.h * HD + hi * 8;
#pragma unroll
    for (int d0 = 0; d0 < 8; ++d0) qr[d0] = *(const bf16x8*)(Qw + d0 * 16); }
  const int sr = tid >> 4, sc = (tid & 15) * 8, vst0 = v_st(sr, sc), vst1 = v_st(32 + sr, sc);
  const int vb0 = (int)(uintptr_t)V_lds + v_rd_base(lane);
  bf16x8 xv0, xv1, xk0, xk1;
#define SLOAD(S, t) do { const size_t off_ = (size_t)(u.krow0 + 64 * (t) + sr) * DA + u.h * HD + sc; \
    S##v0 = *(const bf16x8*)(F.VA + off_); S##v1 = *(const bf16x8*)(F.VA + off_ + 32 * DA); S##k0 = *(const bf16x8*)(F.KA + off_); S##k1 = *(const bf16x8*)(F.KA + off_ + 32 * DA); } while (0)
#define SWRITE(b, S) do { *(bf16x8*)((char*)V_lds + (b) * SHM_V + vst0) = S##v0; *(bf16x8*)((char*)V_lds + (b) * SHM_V + vst1) = S##v1; const int kc = sc * 2; \
    *(bf16x8*)((char*)K_lds + (b) * SHM_K + KSWZ(sr, kc)) = S##k0; *(bf16x8*)((char*)K_lds + (b) * SHM_K + KSWZ(32 + sr, kc)) = S##k1; } while (0)
#define WGBAR() do { asm volatile("s_waitcnt lgkmcnt(0)" ::: "memory"); __builtin_amdgcn_s_barrier(); asm volatile("" ::: "memory"); } while (0)
  const int ns = u.T - u.t0;
#define TILE_AT(s_) (u.ts + (s_) < u.T ? u.ts + (s_) : u.ts + (s_) - ns)
  SLOAD(x, u.ts); SWRITE(0, x);
#define COMPUTE(t, cur) do { if (wact && (t) >= lo && (t) <= hi_t && !(u.probe & 1)) { \
      const int dt = (t) - lo; f32x16 p0, p1; \
      if (dt <= 3) { const float c = btab[639]; _Pragma("unroll") for (int r = 0; r < 16; ++r) { p0[r] = c; p1[r] = c; } } \
      else { const float* bp = btab + (517 - 64 * dt + ibase + r32 - 4 * hi); \
        _Pragma("unroll") for (int r = 0; r < 16; ++r) { const int kk = (r & 3) + 8 * (r >> 2); p0[r] = bp[59 - kk]; p1[r] = bp[27 - kk]; } } \
      if (u.sample && (t) == 8) { _Pragma("unroll") for (int r = 0; r < 16; ++r) p1[r] = -1e30f; } \
      { const bf16* Ks = (const bf16*)((const char*)K_lds + (cur) * SHM_K); \
        _Pragma("unroll") for (int d0 = 0; d0 < 8; ++d0) { const int cb = (d0 * 16 + hi * 8) * 2; \
          const bf16x8 b0 = *(const bf16x8*)((const char*)Ks + KSWZ(r32, cb)), b1 = *(const bf16x8*)((const char*)Ks + KSWZ(32 + r32, cb)); \
          p0 = __builtin_amdgcn_mfma_f32_32x32x16_bf16(b0, qr[d0], p0, 0, 0, 0); \
          p1 = __builtin_amdgcn_mfma_f32_32x32x16_bf16(b1, qr[d0], p1, 0, 0, 0); } } \
      float pmax = p0[0]; \
      _Pragma("unroll") for (int r = 1; r < 16; ++r) pmax = fmaxf(pmax, p0[r]); \
      _Pragma("unroll") for (int r = 0; r < 16; ++r) pmax = fmaxf(pmax, p1[r]); \
      { auto rr = __builtin_amdgcn_permlane32_swap(__float_as_uint(pmax), __float_as_uint(pmax), false, false); pmax = fmaxf(__uint_as_float(rr[0]), __uint_as_float(rr[1])); } \
      float mn, alpha; \
      if (__all(pmax - m_reg <= THRL)) { mn = m_reg; alpha = 1.f; } \
      else { mn = fmaxf(m_reg, pmax); alpha = __builtin_amdgcn_exp2f(m_reg - mn); m_reg = mn; } \
      float ps = 0.f; \
      _Pragma("unroll") for (int r = 0; r < 16; ++r) { p0[r] = __builtin_amdgcn_exp2f(p0[r] - mn); p1[r] = __builtin_amdgcn_exp2f(p1[r] - mn); ps += p0[r] + p1[r]; } \
      { auto rr = __builtin_amdgcn_permlane32_swap(__float_as_uint(ps), __float_as_uint(ps), false, false); ps = __uint_as_float(rr[0]) + __uint_as_float(rr[1]); } \
      if (__any(alpha < 1.f)) { _Pragma("unroll") for (int d = 0; d < 4; ++d) _Pragma("unroll") for (int r = 0; r < 16; ++r) o[d][r] *= alpha; } \
      l_reg = l_reg * alpha + ps; \
      bf16x8 pa0, pa1, pa2, pa3; \
      PK4(p0, 0, pa0); PK4(p0, 8, pa1); PK4(p1, 0, pa2); PK4(p1, 8, pa3); \
      pv_all(o, vb0 + (cur) * SHM_V, pa0, pa1, pa2, pa3); } } while (0)
#define PK4(P, BASE, OUT) do { unsigned a0 = cvtpk(P[BASE + 0], P[BASE + 1]), a1 = cvtpk(P[BASE + 2], P[BASE + 3]);   \
    unsigned b0 = cvtpk(P[BASE + 4], P[BASE + 5]), b1 = cvtpk(P[BASE + 6], P[BASE + 7]);                              \
    auto r0 = __builtin_amdgcn_permlane32_swap(a0, b0, false, false); auto r1 = __builtin_amdgcn_permlane32_swap(a1, b1, false, false); \
    v4u w_ = {r0[0], r1[0], r0[1], r1[1]}; OUT = *reinterpret_cast<bf16x8*>(&w_); } while (0)
#define STEP(s_, cur) do { WGBAR(); const int t_ = TILE_AT(s_); const bool more_ = (s_) + 1 < ns && !(u.probe & 2); if (more_) SLOAD(x, TILE_AT((s_) + 1)); COMPUTE(t_, cur); if (more_) SWRITE((cur) ^ 1, x); } while (0)
  for (int s = 0; s < ns; s += 2) { STEP(s, 0); if (s + 1 < ns) STEP(s + 1, 1); }
#undef TILE_AT
#undef STEP
#undef PK4
#undef COMPUTE
#undef WGBAR
#undef SLOAD
#undef SWRITE
  if (wact && !(u.probe & 4)) {
    const float rl = __builtin_amdgcn_rcpf(l_reg); const int orow = qrow + r32;
    const bf16* szr = F.SZ + (size_t)orow * DA + u.h * HD + 4 * hi; bf16* mr = F.MIX + (size_t)orow * LDK + DC + u.h * HD + 4 * hi;
    v2u sz[16];
#pragma unroll
    for (int d0 = 0; d0 < 4; ++d0)
#pragma unroll
      for (int g = 0; g < 4; ++g) sz[d0 * 4 + g] = *(const GAS v2u*)(szr + d0 * 32 + g * 8);
#pragma unroll
    for (int d0 = 0; d0 < 4; ++d0)
#pragma unroll
      for (int g = 0; g < 4; ++g) { const v2u z = sz[d0 * 4 + g];
        const float v0 = o[d0][4 * g + 0] * rl * __uint_as_float(z.x << 16), v1 = o[d0][4 * g + 1] * rl * __uint_as_float(z.x & 0xffff0000u);
        const float v2 = o[d0][4 * g + 2] * rl * __uint_as_float(z.y << 16), v3 = o[d0][4 * g + 3] * rl * __uint_as_float(z.y & 0xffff0000u);
        v2u w; w.x = cvtpk(v0, v1); w.y = cvtpk(v2, v3); *(GAS v2u*)(mr + d0 * 32 + g * 8) = w; }
  }
  __syncthreads();
}
}
namespace att {
constexpr int SOFF_ML = RING_BYTES + 1024, SOFF_BT = SOFF_ML + 8 * 256;
static_assert(SOFF_BT + 2 * 2560 <= LDS_BYTES && SOFF_ML >= MISC_OFF + 128, "sample attention LDS map");
__device__ __forceinline__ void sample_pairs(Frame& F, char* lds, int wg) {
  int tid_ = F.tid; asm volatile("" : "+v"(tid_));
  const int tid = tid_, wid = F.wave, lane = tid & 63, r32 = lane & 31, hi = lane >> 5, q4 = wid & 3, pr = wid >> 2;
  const int pair = 2 * wg + pr, b = pair >> 4, h = pair & 15;
  char* wreg = lds + wid * 16384;
  float* btab = (float*)(lds + SOFF_BT + pr * 2560);
  float* ml = (float*)(lds + SOFF_ML);
  { const int t4 = tid & 255; const int hh = (2 * wg + (tid >> 8)) & 15; float* bt = (float*)(lds + SOFF_BT + (tid >> 8) * 2560);
    for (int i = t4; i < 640; i += 256) { const int bi = i + 192 < 512 ? i + 192 : 512; bt[i] = F.rel_bias[hh * 513 + bi] * LOG2E; } }
  bf16x8 qr[8];
  { const bf16* Qw = F.Q + (size_t)(MP + 32 * b + r32) * DA + h * HD + hi * 8;
#pragma unroll
    for (int d0 = 0; d0 < 8; ++d0) qr[d0] = *(const bf16x8*)(Qw + d0 * 16); }
  float m_reg = -1e30f, l_reg = 0.f; f32x16 o[4] = {};
  const int vb = (int)(uintptr_t)(wreg + 8192) + v_rd_base(lane);
  __syncthreads();
  const int nsub = q4 == 3 ? 5 : 4;
  int kwf[4], kwb[2];
#pragma unroll
  for (int j = 0; j < 4; ++j) kwf[j] = hi * 256 + ((8 * r32) ^ (((2 * j + hi) & 7) << 4));
#pragma unroll
  for (int j = 0; j < 2; ++j) kwb[j] = (lane >> 4) * 256 + ((16 * (lane & 15)) ^ (((4 * j + (lane >> 4)) & 7) << 4));
  const int vwf = hi * 64 + ((4 * r32) >> 5) * 512 + ((4 * r32) & 31) * 2, vwb = (lane >> 4) * 64 + ((8 * (lane & 15)) >> 5) * 512 + ((8 * (lane & 15)) & 31) * 2;
  const unsigned lofs = (unsigned)(hi * (NH * HD) + 4 * r32) * 4u;
  const unsigned lofb = (unsigned)((lane >> 4) * DA + 8 * (lane & 15)) * 2u;
  for (int s = 0; s < nsub; ++s) {
    const int jbase = s < 4 ? 128 * q4 + 32 * s : 512;
    if (s < 4) { const char* kg = (const char*)(F.cache_k + ((size_t)(b * 512 + jbase) * NH + h) * HD);
#pragma unroll
      for (int hf = 0; hf < 2; ++hf) { f32x4 kv[8];
#pragma unroll
        for (int i = 0; i < 8; ++i) kv[i] = *(const GAS f32x4*)(kg + (size_t)(8 * hf + i) * (2 * NH * HD * 4) + lofs);
#pragma unroll
        for (int i = 0; i < 8; ++i) { v2u w; w.x = cvtpk(kv[i][0], kv[i][1]); w.y = cvtpk(kv[i][2], kv[i][3]); *(v2u*)(wreg + kwf[i & 3] + (8 * hf + i) * 512) = w; } } }
    else { const char* kg = (const char*)(F.KA + (size_t)(MP + 32 * b) * DA + h * HD); v4u kv[8];
#pragma unroll
      for (int i = 0; i < 8; ++i) kv[i] = *(const GAS v4u*)(kg + (size_t)i * (4 * DA * 2) + lofb);
#pragma unroll
      for (int i = 0; i < 8; ++i) *(v4u*)(wreg + kwb[i & 1] + i * 1024) = kv[i]; }
    asm volatile("s_waitcnt lgkmcnt(0)" ::: "memory");
    f32x16 p0;
    { const float* bp = btab + (549 + r32 - 4 * hi - jbase);
#pragma unroll
      for (int r = 0; r < 16; ++r) { const int kk = (r & 3) + 8 * (r >> 2); p0[r] = bp[27 - kk]; } }
#pragma unroll
    for (int d0 = 0; d0 < 8; ++d0) { const bf16x8 kf = *(const bf16x8*)(wreg + KSWZ(r32, (d0 * 16 + hi * 8) * 2)); p0 = __builtin_amdgcn_mfma_f32_32x32x16_bf16(kf, qr[d0], p0, 0, 0, 0); }
    float pmax = p0[0];
#pragma unroll
    for (int r = 1; r < 16; ++r) pmax = fmaxf(pmax, p0[r]);
    { auto rr = __builtin_amdgcn_permlane32_swap(__float_as_uint(pmax), __float_as_uint(pmax), false, false); pmax = fmaxf(__uint_as_float(rr[0]), __uint_as_float(rr[1])); }
    float mn, alpha;
    if (__all(pmax - m_reg <= THRL)) { mn = m_reg; alpha = 1.f; }
    else { mn = fmaxf(m_reg, pmax); alpha = __builtin_amdgcn_exp2f(m_reg - mn); m_reg = mn; }
    float ps = 0.f;
#pragma unroll
    for (int r = 0; r < 16; ++r) { p0[r] = __builtin_amdgcn_exp2f(p0[r] - mn); ps += p0[r]; }
    { auto rr = __builtin_amdgcn_permlane32_swap(__float_as_uint(ps), __float_as_uint(ps), false, false); ps = __uint_as_float(rr[0]) + __uint_as_float(rr[1]); }
    if (__any(alpha < 1.f)) {
#pragma unroll
      for (int d = 0; d < 4; ++d)
#pragma unroll
        for (int r = 0; r < 16; ++r) o[d][r] *= alpha; }
    l_reg = l_reg * alpha + ps;
    bf16x8 pa0, pa1;
#define PK4(P, BASE, OUT) do { unsigned a0 = cvtpk(P[BASE + 0], P[BASE + 1]), a1 = cvtpk(P[BASE + 2], P[BASE + 3]);   \
    unsigned b0 = cvtpk(P[BASE + 4], P[BASE + 5]), b1 = cvtpk(P[BASE + 6], P[BASE + 7]);                              \
    auto r0 = __builtin_amdgcn_permlane32_swap(a0, b0, false, false); auto r1 = __builtin_amdgcn_permlane32_swap(a1, b1, false, false); \
    v4u w_ = {r0[0], r1[0], r0[1], r1[1]}; OUT = *reinterpret_cast<bf16x8*>(&w_); } while (0)
    PK4(p0, 0, pa0); PK4(p0, 8, pa1);
#undef PK4
    if (s < 4) { const char* vg = (const char*)(F.cache_v + ((size_t)(b * 512 + jbase) * NH + h) * HD);
#pragma unroll
      for (int hf = 0; hf < 2; ++hf) { f32x4 vv[8];
#pragma unroll
        for (int i = 0; i < 8; ++i) vv[i] = *(const GAS f32x4*)(vg + (size_t)(8 * hf + i) * (2 * NH * HD * 4) + lofs);
#pragma unroll
        for (int i = 0; i < 8; ++i) { v2u w; w.x = cvtpk(vv[i][0], vv[i][1]); w.y = cvtpk(vv[i][2], vv[i][3]);
          *(v2u*)(wreg + 8192 + vwf + hf * 4096 + ((i >> 1) & 1) * 2048 + ((i >> 2) & 1) * 256 + (i & 1) * 128) = w; } } }
    else { const char* vg = (const char*)(F.VA + (size_t)(MP + 32 * b) * DA + h * HD); v4u vn[8];
#pragma unroll
      for (int i = 0; i < 8; ++i) vn[i] = *(const GAS v4u*)(vg + (size_t)i * (4 * DA * 2) + lofb);
#pragma unroll
      for (int i = 0; i < 8; ++i) *(v4u*)(wreg + 8192 + vwb + ((i >> 2) & 1) * 4096 + (i & 1) * 2048 + ((i >> 1) & 1) * 256) = vn[i]; }
    asm volatile("s_waitcnt lgkmcnt(0)" ::: "memory");
#define PK(L, H) (bf16x8){L[0], L[1], L[2], L[3], H[0], H[1], H[2], H[3]}
#define PVB(D0) do { const s16x4 l0 = tr_read<v_rd_off(D0, 0, 0)>(vb), h0 = tr_read<v_rd_off(D0, 0, 1)>(vb), l1 = tr_read<v_rd_off(D0, 1, 0)>(vb), h1 = tr_read<v_rd_off(D0, 1, 1)>(vb); \
      asm volatile("s_waitcnt lgkmcnt(0)" ::: "memory"); SBAR(); \
      o[D0] = __builtin_amdgcn_mfma_f32_32x32x16_bf16(PK(l0, h0), pa0, o[D0], 0, 0, 0); o[D0] = __builtin_amdgcn_mfma_f32_32x32x16_bf16(PK(l1, h1), pa1, o[D0], 0, 0, 0); } while (0)
    PVB(0); PVB(1); PVB(2); PVB(3);
#undef PVB
#undef PK
    asm volatile("s_waitcnt lgkmcnt(0)" ::: "memory");
  }
#pragma unroll
  for (int d0 = 0; d0 < 4; ++d0)
#pragma unroll
    for (int g = 0; g < 4; ++g) *(f32x4*)(wreg + d0 * 4096 + lane * 64 + g * 16) = (f32x4){o[d0][4 * g], o[d0][4 * g + 1], o[d0][4 * g + 2], o[d0][4 * g + 3]};
  if (hi == 0) { ml[wid * 64 + r32] = m_reg; ml[wid * 64 + 32 + r32] = l_reg; }
  asm volatile("s_waitcnt lgkmcnt(0)" ::: "memory"); __syncthreads();
  { float mj[4], lj[4], M = -1e30f;
#pragma unroll
    for (int j = 0; j < 4; ++j) { mj[j] = ml[(4 * pr + j) * 64 + r32]; lj[j] = ml[(4 * pr + j) * 64 + 32 + r32]; M = fmaxf(M, mj[j]); }
    float L = 0.f, wj[4];
#pragma unroll
    for (int j = 0; j < 4; ++j) { wj[j] = __builtin_amdgcn_exp2f(mj[j] - M); L += wj[j] * lj[j]; }
    const float rl = __builtin_amdgcn_rcpf(L);
    f32x4 acc[4];
#pragma unroll
    for (int g = 0; g < 4; ++g) acc[g] = (f32x4){0.f, 0.f, 0.f, 0.f};
#pragma unroll
    for (int j = 0; j < 4; ++j) { const char* pj = lds + (4 * pr + j) * 16384 + q4 * 4096 + lane * 64;
#pragma unroll
      for (int g = 0; g < 4; ++g) acc[g] += *(const f32x4*)(pj + g * 16) * wj[j]; }
    const int orow = MP + 32 * b + r32;
    const bf16* szr = F.SZ + (size_t)orow * DA + h * HD + 32 * q4 + 4 * hi; bf16* mr = F.MIX + (size_t)orow * LDK + DC + h * HD + 32 * q4 + 4 * hi;
    v2u sz[4];
#pragma unroll
    for (int g = 0; g < 4; ++g) sz[g] = *(const GAS v2u*)(szr + g * 8);
#pragma unroll
    for (int g = 0; g < 4; ++g) { const v2u z = sz[g];
      const float v0 = acc[g][0] * rl * __uint_as_float(z.x << 16), v1 = acc[g][1] * rl * __uint_as_float(z.x & 0xffff0000u);
      const float v2 = acc[g][2] * rl * __uint_as_float(z.y << 16), v3 = acc[g][3] * rl * __uint_as_float(z.y & 0xffff0000u);
      v2u w; w.x = cvtpk(v0, v1); w.y = cvtpk(v2, v3); *(GAS v2u*)(mr + g * 8) = w; }
  }
  __syncthreads();
}
}
__device__ __forceinline__ void p3_attention(Frame& F, char* lds, int probe) {
  if (!(probe & 16)) for (int u = F.vcu; u < NH * (MP / 256); u += F.G) { const int h = u >> 6, qb = u & 63; const int t0 = 8 - 4 * qb > 0 ? 8 - 4 * qb : 0;
    const int ts = qb < 2 ? t0 : (20 - 4 * (qb % 3)) % 12;
    att::attn_unit(F, lds, att::AUnit{h, 256 * qb, 256 * qb - 512, t0, 12, ts, 0, probe}); }
  if (!(probe & 8)) for (int wg = F.vcu; wg < NSB * NH / 2; wg += F.G) att::sample_pairs(F, lds, wg);
}
__device__ __forceinline__ void unpack8(const v4u w, float (&f)[8]) {
  f[0] = __uint_as_float(w.x << 16); f[1] = __uint_as_float(w.x & 0xffff0000u); f[2] = __uint_as_float(w.y << 16); f[3] = __uint_as_float(w.y & 0xffff0000u);
  f[4] = __uint_as_float(w.z << 16); f[5] = __uint_as_float(w.z & 0xffff0000u); f[6] = __uint_as_float(w.w << 16); f[7] = __uint_as_float(w.w & 0xffff0000u); }
__device__ __forceinline__ void p3_convmix(Frame& F) {
  const int gw = F.vcu * NWAVES + F.wave, NGW = F.G * NWAVES, lane = F.lane;
  constexpr int RB = 34; static_assert(MT % RB == 0 && (MT / RB) * 4 == 2048, "conv items");
  for (int it = gw; it < (MT / RB) * 4; it += NGW) {
    const int rb = it >> 2, c = 512 * (it & 3) + 8 * lane, r0 = RB * rb;
    float w0[8], w1[8], w2[8], cb[8], um2[8], um1[8];
    { const f32x4 a0 = *(const GAS f32x4*)(F.conv_w + c), a1 = *(const GAS f32x4*)(F.conv_w + c + 4), b0 = *(const GAS f32x4*)(F.conv_w + DC + c), b1 = *(const GAS f32x4*)(F.conv_w + DC + c + 4);
      const f32x4 c0 = *(const GAS f32x4*)(F.conv_w + 2 * DC + c), c1 = *(const GAS f32x4*)(F.conv_w + 2 * DC + c + 4), d0 = *(const GAS f32x4*)(F.conv_b + c), d1 = *(const GAS f32x4*)(F.conv_b + c + 4);
#pragma unroll
      for (int j = 0; j < 4; ++j) { w0[j] = a0[j]; w0[4 + j] = a1[j]; w1[j] = b0[j]; w1[4 + j] = b1[j]; w2[j] = c0[j]; w2[4 + j] = c1[j]; cb[j] = d0[j]; cb[4 + j] = d1[j]; } }
    if (r0 == 0) {
#pragma unroll
      for (int j = 0; j < 8; ++j) { um2[j] = 0.f; um1[j] = 0.f; } }
    else if (r0 > MP && ((r0 - MP) & 31) == 1) { const float* cc = F.cache_conv + (size_t)((r0 - MP) >> 5) * 2 * DC + DC + c;
#pragma unroll
      for (int j = 0; j < 8; ++j) um2[j] = cc[j];
      unpack8(*(const GAS v4u*)(F.U + (size_t)(r0 - 1) * DC + c), um1); }
    else if (r0 >= MP && ((r0 - MP) & 31) == 0) {
#pragma unroll
      for (int j = 0; j < 8; ++j) { um2[j] = 0.f; um1[j] = 0.f; } }
    else { unpack8(*(const GAS v4u*)(F.U + (size_t)(r0 - 2) * DC + c), um2); unpack8(*(const GAS v4u*)(F.U + (size_t)(r0 - 1) * DC + c), um1); }
    for (int g0 = 0; g0 < RB; g0 += 8) {
      const int nr = RB - g0 < 8 ? RB - g0 : 8;
      v4u ur[8], gr[8];
#pragma unroll
      for (int i = 0; i < 8; ++i) if (i < nr) { const size_t ro = (size_t)(r0 + g0 + i) * DC + c; ur[i] = *(const GAS v4u*)(F.U + ro); gr[i] = *(const GAS v4u*)(F.Gc + ro); }
#pragma unroll
      for (int i = 0; i < 8; ++i) if (i < nr) { const int r = r0 + g0 + i; float uu[8], gg[8], ov[8];
        if (r >= MP && ((r - MP) & 31) == 0) { const float* cc = F.cache_conv + (size_t)((r - MP) >> 5) * 2 * DC + c;
#pragma unroll
          for (int j = 0; j < 8; ++j) { um2[j] = cc[j]; um1[j] = cc[DC + j]; } }
        unpack8(ur[i], uu); unpack8(gr[i], gg);
#pragma unroll
        for (int j = 0; j < 8; ++j) { ov[j] = (cb[j] + w0[j] * um2[j] + w1[j] * um1[j] + w2[j] * uu[j]) * gg[j]; um2[j] = um1[j]; um1[j] = uu[j]; }
        v4u o; o.x = cvtpk(ov[0], ov[1]); o.y = cvtpk(ov[2], ov[3]); o.z = cvtpk(ov[4], ov[5]); o.w = cvtpk(ov[6], ov[7]);
        *(GAS v4u*)(F.MIX + (size_t)r * LDK + c) = o; }
    }
  }
}
struct Args { const float* in[16]; float* out; unsigned char* ws; int ph_lo, ph_hi; };
__global__ void __launch_bounds__(NWAVES * 64, 2) fwd(Args args) {
    extern __shared__ __attribute__((aligned(16))) unsigned char lds[];
    Frame F;
    F.lds = (LAS unsigned char*)lds;
    F.MISC = (volatile LAS unsigned*)(F.lds + MISC_OFF);
    F.tid = threadIdx.x; F.lane = F.tid & 63; F.wave = __builtin_amdgcn_readfirstlane(F.tid >> 6);
    F.G = gridDim.x; { const int bx = blockIdx.x; F.vcu = (F.G % 8 == 0) ? (bx % 8) * (F.G / 8) + bx / 8 : bx; }
    unsigned char* ws = args.ws;
    F.ctl = (gu32*)(ws + WS_CTL);
    F.x_prompt = args.in[0]; F.x_sample = args.in[1]; F.cache_k = args.in[2]; F.cache_v = args.in[3]; F.cache_conv = args.in[4]; F.c_prompt = args.in[5]; F.c_sample = args.in[6];
    F.g_norm = args.in[7]; F.w_ada = args.in[8]; F.b_ada = args.in[9]; F.w_in = args.in[10]; F.conv_w = args.in[11]; F.conv_b = args.in[12]; F.rel_bias = args.in[13]; F.w_out = args.in[14]; F.g_final = args.in[15];
    F.out = args.out;
    F.modA = (float*)(ws + WS_MOD); F.modB = (float*)(ws + WS_MOD + MOD_STRIDE); F.gate = (float*)(ws + WS_MOD + 2 * MOD_STRIDE);
    F.WT1 = (bf16*)(ws + WS_WT1); F.WT2 = (bf16*)(ws + WS_WT2); F.H = (bf16*)(ws + WS_H); F.MIX = (bf16*)(ws + WS_H);
    F.U = (bf16*)(ws + WS_U); F.Gc = (bf16*)(ws + WS_G); F.Q = (bf16*)(ws + WS_Q); F.SZ = (bf16*)(ws + WS_SZ); F.KA = (bf16*)(ws + WS_KA); F.VA = (bf16*)(ws + WS_VA); F.XN = (bf16*)(ws + WS_XN); F.PART = (float*)(ws + WS_PART);
    for (int u = F.tid; u < (LDS_BYTES - LDSCTL_OFF) / 4; u += NWAVES * 64) ((LAS unsigned*)(F.lds + LDSCTL_OFF))[u] = 0u;
    __syncthreads();
    XcdBarrier bar; bar.bar = (unsigned*)(F.ctl + CW_BAR); bar.x = 0; bar.st = nullptr;
    if (N_LAUNCHES != PER_PHASE) bar = xcd_barrier_post((unsigned*)(F.ctl + CW_BAR), F.MISC + 8);
#if defined(PROBE_STAMP)
    unsigned long long ta = 0, tb = 0;
#define STAMP(i) do { if ((i) == PROBE_STAMP || (PROBE_STAMP == 100 && (i) == 0)) ta = __builtin_amdgcn_s_memrealtime(); if ((i) == PROBE_STAMP + 1) tb = __builtin_amdgcn_s_memrealtime(); } while (0)
#define GRID_BAR(i) do { if (N_LAUNCHES != PER_PHASE) xcd_barrier(bar); STAMP(i); } while (0)
    STAMP(0);
#else
#define GRID_BAR(i) do { if (N_LAUNCHES != PER_PHASE) xcd_barrier(bar); } while (0)
#endif
    const int lo = args.ph_lo, hi = args.ph_hi;
    const bool splitk = (F.G == 256);
#define IN(k) (lo <= (k) && (k) < hi)
#define BOTH(k) (IN(k) && IN((k) + 1))
#ifndef PROBE_REPEAT
#define PROBE_REPEAT 0
#endif
#define REP(k) ((PROBE_REPEAT >> (4 * (k))) & 15)
#if defined(PROBE_P0SPLIT)
    if (IN(0)) { STAMP(20); p0_prologue(F, 1); xcd_barrier(bar); STAMP(21); p0_prologue(F, 2); GRID_BAR(1); STAMP(22); }
#else
    if (IN(0)) { for (int rep = 0; rep <= REP(0); ++rep) { p0_prologue(F, 0); if (BOTH(0)) GRID_BAR(1); } }
#endif
    if (IN(1)) { for (int rep = 0; rep <= REP(1); ++rep) { p1_hrows(F); if (BOTH(1)) GRID_BAR(2); } }
#if defined(PROBE_MFMA)
    if (IN(2)) {
        const bf16* ha = F.H + (size_t)(blockIdx.x * 64 + F.lane) * LDK + F.wave * 64; const bf16* wb = F.WT1 + (size_t)(blockIdx.x * 64 + F.lane) * LDK + F.wave * 64;
        bf16x8 a[8], b[8];
#pragma unroll
        for (int j = 0; j < 8; ++j) { a[j] = *(const bf16x8*)(ha + 8 * j); b[j] = *(const bf16x8*)(wb + 8 * j); }
        f32x4 acc[16];
#pragma unroll
        for (int j = 0; j < 16; ++j) acc[j] = (f32x4){0.f, 0.f, 0.f, 0.f};
        for (int it = 0; it < 17 * 64 * 4 / PROBE_MFMA; ++it) {
#pragma unroll
            for (int j = 0; j < 16; ++j) acc[j] = __builtin_amdgcn_mfma_f32_16x16x32_bf16(a[j & 7], b[(j >> 1) & 7], acc[j], 0, 0, 0);
        }
        float sacc = 0.f;
#pragma unroll
        for (int j = 0; j < 16; ++j) sacc += acc[j][0] + acc[j][1] + acc[j][2] + acc[j][3];
        if (sacc == 12345.678f) F.ctl[64] = 1u;
        GRID_BAR();
    }
#endif
    for (int rep = 0; rep <= REP(2); ++rep)
    if (IN(2)) {
        pg8::Gemm g{F.H, F.WT1, MT, NIN, DM, LDK};
#if defined(PROBE_GEMM)
        g.probe = rep ? PROBE_GEMM : 0;
#endif
        pg8::EpiIn E{F.U, F.Gc, F.Q, F.SZ, F.KA, F.VA, F.out};
        if (splitk) { typedef pg8::G1_ORDER G1; G1 S; S.init(MT, NIN, DM, (int)blockIdx.x); pg8::gemm_phase<pg8::EpiIn, G1, PG8_ALIGN, PG8_SP2>(F.lds + RING_OFF, g, S, E); }
        else { pg8::StaticOrder S; S.init(MT, NIN, DM, F.G, (int)blockIdx.x); pg8::gemm_phase<pg8::EpiIn, pg8::StaticOrder, PG8_ALIGN, PG8_SP2>(F.lds + RING_OFF, g, S, E); }
        if (BOTH(2)) GRID_BAR(3);
#if defined(PROBE_ADA_LATE)
        STAMP(30); p0_prologue(F, PROBE_ADA_LATE); xcd_barrier(bar); STAMP(31);
#endif
    }
    for (int rep = 0; rep <= REP(3); ++rep)
    if (IN(3)) {
#if defined(PROBE_P3) && PROBE_P3 == 1
        if (rep == 0) p3_convmix(F); p3_attention(F, (char*)lds + RING_OFF, rep ? PROBE_ATT : 0);
#elif defined(PROBE_P3) && PROBE_P3 == 2
        if (rep == 0) p3_attention(F, (char*)lds + RING_OFF, 0); p3_convmix(F);
#elif defined(PROBE_STAMP) && PROBE_STAMP >= 10
#if defined(PROBE_HOTKV)
        p3_attention(F, (char*)lds + RING_OFF, 8); xcd_barrier(bar);
        STAMP(10); p3_attention(F, (char*)lds + RING_OFF, 8 + 4 + PROBE_HOTKV); xcd_barrier(bar); STAMP(11);
#else
        STAMP(10); p3_attention(F, (char*)lds + RING_OFF, 8); xcd_barrier(bar); STAMP(11);
#endif
        p3_attention(F, (char*)lds + RING_OFF, 16); xcd_barrier(bar); STAMP(12); p3_convmix(F); xcd_barrier(bar); STAMP(13);
#else
        p3_attention(F, (char*)lds + RING_OFF, 0); p3_convmix(F);
#endif
        if (BOTH(3)) GRID_BAR(4); }
    for (int rep = 0; rep <= REP(4); ++rep)
    if (IN(4)) {
        pg8::Gemm g{F.MIX, F.WT2, MT, DM, DM, LDK};
#if defined(PROBE_GEMM)
        g.probe = 0;
#endif
        pg8::EpiOut E{F.gate, F.XN, F.PART};
        if (splitk) { pg8::TailSplitOrder S; S.init(F.G, (int)blockIdx.x); pg8::gemm_phase<pg8::EpiOut, pg8::TailSplitOrder, PG8_ALIGN, PG8_SP2>(F.lds + RING_OFF, g, S, E); }
        else { pg8::StaticOrder S; S.init(MT, DM, DM, F.G, (int)blockIdx.x); pg8::gemm_phase<pg8::EpiOut, pg8::StaticOrder, PG8_ALIGN, PG8_SP2>(F.lds + RING_OFF, g, S, E); }
        if (BOTH(4)) GRID_BAR(5);
    }
    if (IN(5)) { p5_final(F, splitk); }
#if defined(PROBE_STAMP)
    STAMP(6);
#if PROBE_STAMP == 100
    tb = __builtin_amdgcn_s_memrealtime();
#endif
    if (blockIdx.x == 0 && F.tid == 0) { const unsigned long long d = tb - ta, te = __builtin_amdgcn_s_memrealtime();
        while (__builtin_amdgcn_s_memrealtime() - te < 4ull * d) __builtin_amdgcn_s_sleep(32); }
#endif
#undef IN
#undef BOTH
}

extern "C" void kernel_launch(void* const* d_in, const int* in_sizes, int n_in, void* d_out, int out_size, void* d_ws, size_t ws_size, hipStream_t stream) {
    static int grid = 0;
    if (grid == 0) {
        if (n_in != 16 || in_sizes[0] != MP * DM || out_size != (int)O_END || ws_size < WS_END) {
            fprintf(stderr, "kernel_launch: shape mismatch: n_in %d in0 %d out %d ws %zu (need >= %zu); nothing launched\n", n_in, n_in > 0 ? in_sizes[0] : -1, out_size, ws_size, (size_t)WS_END); grid = -1; return; }
        int dev = 0, cus = 0, per_cu = 0;
        if (hipGetDevice(&dev) != hipSuccess || hipDeviceGetAttribute(&cus, hipDeviceAttributeMultiprocessorCount, dev) != hipSuccess) { fprintf(stderr, "kernel_launch: device query failed\n"); grid = -1; return; }
        if (hipFuncSetAttribute((const void*)fwd, hipFuncAttributeMaxDynamicSharedMemorySize, LDS_BYTES) != hipSuccess) { fprintf(stderr, "kernel_launch: hipFuncSetAttribute failed\n"); grid = -1; return; }
        if (hipOccupancyMaxActiveBlocksPerMultiprocessor(&per_cu, (const void*)fwd, NWAVES * 64, LDS_BYTES) != hipSuccess || per_cu < 1)
            fprintf(stderr, "kernel_launch: note: occupancy query reports %d workgroups per CU\n", per_cu);
        (void)hipGetLastError();
        grid = cus;
    }
    if (grid < 0) return;
    if (hipMemsetAsync((char*)d_ws + WS_CTL, 0, CTL_ZERO_BYTES, stream) != hipSuccess) { fprintf(stderr, "kernel_launch: memset failed\n"); return; }
    Args a{};
    for (int i = 0; i < 16; ++i) a.in[i] = (const float*)d_in[i];
    a.out = (float*)d_out; a.ws = (unsigned char*)d_ws;
    const int nl = (N_LAUNCHES == PER_PHASE) ? PER_PHASE : 1;
    for (int li = 0; li < nl; ++li) {
        a.ph_lo = (N_LAUNCHES == PER_PHASE) ? li : 0; a.ph_hi = (N_LAUNCHES == PER_PHASE) ? li + 1 : PER_PHASE;
        hipLaunchKernelGGL(fwd, dim3(grid), dim3(NWAVES * 64), LDS_BYTES, stream, a);
        const hipError_t le = hipPeekAtLastError();
        if (le != hipSuccess) { fprintf(stderr, "kernel_launch: launch %d failed: %s\n", li, hipGetErrorName(le)); break; }
    }
}
```

```cpp
#include <hip/hip_runtime.h>
#include <cstdio>
#include <cstdint>

#ifndef MK_N_LAUNCHES
#define MK_N_LAUNCHES 1
#endif
constexpr int N_LAUNCHES = MK_N_LAUNCHES;
constexpr int PER_PHASE = 6;

constexpr int DM = 4096, MP = 16384, NSB = 32, NST = 32, MS = NSB * NST, MT = MP + MS;
constexpr int LDK = DM + 64;
constexpr int NIN = 16384, DC = 2048, DA = 2048, NH = 16, HD = 128;
constexpr int KROWS = MT;
constexpr float NORM_EPS = 1e-6f;
constexpr float LOG2E = 1.4426950408889634f;
constexpr float QSCALE = 0.08838834764831845f * LOG2E;
constexpr size_t O_YP = 0, O_YS = (size_t)MP * DM, O_KP = O_YS + (size_t)MS * DM, O_VP = O_KP + 512 * 2048, O_CP = O_VP + 512 * 2048, O_KS = O_CP + 2 * 2048,
                 O_VS = O_KS + (size_t)MS * 2048, O_CS = O_VS + (size_t)MS * 2048, O_END = O_CS + (size_t)NSB * 2 * 2048;
static_assert(O_END == 77729792, "output size");

namespace pg8 {
#define PG8_LAS __attribute__((address_space(3)))
typedef unsigned short bf16_t;
typedef short bf16x8 __attribute__((ext_vector_type(8)));
typedef float f32x4 __attribute__((ext_vector_type(4)));
typedef unsigned u32x4 __attribute__((ext_vector_type(4)));
constexpr int BM = 256, BK = 64, HALF = 128, HTB = HALF * BK * 2  , STAGE_BYTES = 8 * HTB, NXCD = 8, WGM = 8;

__host__ __device__ __forceinline__ int lds_byte(int r, int c) { const int st = (r >> 4) * 2 + (c >> 5), rr = r & 15, cc = c & 31, ob = rr * 64 + cc * 2; return st * 1024 + (ob ^ (((ob >> 9) & 1) << 5)); }
__host__ __device__ __forceinline__ void stage_rc(int b, int& R, int& C) { const int st = b / 1024, sb = b % 1024, swz = sb ^ (((sb >> 9) & 1) << 5); R = (st >> 1) * 16 + swz / 64; C = (st & 1) * 32 + (swz % 64) / 2; }
__host__ __device__ __forceinline__ int perm32(int rho) { const int n = rho >> 4, i = rho & 15; return 8 * (i >> 2) + 4 * n + (i & 3); }

struct Unit { int pm, pn, kb, nt, part; };
struct Gemm { const bf16_t* A; const bf16_t* Bt; int M, N, K, ld;
#if defined(PROBE_GEMM)
    int probe;
#endif
};

struct StaticOrder {
    int nM, nN, nwg, G, c, nK;
#if defined(PROBE_HOT)
    int hot;
#endif
    __host__ __device__ void init(int M, int N, int K, int G_, int c_) { nM = M / BM; nN = N / BM; nK = K / BK; nwg = nM * nN; G = G_; c = c_;
#if defined(PROBE_HOT)
        hot = 0;
#endif
    }
    __host__ __device__ bool next(int i, Unit& u) const {
        const long L = (long)i * G + c; if (L >= nwg) return false;
#if defined(PROBE_HOT)
        if (hot) { const int l = c >> 3; u.pm = l & 7; u.pn = (l >> 3) + PROBE_HOT - 1; return true; }
#endif
        int wgid = (int)L; { const int q = nwg / NXCD, r = nwg % NXCD, xcd = wgid % NXCD, off = wgid / NXCD; wgid = (xcd < r ? xcd * (q + 1) : r * (q + 1) + (xcd - r) * q) + off; }
        const int nig = WGM * nN, gid = wgid / nig, fm = gid * WGM, gsz = (nM - fm) < WGM ? (nM - fm) : WGM;
        u.pm = fm + ((wgid % nig) % gsz); u.pn = (wgid % nig) / gsz; u.kb = 0; u.nt = nK; u.part = -1; return true;
    }
    __device__ __forceinline__ void a_ready(const Unit&) const {}
    __device__ __forceinline__ void done(const Unit&) const {}
};
__device__ __forceinline__ unsigned cvt_pk_bf16(float lo, float hi) { unsigned r; asm volatile("v_cvt_pk_bf16_f32 %0, %1, %2" : "=v"(r) : "v"(lo), "v"(hi)); return r; }
typedef float f32x2 __attribute__((ext_vector_type(2)));
__device__ __forceinline__ float silu_f(float x) { return x * __builtin_amdgcn_rcpf(1.0f + __builtin_amdgcn_exp2f(-1.4426950408889634f * x)); }
__device__ __forceinline__ f32x4 silu4(f32x4 v) { f32x4 r; r[0] = silu_f(v[0]); r[1] = silu_f(v[1]); r[2] = silu_f(v[2]); r[3] = silu_f(v[3]); return r; }
__device__ __forceinline__ u32x4 pack8(f32x4 v0, f32x4 v1) { u32x4 w; w.x = cvt_pk_bf16(v0[0], v0[1]); w.y = cvt_pk_bf16(v0[2], v0[3]); w.z = cvt_pk_bf16(v1[0], v1[1]); w.w = cvt_pk_bf16(v1[2], v1[3]); return w; }
__device__ __forceinline__ int krow_of(int row) { return row; }

struct EpiIn {
    static constexpr bool PERM = true, AFTER_DRAIN = false;
    bf16_t *U, *G, *Q, *SZ, *KA, *VA; float* out;
    __device__ __forceinline__ void operator()(const f32x4 (&acc)[2][2][4][2], const Unit& u, int wr, int wc, int fr, int fq) const {
        const int pn = u.pn, row0 = u.pm * BM + wr * 64 + fr;
        if (pn < 32) {
            const int col = (pn & 15) * 128 + wc * 32 + 8 * fq;
            if (pn < 16) {
#pragma unroll
                for (int ai = 0; ai < 2; ++ai)
#pragma unroll
                    for (int m = 0; m < 4; ++m) { const int row = row0 + ai * HALF + m * 16;
                        const f32x4 v0 = acc[ai][0][m][0] * acc[ai][1][m][0], v1 = acc[ai][0][m][1] * acc[ai][1][m][1];
                        *(u32x4*)(U + (size_t)row * DC + col) = pack8(v0, v1);
                        if (u.pm >= 63) { long o = -1;
                            if (row >= MP) { const int t = row & 31; if (t >= 30) o = (long)O_CS + (long)((((row - MP) >> 5) * 2 + (t - 30)) * 2048); }
                            else if (row >= MP - 2) o = (long)O_CP + (long)((row - (MP - 2)) * 2048);
                            if (o >= 0) { *(f32x4*)(out + o + col) = v0; *(f32x4*)(out + o + col + 4) = v1; } } }
            } else {
#pragma unroll
                for (int ai = 0; ai < 2; ++ai)
#pragma unroll
                    for (int m = 0; m < 4; ++m) { const int row = row0 + ai * HALF + m * 16;
                        const f32x4 v0 = acc[ai][0][m][0] * silu4(acc[ai][1][m][0]), v1 = acc[ai][0][m][1] * silu4(acc[ai][1][m][1]);
                        *(u32x4*)(G + (size_t)row * DC + col) = pack8(v0, v1); }
            }
        } else {
            const int part = (pn - 32) >> 3, colp = ((pn - 32) & 7) * 256 + wc * 32 + 8 * fq;
            if (part == 0) {
#pragma unroll
                for (int ai = 0; ai < 2; ++ai)
#pragma unroll
                    for (int m = 0; m < 4; ++m) { const int row = row0 + ai * HALF + m * 16;
#pragma unroll
                        for (int bj = 0; bj < 2; ++bj) *(u32x4*)(Q + (size_t)row * DA + colp + bj * HALF) = pack8(acc[ai][bj][m][0] * QSCALE, acc[ai][bj][m][1] * QSCALE); }
            } else if (part == 3) {
#pragma unroll
                for (int ai = 0; ai < 2; ++ai)
#pragma unroll
                    for (int m = 0; m < 4; ++m) { const int row = row0 + ai * HALF + m * 16;
#pragma unroll
                        for (int bj = 0; bj < 2; ++bj) *(u32x4*)(SZ + (size_t)row * DA + colp + bj * HALF) = pack8(silu4(acc[ai][bj][m][0]), silu4(acc[ai][bj][m][1])); }
            } else {
                bf16_t* dst = part == 1 ? KA : VA;
                float* odp = out + (part == 1 ? O_KP : O_VP); float* ods = out + (part == 1 ? O_KS : O_VS);
#pragma unroll
                for (int ai = 0; ai < 2; ++ai)
#pragma unroll
                    for (int m = 0; m < 4; ++m) { const int row = row0 + ai * HALF + m * 16; const size_t kr = (size_t)krow_of(row);
#pragma unroll
                        for (int bj = 0; bj < 2; ++bj) { *(u32x4*)(dst + kr * DA + colp + bj * HALF) = pack8(acc[ai][bj][m][0], acc[ai][bj][m][1]);
                            if (u.pm >= 62) { float* o = row >= MP ? ods + (size_t)(row - MP) * DA : odp + (size_t)(row - (MP - 512)) * DA;
                                *(f32x4*)(o + colp + bj * HALF) = acc[ai][bj][m][0]; *(f32x4*)(o + colp + bj * HALF + 4) = acc[ai][bj][m][1]; } } }
            }
        }
    }
};
struct EpiOut {
    static constexpr bool PERM = true, AFTER_DRAIN = false;
    const float* gate; bf16_t* XN; float* PART;
    __device__ __forceinline__ void operator()(const f32x4 (&acc)[2][2][4][2], const Unit& u, int wr, int wc, int fr, int fq) const {
        const int row0 = u.pm * BM + wr * 64 + fr, col = u.pn * BM + wc * 32 + 8 * fq;
        if (u.part >= 0) {
            float* pb = PART + (size_t)u.part * MS * DM;
#pragma unroll
            for (int ai = 0; ai < 2; ++ai)
#pragma unroll
                for (int m = 0; m < 4; ++m) { float* pr = pb + (size_t)(row0 + ai * HALF + m * 16 - MP) * DM + col;
#pragma unroll
                    for (int bj = 0; bj < 2; ++bj) { *(f32x4*)(pr + bj * HALF) = acc[ai][bj][m][0]; *(f32x4*)(pr + bj * HALF + 4) = acc[ai][bj][m][1]; } }
            return;
        }
        if (u.pm < MP / BM) {
            f32x4 g[2][2];
#pragma unroll
            for (int bj = 0; bj < 2; ++bj) { g[bj][0] = *(const f32x4*)(gate + col + bj * HALF); g[bj][1] = *(const f32x4*)(gate + col + bj * HALF + 4); }
#pragma unroll
            for (int ai = 0; ai < 2; ++ai)
#pragma unroll
                for (int m = 0; m < 4; ++m) { bf16_t* yr = XN + (size_t)(row0 + ai * HALF + m * 16) * DM + col;
#pragma unroll
                    for (int bj = 0; bj < 2; ++bj) *(u32x4*)(yr + bj * HALF) = pack8(g[bj][0] * acc[ai][bj][m][0], g[bj][1] * acc[ai][bj][m][1]); }
        } else {
#pragma unroll
            for (int ai = 0; ai < 2; ++ai)
#pragma unroll
                for (int m = 0; m < 4; ++m) { const int row = row0 + ai * HALF + m * 16; const float* gr = gate + (size_t)(1 + ((row - MP) >> 5)) * DM + col; bf16_t* yr = XN + (size_t)row * DM + col;
#pragma unroll
                    for (int bj = 0; bj < 2; ++bj) *(u32x4*)(yr + bj * HALF) = pack8(*(const f32x4*)(gr + bj * HALF) * acc[ai][bj][m][0], *(const f32x4*)(gr + bj * HALF + 4) * acc[ai][bj][m][1]); }
        }
    }
};
template <int XM, int XN, int RM, int RN, bool MFIRST> struct GridOrderT {
    static_assert(XM * XN == 8 && RM * RN == 32, "GridOrderT geometry");
    int nM, nN, nK, c;
    __device__ void init(int M, int N, int K, int c_) { nM = M / BM; nN = N / BM; nK = K / BK; c = c_; }
    __device__ bool next(int i, Unit& u) const {
        constexpr int BMc = XM * RM, BNc = XN * RN;
        const int x = c & 7, k = c >> 3, nq = nN / BNc, ng = (nM & ~15) / BMc, full = ng * nq;
        u.kb = 0; u.nt = nK; u.part = -1;
        if (i < full) { const int g = MFIRST ? i % ng : i / nq, q = MFIRST ? i / ng : i % nq;
            u.pm = BMc * g + RM * (x / XN) + (k % RM); u.pn = BNc * q + RN * (x % XN) + (k / RM); return true; }
        if (i == full && (nM & 15) == 4 && nN == 64) { u.pm = (nM & ~15) + (k & 3); u.pn = 8 * x + (k >> 2); return true; }
        return false;
    }
    __device__ __forceinline__ void a_ready(const Unit&) const {}
    __device__ __forceinline__ void done(const Unit&) const {}
};
typedef GridOrderT<4, 2, 4, 8, false> GridOrder;
#ifndef G1_ORDER
#define G1_ORDER GridOrderT<2, 4, 4, 8, false>
#endif
struct TailSplitOrder {
    GridOrder so; int c;
    __device__ void init(int G, int c_) { so.init(MP, DM, DM, c_); c = c_; (void)G; }
    __device__ bool next(int i, Unit& u) const {
        if (i < 4) return so.next(i, u);
        if (i > 4) return false;
        const int kq = c & 3, r = c >> 2; u.pm = MP / BM + (r & 3); u.pn = r >> 2; u.kb = kq * (DM / 4) * 2; u.nt = DM / 4 / BK; u.part = kq; return true;
    }
    __device__ __forceinline__ void a_ready(const Unit&) const {}
    __device__ __forceinline__ void done(const Unit&) const {}
};
template <class Epi, class Sched, bool ALIGN_EPI = false, bool SP2 = false>
__device__ __forceinline__ void gemm_phase(PG8_LAS unsigned char* lds, const Gemm g, const Sched& S, const Epi& E) {
    int tid_ = threadIdx.x; asm volatile("" : "+v"(tid_));
    const int tid = tid_, wid = __builtin_amdgcn_readfirstlane(tid >> 6), lane = tid & 63, wr = wid >> 2, wc = wid & 3, fr = lane & 15, fq = lane >> 4;
    const int LD = g.ld;
    unsigned voffA[2], voffB[2];
#pragma unroll
    for (int i = 0; i < 2; ++i) { int R, C; stage_rc(tid * 16 + i * 8192, R, C); const int Rb = Epi::PERM ? ((R & ~31) + perm32(R & 31)) : R;
        voffA[i] = (unsigned)(R * LD + C) * 2u; voffB[i] = (unsigned)(Rb * LD + C) * 2u; }
    const size_t kstep = (size_t)(BK * 2);
    const size_t hstep = (size_t)HALF * LD * 2;
    const size_t tstep = 2 * hstep;
    const unsigned ldsw = (unsigned)wid * 1024u;
    const int aoff = lds_byte(wr * 64 + fr, fq * 8), boff = lds_byte(wc * 32 + fr, fq * 8);
#define PG8_SA(b, h) (((b) * 2 + (h)) * HTB)
#define PG8_SB(b, h) ((4 + (b) * 2 + (h)) * HTB)
#if defined(PROBE_GEMM)
    const int pf = g.probe;
#define PG8_PF(b) if (!(pf & (b)))
#else
#define PG8_PF(b)
#endif
#define PG8_STAGE(bufoff, gbase, voff) do { PG8_PF(2) _Pragma("unroll") for (int _i = 0; _i < 2; ++_i) \
        __builtin_amdgcn_global_load_lds((const unsigned*)((const char*)(gbase) + (voff)[_i]), (PG8_LAS unsigned*)(lds + (bufoff) + ldsw + _i * 8192), 16, 0, 0); } while (0)
#define PG8_LDA(dst, b, h) do { _Pragma("unroll") for (int m = 0; m < 4; ++m) _Pragma("unroll") for (int k = 0; k < 2; ++k) dst[m][k] = *(const PG8_LAS bf16x8*)(lds + PG8_SA(b, h) + aoff + m * 2048 + k * 1024); } while (0)
#define PG8_LDB(dst, b, h) do { _Pragma("unroll") for (int n = 0; n < 2; ++n) _Pragma("unroll") for (int k = 0; k < 2; ++k) dst[n][k] = *(const PG8_LAS bf16x8*)(lds + PG8_SB(b, h) + boff + n * 2048 + k * 1024); } while (0)
#define PG8_MMA(ai, bj, At, Bt) do { __builtin_amdgcn_s_setprio(1); PG8_PF(1) _Pragma("unroll") for (int m = 0; m < 4; ++m) _Pragma("unroll") for (int n = 0; n < 2; ++n) _Pragma("unroll") for (int k = 0; k < 2; ++k) \
        acc[ai][bj][m][n] = __builtin_amdgcn_mfma_f32_16x16x32_bf16(Bt[n][k], At[m][k], acc[ai][bj][m][n], 0, 0, 0); __builtin_amdgcn_s_setprio(0); } while (0)
#define PG8_WAIT_V(n) asm volatile("s_waitcnt vmcnt(" #n ")" ::: "memory")
#define PG8_WAIT_L(n) asm volatile("s_waitcnt lgkmcnt(" #n ")" ::: "memory")
#define PG8_BAR __builtin_amdgcn_s_barrier()
#define PG8_SCHED __builtin_amdgcn_sched_barrier(0)
    Unit cur, nxt; int ui = 0;
    if (!S.next(0, cur)) return;
    f32x4 acc[2][2][4][2];
#pragma unroll
    for (int a = 0; a < 2; ++a)
#pragma unroll
        for (int b = 0; b < 2; ++b)
#pragma unroll
            for (int m = 0; m < 4; ++m)
#pragma unroll
                for (int n = 0; n < 2; ++n) acc[a][b][m][n] = (f32x4){0.f, 0.f, 0.f, 0.f};
    bf16x8 At[4][2], B0[2][2], B1[2][2];
    const char* cA = (const char*)g.A + (size_t)cur.pm * tstep + cur.kb; const char* cB = (const char*)g.Bt + (size_t)cur.pn * tstep + cur.kb;
    S.a_ready(cur);
    if constexpr (SP2) {
        PG8_STAGE(PG8_SB(0, 0), cB, voffB); PG8_STAGE(PG8_SB(0, 1), cB + hstep, voffB); PG8_STAGE(PG8_SA(0, 0), cA, voffA); PG8_STAGE(PG8_SA(0, 1), cA + hstep, voffA);
        if (wr == 1) PG8_BAR;
        PG8_WAIT_V(2); PG8_BAR;
        PG8_STAGE(PG8_SB(1, 0), cB + kstep, voffB); PG8_STAGE(PG8_SA(1, 0), cA + kstep, voffA); PG8_STAGE(PG8_SB(1, 1), cB + hstep + kstep, voffB);
        PG8_WAIT_V(6); PG8_BAR;
    } else {
        PG8_STAGE(PG8_SB(0, 0), cB, voffB); PG8_STAGE(PG8_SA(0, 0), cA, voffA); PG8_STAGE(PG8_SB(0, 1), cB + hstep, voffB); PG8_STAGE(PG8_SA(0, 1), cA + hstep, voffA);
        if (wr == 1) PG8_BAR;
        PG8_WAIT_V(4); PG8_BAR;
        PG8_STAGE(PG8_SB(1, 0), cB + kstep, voffB); PG8_STAGE(PG8_SA(1, 0), cA + kstep, voffA); PG8_STAGE(PG8_SB(1, 1), cB + hstep + kstep, voffB);
        PG8_WAIT_V(6); PG8_BAR;
    }
    for (;;) {
        const bool has_next = S.next(ui + 1, nxt);
        const char* nA = has_next ? (const char*)g.A + (size_t)nxt.pm * tstep + nxt.kb : cA; const char* nB = has_next ? (const char*)g.Bt + (size_t)nxt.pn * tstep + nxt.kb : cB;
        const int nt = cur.nt;
        for (int t = 0; t < nt; t += 2) {
            const bool last = (t == nt - 2);
            const char* a1 = cA + (size_t)(t + 1) * kstep;
            const char* a2 = last ? nA : cA + (size_t)(t + 2) * kstep; const char* b2 = last ? nB : cB + (size_t)(t + 2) * kstep;
            const char* a3 = a2 + kstep; const char* b3 = b2 + kstep;
            if (last && has_next) S.a_ready(nxt);
            if constexpr (SP2) {
            PG8_LDB(B0, 0, 0); PG8_LDB(B1, 0, 1); PG8_SCHED; PG8_LDA(At, 0, 0); PG8_STAGE(PG8_SA(1, 1), a1 + hstep, voffA);
            PG8_WAIT_V(8); PG8_WAIT_L(0); PG8_BAR; PG8_MMA(0, 0, At, B0); PG8_MMA(0, 1, At, B1); PG8_BAR; PG8_SCHED;
            PG8_LDA(At, 0, 1); PG8_STAGE(PG8_SB(0, 0), b2, voffB); PG8_STAGE(PG8_SB(0, 1), b2 + hstep, voffB); PG8_STAGE(PG8_SA(0, 0), a2, voffA);
            PG8_WAIT_V(8); PG8_WAIT_L(0); PG8_BAR; PG8_MMA(1, 0, At, B0); PG8_MMA(1, 1, At, B1); PG8_BAR; PG8_SCHED;
            PG8_LDB(B0, 1, 0); PG8_LDB(B1, 1, 1); PG8_SCHED; PG8_LDA(At, 1, 0); PG8_STAGE(PG8_SA(0, 1), a2 + hstep, voffA);
            PG8_WAIT_V(8); PG8_WAIT_L(0); PG8_BAR; PG8_MMA(0, 0, At, B0); PG8_MMA(0, 1, At, B1); PG8_BAR; PG8_SCHED;
            PG8_LDA(At, 1, 1); PG8_STAGE(PG8_SB(1, 0), b3, voffB); PG8_STAGE(PG8_SB(1, 1), b3 + hstep, voffB); PG8_STAGE(PG8_SA(1, 0), a3, voffA);
            PG8_WAIT_V(8); PG8_WAIT_L(0); PG8_BAR; PG8_MMA(1, 0, At, B0); PG8_MMA(1, 1, At, B1); PG8_BAR; PG8_SCHED;
            } else {
            PG8_LDB(B0, 0, 0); PG8_SCHED; PG8_LDA(At, 0, 0); PG8_STAGE(PG8_SA(1, 1), a1 + hstep, voffA);
            PG8_WAIT_L(8); PG8_BAR; PG8_WAIT_L(0); PG8_MMA(0, 0, At, B0); PG8_BAR; PG8_SCHED;
            PG8_LDB(B1, 0, 1); PG8_STAGE(PG8_SB(0, 0), b2, voffB);
            PG8_BAR; PG8_WAIT_L(0); PG8_MMA(0, 1, At, B1); PG8_BAR;
            PG8_LDA(At, 0, 1); PG8_STAGE(PG8_SA(0, 0), a2, voffA);
            PG8_BAR; PG8_WAIT_L(0); PG8_MMA(1, 0, At, B0); PG8_BAR; PG8_SCHED;
            PG8_STAGE(PG8_SB(0, 1), b2 + hstep, voffB);
            PG8_WAIT_V(6); PG8_BAR; PG8_MMA(1, 1, At, B1); PG8_BAR;
            PG8_LDB(B0, 1, 0); PG8_SCHED; PG8_LDA(At, 1, 0); PG8_STAGE(PG8_SA(0, 1), a2 + hstep, voffA);
            PG8_WAIT_L(8); PG8_BAR; PG8_WAIT_L(0); PG8_MMA(0, 0, At, B0); PG8_BAR; PG8_SCHED;
            PG8_LDB(B1, 1, 1); PG8_STAGE(PG8_SB(1, 0), b3, voffB);
            PG8_BAR; PG8_WAIT_L(0); PG8_MMA(0, 1, At, B1); PG8_BAR;
            PG8_LDA(At, 1, 1); PG8_STAGE(PG8_SA(1, 0), a3, voffA);
            PG8_BAR; PG8_WAIT_L(0); PG8_MMA(1, 0, At, B0); PG8_BAR; PG8_SCHED;
            PG8_STAGE(PG8_SB(1, 1), b3 + hstep, voffB);
            PG8_WAIT_V(6); PG8_BAR; PG8_MMA(1, 1, At, B1); PG8_BAR;
            }
        }
        if constexpr (ALIGN_EPI) { if (wr == 0) PG8_BAR; }
        if constexpr (!Epi::AFTER_DRAIN) { PG8_PF(8) E(acc, cur, wr, wc, fr, fq); S.done(cur); }
        if (!has_next) break;
#pragma unroll
        for (int a = 0; a < 2; ++a)
#pragma unroll
            for (int b = 0; b < 2; ++b)
#pragma unroll
                for (int m = 0; m < 4; ++m)
#pragma unroll
                    for (int n = 0; n < 2; ++n) acc[a][b][m][n] = (f32x4){0.f, 0.f, 0.f, 0.f};
        cur = nxt; cA = nA; cB = nB; ++ui;
        if constexpr (ALIGN_EPI) { if (wr == 1) PG8_BAR; }
    }
    PG8_WAIT_V(0);
    if constexpr (!ALIGN_EPI) { if (wr == 0) PG8_BAR; }
    PG8_BAR;
    if constexpr (Epi::AFTER_DRAIN) { E.fused(acc, cur, wr, wc, fr, fq, lds, wid, lane); S.done(cur); }
#undef PG8_SA
#undef PG8_SB
#undef PG8_STAGE
#undef PG8_LDA
#undef PG8_LDB
#undef PG8_MMA
#undef PG8_WAIT_V
#undef PG8_WAIT_L
#undef PG8_BAR
#undef PG8_SCHED
}
}

#ifndef PG8_SP2
#define PG8_SP2 true
#endif
#ifndef PG8_ALIGN
#define PG8_ALIGN true
#endif
constexpr size_t MiB = 1u << 20;
constexpr size_t WS_CTL = 0, CTL_ZERO_BYTES = 32768;
constexpr size_t WS_MOD = 2 * MiB;
constexpr size_t MOD_STRIDE = (size_t)33 * DM * 4;
constexpr size_t WS_WT2 = 4 * MiB;
constexpr size_t WS_WT1 = 38 * MiB;
constexpr size_t WS_H = 170 * MiB;
constexpr size_t WS_U = 310 * MiB, WS_G = 378 * MiB, WS_Q = 446 * MiB, WS_SZ = 514 * MiB;
constexpr size_t WS_KA = 582 * MiB, WS_VA = 718 * MiB, WS_END = 854 * MiB;
static_assert(WS_WT2 + (size_t)DM * LDK * 2 <= WS_WT1 && WS_WT1 + (size_t)NIN * LDK * 2 <= WS_H, "d_ws map (weights)");
static_assert(WS_MOD + 3 * MOD_STRIDE <= WS_WT2 && WS_H + (size_t)MT * LDK * 2 <= WS_U && WS_U + (size_t)MT * DC * 2 <= WS_G && WS_KA + (size_t)KROWS * DA * 2 <= WS_VA && WS_VA + (size_t)KROWS * DA * 2 <= WS_END, "d_ws map");
constexpr size_t WS_XN = WS_U;
constexpr size_t WS_PART = WS_Q;
static_assert(WS_XN + (size_t)MT * DM * 2 <= WS_Q && WS_PART + (size_t)4 * MS * DM * 4 <= WS_SZ, "d_ws overlays");
constexpr int CW_TMO = 0, CW_BAR = 4096;
constexpr int RING_OFF = 0, RING_BYTES = 131072;
constexpr int LDSCTL_OFF = RING_BYTES, MISC_OFF = LDSCTL_OFF + 320;
constexpr int LDS_BYTES = 147456;
constexpr int NWAVES = 8;

#define GAS __attribute__((address_space(1)))
#define LAS __attribute__((address_space(3)))
typedef unsigned short bf16;
typedef unsigned v4u __attribute__((ext_vector_type(4)));
typedef unsigned v2u __attribute__((ext_vector_type(2)));
typedef float f32x4 __attribute__((ext_vector_type(4)));
typedef float f32x16 __attribute__((ext_vector_type(16)));
typedef short bf16x8 __attribute__((ext_vector_type(8)));
typedef short s16x4 __attribute__((ext_vector_type(4)));
typedef GAS unsigned gu32;
#define RLX_AGENT __ATOMIC_RELAXED, __HIP_MEMORY_SCOPE_AGENT
#define LDS_WAIT() asm volatile("s_waitcnt lgkmcnt(0)" ::: "memory")
#define VM_WAIT() asm volatile("s_waitcnt vmcnt(0)" ::: "memory")
__device__ __forceinline__ unsigned cvtpk(float lo, float hi) { unsigned r; asm volatile("v_cvt_pk_bf16_f32 %0, %1, %2" : "=v"(r) : "v"(lo), "v"(hi)); return r; }
__device__ __forceinline__ float bf2f(unsigned short b) { return __uint_as_float(((unsigned)b) << 16); }
__device__ __forceinline__ float wave_sum(float v) {
#pragma unroll
    for (int o = 1; o < 64; o <<= 1) v += __shfl_xor(v, o);
    return v;
}
#define XB_TMO      128
#define XB_XCNT(j)  (256  + 64 * (j))
#define XB_XSUB(j)  (1280 + 64 * (j))
#define XB_XGEN(j)  (2304 + 64 * (j))
#define XB_TOP      3328
#define XB_TOPGEN   3392
#define XCD_BAR_WORDS 3456
#define XB_SPIN_CAP (1u << 18)

__device__ __forceinline__ unsigned xb_ld(unsigned* p)              { return __hip_atomic_load(p, __ATOMIC_RELAXED, __HIP_MEMORY_SCOPE_AGENT); }
__device__ __forceinline__ unsigned xb_add(unsigned* p, unsigned v) { return __hip_atomic_fetch_add(p, v, __ATOMIC_RELAXED, __HIP_MEMORY_SCOPE_AGENT); }
__device__ __forceinline__ unsigned xb_xcc_id() { return (unsigned)__builtin_amdgcn_s_getreg((3 << 11) | 20) & 0xFu; }
#define XB_SPIN(cond, bar) do { unsigned _sp = 0; while (cond) { __builtin_amdgcn_s_sleep(1); \
    if ((++_sp & 255u) == 0u) { if (xb_ld(&(bar)[XB_TMO])) break; if (_sp > XB_SPIN_CAP) { atomicAdd(&(bar)[XB_TMO], 1u); break; } } } } while (0)

struct XcdBarrier {
    unsigned* bar; unsigned x;
    volatile LAS unsigned* st;
};

__device__ __forceinline__ XcdBarrier xcd_barrier_post(unsigned* bar, volatile LAS unsigned* st) {
    XcdBarrier b; b.bar = bar; b.x = xb_xcc_id(); b.st = st;
    if (threadIdx.x == 0) (void)xb_add(&bar[XB_XCNT(b.x)], 1u);
    return b;
}
__device__ __forceinline__ void xcd_barrier_complete(unsigned* bar, unsigned x, unsigned& nloc, unsigned& nx) {
    const unsigned G = gridDim.x * gridDim.y * gridDim.z;
    unsigned sum, cnt, mine, sp = 0u;
    for (;;) {
        sum = 0u; cnt = 0u; mine = 0u;
#pragma unroll
        for (unsigned j = 0; j < 16; ++j) { const unsigned c = xb_ld(&bar[XB_XCNT(j)]); sum += c; cnt += (c > 0u) ? 1u : 0u; mine = (j == x) ? c : mine; }
        if (sum == G) break;
        __builtin_amdgcn_s_sleep(1);
        if ((++sp & 255u) == 0u) { if (xb_ld(&bar[XB_TMO])) break; if (sp > XB_SPIN_CAP) { atomicAdd(&bar[XB_TMO], 1u); break; } }
    }
    nloc = mine > 0u ? mine : 1u; nx = cnt > 0u ? cnt : 1u;
}

__device__ __forceinline__ void xcd_barrier(const XcdBarrier& b) {
    asm volatile("s_waitcnt vmcnt(0)" ::: "memory");
    __syncthreads();
    if (threadIdx.x == 0) {
        unsigned* bar = b.bar;
        __builtin_amdgcn_s_waitcnt(0);
        unsigned nloc = b.st[0], nx = b.st[1];
        if (nloc == 0u) { xcd_barrier_complete(bar, b.x, nloc, nx); b.st[0] = nloc; b.st[1] = nx; }
        const unsigned old = xb_add(&bar[XB_XSUB(b.x)], 1u);
        const unsigned gen = old / nloc;
        if (old + 1u == (gen + 1u) * nloc) {
            __builtin_amdgcn_fence(__ATOMIC_RELEASE, "agent");
            asm volatile("s_waitcnt vmcnt(0)" ::: "memory");
            const unsigned og = xb_add(&bar[XB_TOP], 1u);
            const unsigned tg = og / nx;
            if (og + 1u == (tg + 1u) * nx) xb_add(&bar[XB_TOPGEN], 1u);
            else XB_SPIN(xb_ld(&bar[XB_TOPGEN]) == tg, bar);
            __builtin_amdgcn_fence(__ATOMIC_ACQUIRE, "agent");
            xb_add(&bar[XB_XGEN(b.x)], 1u);
            asm volatile("s_waitcnt vmcnt(0)" ::: "memory");
        } else {
            XB_SPIN(xb_ld(&bar[XB_XGEN(b.x)]) == gen, bar);
            __builtin_amdgcn_fence(__ATOMIC_ACQUIRE, "agent");
            asm volatile("s_waitcnt vmcnt(0)" ::: "memory");
        }
    }
    __syncthreads();
}

struct Frame {
    LAS unsigned char* lds;
    volatile LAS unsigned* MISC;
    gu32* ctl;
    int tid, lane, wave, vcu, G;
    const float *x_prompt, *x_sample, *cache_k, *cache_v, *cache_conv, *c_prompt, *c_sample, *g_norm, *w_ada, *b_ada, *w_in, *conv_w, *conv_b, *rel_bias, *w_out, *g_final;
    float* out;
    float *modA, *modB, *gate;
    bf16 *WT1, *WT2, *H, *MIX, *U, *Gc, *Q, *SZ, *KA, *VA, *XN; float* PART;
};

__device__ __forceinline__ int win_src_col(int np) {
    const int tile = np >> 8, r = np & 255, half = r >> 7, c = r & 127;
    if (tile < 16) return (half ? 4096 : 0) + 128 * tile + c;
    if (tile < 32) return (half ? 6144 : 2048) + 128 * (tile - 16) + c;
    return np;
}
__device__ __forceinline__ void p0_transpose_item(const float* W, int K, int N, bf16* WT, int k0, int src_n0, int dst_n0, LAS float* scr, int lane) {
    const float* wp = W + (size_t)(k0 + (lane >> 3)) * N + src_n0 + 4 * (lane & 7); f32x4 v[8];
#pragma unroll
    for (int i = 0; i < 8; ++i) v[i] = *(const GAS f32x4*)(wp + (size_t)(8 * i) * N);
#pragma unroll
    for (int i = 0; i < 8; ++i) { LAS float* d = scr + (8 * i + (lane >> 3)) * 33 + 4 * (lane & 7); d[0] = v[i][0]; d[1] = v[i][1]; d[2] = v[i][2]; d[3] = v[i][3]; }
    LDS_WAIT(); asm volatile("" ::: "memory");
    const int c = lane & 7;
#pragma unroll
    for (int j = 0; j < 4; ++j) { const int n = (lane >> 3) + 8 * j; const LAS float* s = scr + (8 * c) * 33 + n;
        v4u o; o.x = cvtpk(s[0 * 33], s[1 * 33]); o.y = cvtpk(s[2 * 33], s[3 * 33]); o.z = cvtpk(s[4 * 33], s[5 * 33]); o.w = cvtpk(s[6 * 33], s[7 * 33]);
        *(GAS v4u*)(WT + (size_t)(dst_n0 + n) * LDK + k0 + 8 * c) = o; }
    LDS_WAIT(); asm volatile("" ::: "memory");
}
__device__ __forceinline__ void p0_ada_task(Frame& F, int task) {
    int tid_ = F.tid; asm volatile("" : "+v"(tid_));
    const int n0 = 64 * task, lane = tid_ & 63, w = F.wave, q = lane & 15, r = lane >> 4;
    LAS float* cs = (LAS float*)(F.lds + RING_OFF + w * 8704);
    f32x4 acc[2][4]; float ap[4] = {0.f, 0.f, 0.f, 0.f};
#pragma unroll
    for (int h = 0; h < 2; ++h)
#pragma unroll
        for (int e = 0; e < 4; ++e) acc[h][e] = (f32x4){0.f, 0.f, 0.f, 0.f};
    const float* wbase = F.w_ada + (size_t)r * (3 * DM) + n0 + 4 * q;
#define ADA_LOADW(WV, bt) do { _Pragma("unroll") for (int i = 0; i < 8; ++i) WV[i] = *(const GAS f32x4*)(wbase + (size_t)(512 * w + 32 * (bt) + 4 * i) * (3 * DM)); } while (0)
#define ADA_LOADC(ch) do { const int k0_ = 512 * w + 64 * (ch); _Pragma("unroll") for (int j = 0; j < 8; ++j) { const int idx = j * 64 + lane; \
        cr[j] = *(const GAS f32x4*)(F.c_sample + (size_t)(idx >> 4) * DM + k0_ + 4 * (idx & 15)); } cpr = F.c_prompt[k0_ + lane]; } while (0)
#define ADA_MMA(WV, hb) do { _Pragma("unroll") for (int i = 0; i < 8; ++i) { const int kk = 4 * (8 * (hb) + i) + r; \
        const float a0 = cs[q * 65 + kk], a1 = cs[(q + 16) * 65 + kk], cp = cs[32 * 65 + kk]; \
        _Pragma("unroll") for (int e = 0; e < 4; ++e) { acc[0][e] = __builtin_amdgcn_mfma_f32_16x16x4f32(a0, WV[i][e], acc[0][e], 0, 0, 0); \
            acc[1][e] = __builtin_amdgcn_mfma_f32_16x16x4f32(a1, WV[i][e], acc[1][e], 0, 0, 0); ap[e] = fmaf(cp, WV[i][e], ap[e]); } } } while (0)
    f32x4 wvA[8], wvB[8], cr[8]; float cpr;
    ADA_LOADC(0); ADA_LOADW(wvA, 0);
    for (int ch = 0; ch < 8; ++ch) {
#pragma unroll
        for (int j = 0; j < 8; ++j) { const int idx = j * 64 + lane; LAS float* d = cs + (idx >> 4) * 65 + 4 * (idx & 15); d[0] = cr[j][0]; d[1] = cr[j][1]; d[2] = cr[j][2]; d[3] = cr[j][3]; }
        cs[32 * 65 + lane] = cpr;
        LDS_WAIT(); asm volatile("" ::: "memory");
        if (ch + 1 < 8) ADA_LOADC(ch + 1);
        ADA_LOADW(wvB, 2 * ch + 1);
        ADA_MMA(wvA, 0);
        if (ch + 1 < 8) ADA_LOADW(wvA, 2 * ch + 2);
        ADA_MMA(wvB, 1);
        LDS_WAIT(); asm volatile("" ::: "memory");
    }
#undef ADA_LOADW
#undef ADA_LOADC
#undef ADA_MMA
#pragma unroll
    for (int e = 0; e < 4; ++e) { ap[e] += __shfl_xor(ap[e], 16); ap[e] += __shfl_xor(ap[e], 32); }
#pragma unroll
    for (int h = 0; h < 2; ++h)
#pragma unroll
        for (int e = 0; e < 4; ++e)
#pragma unroll
            for (int i = 0; i < 4; ++i) cs[(16 * h + 4 * r + i) * 64 + 4 * q + e] = acc[h][e][i];
    if (r == 0) {
#pragma unroll
        for (int e = 0; e < 4; ++e) cs[32 * 64 + 4 * q + e] = ap[e]; }
    LDS_WAIT(); __syncthreads();
    for (int idx = F.tid; idx < 33 * 64; idx += NWAVES * 64) {
        float s = 0.f;
#pragma unroll
        for (int qq = 0; qq < 8; ++qq) s += ((LAS float*)(F.lds + RING_OFF + qq * 8704))[idx];
        const int rr = idx >> 6, col = n0 + (idx & 63), bb = (rr == 32) ? 0 : 1 + rr;
        s += F.b_ada[col];
        if (col < DM) F.modB[(size_t)bb * DM + col] = s;
        else if (col < 2 * DM) F.modA[(size_t)bb * DM + col - DM] = F.g_norm[col - DM] * (1.f + s);
        else F.gate[(size_t)bb * DM + col - 2 * DM] = s;
    }
    __syncthreads();
}
__device__ __forceinline__ void p0_prologue(Frame& F, int mode) {
    constexpr int N_ADA = 3 * DM / 64;
    if (mode != 2) for (int t = F.vcu; t < N_ADA; t += F.G) p0_ada_task(F, t);
    if (mode == 1) return;
    LAS float* scr = (LAS float*)(F.lds + RING_OFF + F.wave * 16384);
    int tid_ = F.tid; asm volatile("" : "+v"(tid_));
    const int gw = F.vcu * NWAVES + F.wave, NGW = F.G * NWAVES, lane = tid_ & 63;
    constexpr int I_IN = (DM / 64) * (NIN / 32), I_OUT = (DM / 64) * (DM / 32);
    constexpr int NITEMS = I_IN + I_OUT;
    for (int it = gw; it < NITEMS; it += NGW) {
        int r = it;
        if (r < I_IN) { const int nblk = NIN / 32, kb = r / nblk, nb = r % nblk; p0_transpose_item(F.w_in, DM, NIN, F.WT1, 64 * kb, win_src_col(32 * nb), 32 * nb, scr, lane); continue; } r -= I_IN;
        { const int nblk = DM / 32, kb = r / nblk, nb = r % nblk; p0_transpose_item(F.w_out, DM, DM, F.WT2, 64 * kb, 32 * nb, 32 * nb, scr, lane); }
    }
}
__device__ __forceinline__ void p1_hrows(Frame& F) {
    int tid_ = F.tid; asm volatile("" : "+v"(tid_));
    const int gw = F.vcu * NWAVES + F.wave, NGW = F.G * NWAVES, lane = tid_ & 63;
    f32x4 A[16], B[16]; int cur_bb = -1;
    for (int m = gw; m < MT; m += NGW) {
        const float* xrow = m < MP ? F.x_prompt + (size_t)m * DM : F.x_sample + (size_t)(m - MP) * DM;
        const int bb = m < MP ? 0 : 1 + ((m - MP) >> 5);
        const GAS f32x4* xr = (const GAS f32x4*)xrow + lane;
        f32x4 v[16];
#pragma unroll
        for (int j = 0; j < 16; ++j) v[j] = xr[64 * j];
        if (bb != cur_bb) { cur_bb = bb;
            const GAS f32x4* ar = (const GAS f32x4*)(F.modA + (size_t)bb * DM) + lane; const GAS f32x4* br = (const GAS f32x4*)(F.modB + (size_t)bb * DM) + lane;
#pragma unroll
            for (int j = 0; j < 16; ++j) { A[j] = ar[64 * j]; B[j] = br[64 * j]; } }
        float s = 0.f;
#pragma unroll
        for (int j = 0; j < 16; ++j) s += (v[j].x * v[j].x + v[j].y * v[j].y) + (v[j].z * v[j].z + v[j].w * v[j].w);
        const float rstd = 1.0f / sqrtf(wave_sum(s) * (1.f / DM) + NORM_EPS);
        GAS v2u* o8 = (GAS v2u*)(F.H + (size_t)m * LDK) + lane;
#pragma unroll
        for (int j = 0; j < 16; ++j) { const f32x4 hv = (v[j] * rstd) * A[j] + B[j]; v2u o; o.x = cvtpk(hv.x, hv.y); o.y = cvtpk(hv.z, hv.w); o8[64 * j] = o; }
    }
}
__device__ __forceinline__ void p5_final(Frame& F, bool splitk) {
    int tid_ = F.tid; asm volatile("" : "+v"(tid_));
    const int gw = F.vcu * NWAVES + F.wave, NGW = F.G * NWAVES, lane = tid_ & 63;
    f32x4 gf[16];
#pragma unroll
    for (int j = 0; j < 8; ++j) { gf[2 * j] = *(const GAS f32x4*)(F.g_final + 512 * j + 8 * lane); gf[2 * j + 1] = *(const GAS f32x4*)(F.g_final + 512 * j + 8 * lane + 4); }
    for (int m = gw; m < MT; m += NGW) {
        f32x4 v[16];
        if (m >= MP && splitk) {
            const float* xr = F.x_sample + (size_t)(m - MP) * DM + 8 * lane; const float* gr = F.gate + (size_t)(1 + ((m - MP) >> 5)) * DM + 8 * lane;
            const float* pr = F.PART + (size_t)(m - MP) * DM + 8 * lane;
#pragma unroll
            for (int j = 0; j < 16; ++j) { const int o = 512 * (j >> 1) + 4 * (j & 1);
                const f32x4 p0 = *(const GAS f32x4*)(pr + o), p1 = *(const GAS f32x4*)(pr + (size_t)MS * DM + o), p2 = *(const GAS f32x4*)(pr + (size_t)2 * MS * DM + o), p3 = *(const GAS f32x4*)(pr + (size_t)3 * MS * DM + o);
                v[j] = *(const GAS f32x4*)(xr + o) + *(const GAS f32x4*)(gr + o) * ((p0 + p1) + (p2 + p3)); }
        } else {
            const bf16* xn = F.XN + (size_t)m * DM + 8 * lane; v4u w[8];
            const float* xr = (m < MP ? F.x_prompt + (size_t)m * DM : F.x_sample + (size_t)(m - MP) * DM) + 8 * lane;
#pragma unroll
            for (int j = 0; j < 8; ++j) w[j] = *(const GAS v4u*)(xn + 512 * j);
#pragma unroll
            for (int j = 0; j < 16; ++j) v[j] = *(const GAS f32x4*)(xr + 512 * (j >> 1) + 4 * (j & 1));
#pragma unroll
            for (int j = 0; j < 8; ++j) { v[2 * j] += (f32x4){__uint_as_float(w[j].x << 16), __uint_as_float(w[j].x & 0xffff0000u), __uint_as_float(w[j].y << 16), __uint_as_float(w[j].y & 0xffff0000u)};
                v[2 * j + 1] += (f32x4){__uint_as_float(w[j].z << 16), __uint_as_float(w[j].z & 0xffff0000u), __uint_as_float(w[j].w << 16), __uint_as_float(w[j].w & 0xffff0000u)}; }
        }
        float s = 0.f;
#pragma unroll
        for (int j = 0; j < 16; ++j) s += (v[j].x * v[j].x + v[j].y * v[j].y) + (v[j].z * v[j].z + v[j].w * v[j].w);
        const float rstd = 1.0f / sqrtf(wave_sum(s) * (1.f / DM) + NORM_EPS);
        float* yr = F.out + (size_t)m * DM + 8 * lane;
#pragma unroll
        for (int j = 0; j < 16; ++j) *(GAS f32x4*)(yr + 512 * (j >> 1) + 4 * (j & 1)) = (v[j] * rstd) * gf[j];
    }
}
namespace att {
constexpr int SHM_V = 16384, SHM_K = 16384, OFF_V = 0, OFF_K = 4 * SHM_V, OFF_BT = RING_BYTES + 8192;
static_assert(OFF_K + 4 * SHM_K <= RING_BYTES && OFF_BT + 2560 <= LDS_BYTES, "attention LDS map");
constexpr float THRL = 8.f * 1.4426950408889634f;
#define KSWZ(row, colB) ((row) * 256 + ((colB) ^ (((row) & 7) << 4)))
#define SBAR() __builtin_amdgcn_sched_barrier(0)
__device__ __forceinline__ int crow(int r, int hi) { return (r & 3) + 8 * (r >> 2) + 4 * hi; }
__device__ __forceinline__ int v_st(int k, int c) { const int kk = (k & ~0xC) | ((k & 4) << 1) | ((k & 8) >> 1); return ((kk >> 3) * 4 + (c >> 5)) * 512 + ((kk & 7) * 32 + (c & 31)) * 2; }
__device__ __forceinline__ int v_rd_base(int lane) { return ((lane & 3) << 3) | (((lane >> 2) & 3) << 6) | (((lane >> 4) & 1) << 5) | (((lane >> 5) & 1) << 8); }
constexpr int v_rd_off(int d0, int ks, int half) { return d0 * 512 + ks * 4096 + half * 2048; }
template <int OFF> __device__ __forceinline__ s16x4 tr_read(int vb) { s16x4 r; asm volatile("ds_read_b64_tr_b16 %0, %1 offset:%2" : "=&v"(r) : "v"(vb), "i"(OFF) : "memory"); return r; }
#define PK(L, H) (bf16x8){L[0], L[1], L[2], L[3], H[0], H[1], H[2], H[3]}
#define RD8(D0, X) const s16x4 X##l0 = tr_read<v_rd_off(D0, 0, 0)>(vb), X##h0 = tr_read<v_rd_off(D0, 0, 1)>(vb), X##l1 = tr_read<v_rd_off(D0, 1, 0)>(vb), X##h1 = tr_read<v_rd_off(D0, 1, 1)>(vb), \
                            X##l2 = tr_read<v_rd_off(D0, 2, 0)>(vb), X##h2 = tr_read<v_rd_off(D0, 2, 1)>(vb), X##l3 = tr_read<v_rd_off(D0, 3, 0)>(vb), X##h3 = tr_read<v_rd_off(D0, 3, 1)>(vb)
#define MM4(OD, X) do { OD = __builtin_amdgcn_mfma_f32_32x32x16_bf16(PK(X##l0, X##h0), pa0, OD, 0, 0, 0); OD = __builtin_amdgcn_mfma_f32_32x32x16_bf16(PK(X##l1, X##h1), pa1, OD, 0, 0, 0); \
                        OD = __builtin_amdgcn_mfma_f32_32x32x16_bf16(PK(X##l2, X##h2), pa2, OD, 0, 0, 0); OD = __builtin_amdgcn_mfma_f32_32x32x16_bf16(PK(X##l3, X##h3), pa3, OD, 0, 0, 0); } while (0)
__device__ __forceinline__ void pv_all(f32x16 (&o)[4], int vb, bf16x8 pa0, bf16x8 pa1, bf16x8 pa2, bf16x8 pa3) {
  RD8(0, a); RD8(1, b);
  asm volatile("s_waitcnt lgkmcnt(8)" ::: "memory"); SBAR(); MM4(o[0], a); SBAR();
  RD8(2, c);
  asm volatile("s_waitcnt lgkmcnt(8)" ::: "memory"); SBAR(); MM4(o[1], b); SBAR();
  RD8(3, d);
  asm volatile("s_waitcnt lgkmcnt(8)" ::: "memory"); SBAR(); MM4(o[2], c); SBAR();
  asm volatile("s_waitcnt lgkmcnt(0)" ::: "memory"); SBAR(); MM4(o[3], d);
}
#undef PK
#undef RD8
#undef MM4
struct AUnit { int h, qrow0, krow0, t0, T, ts, sample, probe; };
__device__ __forceinline__ void attn_unit(Frame& F, char* lds, const AUnit u) {
  int tid_ = F.tid; asm volatile("" : "+v"(tid_));
  const int tid = tid_, wid = F.wave, lane = tid & 63, r32 = lane & 31, hi = lane >> 5;
  bf16* V_lds = (bf16*)(lds + OFF_V); bf16* K_lds = (bf16*)(lds + OFF_K);
  float* btab = (float*)(lds + OFF_BT);
  for (int i = tid; i < 640; i += 512) { const int bi = i + 192 < 512 ? i + 192 : 512; btab[i] = F.rel_bias[u.h * 513 + bi] * LOG2E; }
  const bool wact = u.sample ? (wid == 0) : true;
  const int lo = u.sample ? 0 : (wid >> 1), hi_t = lo + 8, ibase = u.sample ? 0 : 32 * (wid & 1);
  const int qrow = u.qrow0 + (u.sample ? 0 : 32 * wid);
  float m_reg = -1e30f, l_reg = 0.f; f32x16 o[4] = {}; bf16x8 qr[8];
  { const bf16* Qw = F.Q + (size_t)(qrow + r32) * DA + u.h * HD + hi * 8;
#pragma unroll
    for (int d0 = 0; d0 < 8; ++d0) qr[d0] = *(const bf16x8*)(Qw + d0 * 16); }
  const int sr = tid >> 4, sc = (tid & 15) * 8, vst0 = v_st(sr, sc), vst1 = v_st(32 + sr, sc);
  const int vb0 = (int)(uintptr_t)V_lds + v_rd_base(lane);
  bf16x8 xv0, xv1, xk0, xk1, yv0, yv1, yk0, yk1;
#define SLOAD(S, t) do { const size_t off_ = (size_t)(u.krow0 + 64 * (t) + sr) * DA + u.h * HD + sc; \
    S##v0 = *(const bf16x8*)(F.VA + off_); S##v1 = *(const bf16x8*)(F.VA + off_ + 32 * DA); S##k0 = *(const bf16x8*)(F.KA + off_); S##k1 = *(const bf16x8*)(F.KA + off_ + 32 * DA); } while (0)
#define SWRITE(b, S) do { *(bf16x8*)((char*)V_lds + (b) * SHM_V + vst0) = S##v0; *(bf16x8*)((char*)V_lds + (b) * SHM_V + vst1) = S##v1; const int kc = sc * 2; \
    *(bf16x8*)((char*)K_lds + (b) * SHM_K + KSWZ(sr, kc)) = S##k0; *(bf16x8*)((char*)K_lds + (b) * SHM_K + KSWZ(32 + sr, kc)) = S##k1; } while (0)
#define WGBAR() do { asm volatile("s_waitcnt lgkmcnt(0)" ::: "memory"); __builtin_amdgcn_s_barrier(); asm volatile("" ::: "memory"); } while (0)
  const int ns = u.T - u.t0;
#define TILE_AT(s_) (u.ts + (s_) < u.T ? u.ts + (s_) : u.ts + (s_) - ns)
  SLOAD(x, u.ts); SLOAD(y, TILE_AT(1)); SWRITE(0, x); SWRITE(1, y);
#define COMPUTE(t, cur) do { if (wact && (t) >= lo && (t) <= hi_t && !(u.probe & 1)) { \
      const int dt = (t) - lo; f32x16 p0, p1; \
      if (dt <= 3) { const float c = btab[639]; _Pragma("unroll") for (int r = 0; r < 16; ++r) { p0[r] = c; p1[r] = c; } } \
      else { const float* bp = btab + (517 - 64 * dt + ibase + r32 - 4 * hi); \
        _Pragma("unroll") for (int r = 0; r < 16; ++r) { const int kk = (r & 3) + 8 * (r >> 2); p0[r] = bp[59 - kk]; p1[r] = bp[27 - kk]; } } \
      if (u.sample && (t) == 8) { _Pragma("unroll") for (int r = 0; r < 16; ++r) p1[r] = -1e30f; } \
      { const bf16* Ks = (const bf16*)((const char*)K_lds + (cur) * SHM_K); \
        _Pragma("unroll") for (int d0 = 0; d0 < 8; ++d0) { const int cb = (d0 * 16 + hi * 8) * 2; \
          const bf16x8 b0 = *(const bf16x8*)((const char*)Ks + KSWZ(r32, cb)), b1 = *(const bf16x8*)((const char*)Ks + KSWZ(32 + r32, cb)); \
          p0 = __builtin_amdgcn_mfma_f32_32x32x16_bf16(b0, qr[d0], p0, 0, 0, 0); \
          p1 = __builtin_amdgcn_mfma_f32_32x32x16_bf16(b1, qr[d0], p1, 0, 0, 0); } } \
      float pmax = p0[0]; \
      _Pragma("unroll") for (int r = 1; r < 16; ++r) pmax = fmaxf(pmax, p0[r]); \
      _Pragma("unroll") for (int r = 0; r < 16; ++r) pmax = fmaxf(pmax, p1[r]); \
      { auto rr = __builtin_amdgcn_permlane32_swap(__float_as_uint(pmax), __float_as_uint(pmax), false, false); pmax = fmaxf(__uint_as_float(rr[0]), __uint_as_float(rr[1])); } \
      float mn, alpha; \
      if (__all(pmax - m_reg <= THRL)) { mn = m_reg; alpha = 1.f; } \
      else { mn = fmaxf(m_reg, pmax); alpha = __builtin_amdgcn_exp2f(m_reg - mn); m_reg = mn; } \
      float ps = 0.f; \
      _Pragma("unroll") for (int r = 0; r < 16; ++r) { p0[r] = __builtin_amdgcn_exp2f(p0[r] - mn); p1[r] = __builtin_amdgcn_exp2f(p1[r] - mn); ps += p0[r] + p1[r]; } \
      { auto rr = __builtin_amdgcn_permlane32_swap(__float_as_uint(ps), __float_as_uint(ps), false, false); ps = __uint_as_float(rr[0]) + __uint_as_float(rr[1]); } \
      if (__any(alpha < 1.f)) { _Pragma("unroll") for (int d = 0; d < 4; ++d) _Pragma("unroll") for (int r = 0; r < 16; ++r) o[d][r] *= alpha; } \
      l_reg = l_reg * alpha + ps; \
      bf16x8 pa0, pa1, pa2, pa3; \
      PK4(p0, 0, pa0); PK4(p0, 8, pa1); PK4(p1, 0, pa2); PK4(p1, 8, pa3); \
      pv_all(o, vb0 + (cur) * SHM_V, pa0, pa1, pa2, pa3); } } while (0)
#define PK4(P, BASE, OUT) do { unsigned a0 = cvtpk(P[BASE + 0], P[BASE + 1]), a1 = cvtpk(P[BASE + 2], P[BASE + 3]);   \
    unsigned b0 = cvtpk(P[BASE + 4], P[BASE + 5]), b1 = cvtpk(P[BASE + 6], P[BASE + 7]);                              \
    auto r0 = __builtin_amdgcn_permlane32_swap(a0, b0, false, false); auto r1 = __builtin_amdgcn_permlane32_swap(a1, b1, false, false); \
    v4u w_ = {r0[0], r1[0], r0[1], r1[1]}; OUT = *reinterpret_cast<bf16x8*>(&w_); } while (0)
#define STEP2(s_, cur) do { WGBAR(); const int ta_ = TILE_AT(s_), tb_ = TILE_AT((s_) + 1); const bool more_ = (s_) + 2 < ns && !(u.probe & 2); \
    if (more_) { SLOAD(x, TILE_AT((s_) + 2)); SLOAD(y, TILE_AT((s_) + 3)); } COMPUTE(ta_, 2 * (cur)); COMPUTE(tb_, 2 * (cur) + 1); \
    if (more_) { SWRITE(2 * ((cur) ^ 1), x); SWRITE(2 * ((cur) ^ 1) + 1, y); } } while (0)
  for (int s = 0; s < ns; s += 4) { STEP2(s, 0); if (s + 2 < ns) STEP2(s + 2, 1); }
#undef TILE_AT
#undef STEP2
#undef PK4
#undef COMPUTE
#undef WGBAR
#undef SLOAD
#undef SWRITE
  if (wact && !(u.probe & 4)) {
    const float rl = __builtin_amdgcn_rcpf(l_reg); const int orow = qrow + r32;
    const bf16* szr = F.SZ + (size_t)orow * DA + u.h * HD + 4 * hi; bf16* mr = F.MIX + (size_t)orow * LDK + DC + u.h * HD + 4 * hi;
    v2u sz[16];
#pragma unroll
    for (int d0 = 0; d0 < 4; ++d0)
#pragma unroll
      for (int g = 0; g < 4; ++g) sz[d0 * 4 + g] = *(const GAS v2u*)(szr + d0 * 32 + g * 8);
#pragma unroll
    for (int d0 = 0; d0 < 4; ++d0)
#pragma unroll
      for (int g = 0; g < 4; ++g) { const v2u z = sz[d0 * 4 + g];
        const float v0 = o[d0][4 * g + 0] * rl * __uint_as_float(z.x << 16), v1 = o[d0][4 * g + 1] * rl * __uint_as_float(z.x & 0xffff0000u);
        const float v2 = o[d0][4 * g + 2] * rl * __uint_as_float(z.y << 16), v3 = o[d0][4 * g + 3] * rl * __uint_as_float(z.y & 0xffff0000u);
        v2u w; w.x = cvtpk(v0, v1); w.y = cvtpk(v2, v3); *(GAS v2u*)(mr + d0 * 32 + g * 8) = w; }
  }
  __syncthreads();
}
}
namespace att {
constexpr int SOFF_ML = RING_BYTES + 1024, SOFF_BT = SOFF_ML + 8 * 256;
static_assert(SOFF_BT + 2 * 2560 <= LDS_BYTES && SOFF_ML >= MISC_OFF + 128, "sample attention LDS map");
__device__ __forceinline__ void sample_pairs(Frame& F, char* lds, int wg) {
  int tid_ = F.tid; asm volatile("" : "+v"(tid_));
  const int tid = tid_, wid = F.wave, lane = tid & 63, r32 = lane & 31, hi = lane >> 5, q4 = wid & 3, pr = wid >> 2;
  const int pair = 2 * wg + pr, b = pair >> 4, h = pair & 15;
  char* wreg = lds + wid * 16384;
  float* btab = (float*)(lds + SOFF_BT + pr * 2560);
  float* ml = (float*)(lds + SOFF_ML);
  { const int t4 = tid & 255; const int hh = (2 * wg + (tid >> 8)) & 15; float* bt = (float*)(lds + SOFF_BT + (tid >> 8) * 2560);
    for (int i = t4; i < 640; i += 256) { const int bi = i + 192 < 512 ? i + 192 : 512; bt[i] = F.rel_bias[hh * 513 + bi] * LOG2E; } }
  bf16x8 qr[8];
  { const bf16* Qw = F.Q + (size_t)(MP + 32 * b + r32) * DA + h * HD + hi * 8;
#pragma unroll
    for (int d0 = 0; d0 < 8; ++d0) qr[d0] = *(const bf16x8*)(Qw + d0 * 16); }
  float m_reg = -1e30f, l_reg = 0.f; f32x16 o[4] = {};
  const int vb = (int)(uintptr_t)(wreg + 8192) + v_rd_base(lane);
  __syncthreads();
  const int nsub = q4 == 3 ? 5 : 4;
  int kwf[4], kwb[2];
#pragma unroll
  for (int j = 0; j < 4; ++j) kwf[j] = hi * 256 + ((8 * r32) ^ (((2 * j + hi) & 7) << 4));
#pragma unroll
  for (int j = 0; j < 2; ++j) kwb[j] = (lane >> 4) * 256 + ((16 * (lane & 15)) ^ (((4 * j + (lane >> 4)) & 7) << 4));
  const int vwf = hi * 64 + ((4 * r32) >> 5) * 512 + ((4 * r32) & 31) * 2, vwb = (lane >> 4) * 64 + ((8 * (lane & 15)) >> 5) * 512 + ((8 * (lane & 15)) & 31) * 2;
  const unsigned lofs = (unsigned)(hi * (NH * HD) + 4 * r32) * 4u;
  const unsigned lofb = (unsigned)((lane >> 4) * DA + 8 * (lane & 15)) * 2u;
  for (int s = 0; s < nsub; ++s) {
    const int jbase = s < 4 ? 128 * q4 + 32 * s : 512;
    if (s < 4) { const char* kg = (const char*)(F.cache_k + ((size_t)(b * 512 + jbase) * NH + h) * HD);
#pragma unroll
      for (int hf = 0; hf < 2; ++hf) { f32x4 kv[8];
#pragma unroll
        for (int i = 0; i < 8; ++i) kv[i] = *(const GAS f32x4*)(kg + (size_t)(8 * hf + i) * (2 * NH * HD * 4) + lofs);
#pragma unroll
        for (int i = 0; i < 8; ++i) { v2u w; w.x = cvtpk(kv[i][0], kv[i][1]); w.y = cvtpk(kv[i][2], kv[i][3]); *(v2u*)(wreg + kwf[i & 3] + (8 * hf + i) * 512) = w; } } }
    else { const char* kg = (const char*)(F.KA + (size_t)(MP + 32 * b) * DA + h * HD); v4u kv[8];
#pragma unroll
      for (int i = 0; i < 8; ++i) kv[i] = *(const GAS v4u*)(kg + (size_t)i * (4 * DA * 2) + lofb);
#pragma unroll
      for (int i = 0; i < 8; ++i) *(v4u*)(wreg + kwb[i & 1] + i * 1024) = kv[i]; }
    asm volatile("s_waitcnt lgkmcnt(0)" ::: "memory");
    f32x16 p0;
    { const float* bp = btab + (549 + r32 - 4 * hi - jbase);
#pragma unroll
      for (int r = 0; r < 16; ++r) { const int kk = (r & 3) + 8 * (r >> 2); p0[r] = bp[27 - kk]; } }
#pragma unroll
    for (int d0 = 0; d0 < 8; ++d0) { const bf16x8 kf = *(const bf16x8*)(wreg + KSWZ(r32, (d0 * 16 + hi * 8) * 2)); p0 = __builtin_amdgcn_mfma_f32_32x32x16_bf16(kf, qr[d0], p0, 0, 0, 0); }
    float pmax = p0[0];
#pragma unroll
    for (int r = 1; r < 16; ++r) pmax = fmaxf(pmax, p0[r]);
    { auto rr = __builtin_amdgcn_permlane32_swap(__float_as_uint(pmax), __float_as_uint(pmax), false, false); pmax = fmaxf(__uint_as_float(rr[0]), __uint_as_float(rr[1])); }
    float mn, alpha;
    if (__all(pmax - m_reg <= THRL)) { mn = m_reg; alpha = 1.f; }
    else { mn = fmaxf(m_reg, pmax); alpha = __builtin_amdgcn_exp2f(m_reg - mn); m_reg = mn; }
    float ps = 0.f;
#pragma unroll
    for (int r = 0; r < 16; ++r) { p0[r] = __builtin_amdgcn_exp2f(p0[r] - mn); ps += p0[r]; }
    { auto rr = __builtin_amdgcn_permlane32_swap(__float_as_uint(ps), __float_as_uint(ps), false, false); ps = __uint_as_float(rr[0]) + __uint_as_float(rr[1]); }
    if (__any(alpha < 1.f)) {
#pragma unroll
      for (int d = 0; d < 4; ++d)
#pragma unroll
        for (int r = 0; r < 16; ++r) o[d][r] *= alpha; }
    l_reg = l_reg * alpha + ps;
    bf16x8 pa0, pa1;
#define PK4(P, BASE, OUT) do { unsigned a0 = cvtpk(P[BASE + 0], P[BASE + 1]), a1 = cvtpk(P[BASE + 2], P[BASE + 3]);   \
    unsigned b0 = cvtpk(P[BASE + 4], P[BASE + 5]), b1 = cvtpk(P[BASE + 6], P[BASE + 7]);                              \
    auto r0 = __builtin_amdgcn_permlane32_swap(a0, b0, false, false); auto r1 = __builtin_amdgcn_permlane32_swap(a1, b1, false, false); \
    v4u w_ = {r0[0], r1[0], r0[1], r1[1]}; OUT = *reinterpret_cast<bf16x8*>(&w_); } while (0)
    PK4(p0, 0, pa0); PK4(p0, 8, pa1);
#undef PK4
    if (s < 4) { const char* vg = (const char*)(F.cache_v + ((size_t)(b * 512 + jbase) * NH + h) * HD);
#pragma unroll
      for (int hf = 0; hf < 2; ++hf) { f32x4 vv[8];
#pragma unroll
        for (int i = 0; i < 8; ++i) vv[i] = *(const GAS f32x4*)(vg + (size_t)(8 * hf + i) * (2 * NH * HD * 4) + lofs);
#pragma unroll
        for (int i = 0; i < 8; ++i) { v2u w; w.x = cvtpk(vv[i][0], vv[i][1]); w.y = cvtpk(vv[i][2], vv[i][3]);
          *(v2u*)(wreg + 8192 + vwf + hf * 4096 + ((i >> 1) & 1) * 2048 + ((i >> 2) & 1) * 256 + (i & 1) * 128) = w; } } }
    else { const char* vg = (const char*)(F.VA + (size_t)(MP + 32 * b) * DA + h * HD); v4u vn[8];
#pragma unroll
      for (int i = 0; i < 8; ++i) vn[i] = *(const GAS v4u*)(vg + (size_t)i * (4 * DA * 2) + lofb);
#pragma unroll
      for (int i = 0; i < 8; ++i) *(v4u*)(wreg + 8192 + vwb + ((i >> 2) & 1) * 4096 + (i & 1) * 2048 + ((i >> 1) & 1) * 256) = vn[i]; }
    asm volatile("s_waitcnt lgkmcnt(0)" ::: "memory");
#define PK(L, H) (bf16x8){L[0], L[1], L[2], L[3], H[0], H[1], H[2], H[3]}
#define PVB(D0) do { const s16x4 l0 = tr_read<v_rd_off(D0, 0, 0)>(vb), h0 = tr_read<v_rd_off(D0, 0, 1)>(vb), l1 = tr_read<v_rd_off(D0, 1, 0)>(vb), h1 = tr_read<v_rd_off(D0, 1, 1)>(vb); \
      asm volatile("s_waitcnt lgkmcnt(0)" ::: "memory"); SBAR(); \
      o[D0] = __builtin_amdgcn_mfma_f32_32x32x16_bf16(PK(l0, h0), pa0, o[D0], 0, 0, 0); o[D0] = __builtin_amdgcn_mfma_f32_32x32x16_bf16(PK(l1, h1), pa1, o[D0], 0, 0, 0); } while (0)
    PVB(0); PVB(1); PVB(2); PVB(3);
#undef PVB
#undef PK
    asm volatile("s_waitcnt lgkmcnt(0)" ::: "memory");
  }
#pragma unroll
  for (int d0 = 0; d0 < 4; ++d0)
#pragma unroll
    for (int g = 0; g < 4; ++g) *(f32x4*)(wreg + d0 * 4096 + lane * 64 + g * 16) = (f32x4){o[d0][4 * g], o[d0][4 * g + 1], o[d0][4 * g + 2], o[d0][4 * g + 3]};
  if (hi == 0) { ml[wid * 64 + r32] = m_reg; ml[wid * 64 + 32 + r32] = l_reg; }
  asm volatile("s_waitcnt lgkmcnt(0)" ::: "memory"); __syncthreads();
  { float mj[4], lj[4], M = -1e30f;
#pragma unroll
    for (int j = 0; j < 4; ++j) { mj[j] = ml[(4 * pr + j) * 64 + r32]; lj[j] = ml[(4 * pr + j) * 64 + 32 + r32]; M = fmaxf(M, mj[j]); }
    float L = 0.f, wj[4];
#pragma unroll
    for (int j = 0; j < 4; ++j) { wj[j] = __builtin_amdgcn_exp2f(mj[j] - M); L += wj[j] * lj[j]; }
    const float rl = __builtin_amdgcn_rcpf(L);
    f32x4 acc[4];
#pragma unroll
    for (int g = 0; g < 4; ++g) acc[g] = (f32x4){0.f, 0.f, 0.f, 0.f};
#pragma unroll
    for (int j = 0; j < 4; ++j) { const char* pj = lds + (4 * pr + j) * 16384 + q4 * 4096 + lane * 64;
#pragma unroll
      for (int g = 0; g < 4; ++g) acc[g] += *(const f32x4*)(pj + g * 16) * wj[j]; }
    const int orow = MP + 32 * b + r32;
    const bf16* szr = F.SZ + (size_t)orow * DA + h * HD + 32 * q4 + 4 * hi; bf16* mr = F.MIX + (size_t)orow * LDK + DC + h * HD + 32 * q4 + 4 * hi;
    v2u sz[4];
#pragma unroll
    for (int g = 0; g < 4; ++g) sz[g] = *(const GAS v2u*)(szr + g * 8);
#pragma unroll
    for (int g = 0; g < 4; ++g) { const v2u z = sz[g];
      const float v0 = acc[g][0] * rl * __uint_as_float(z.x << 16), v1 = acc[g][1] * rl * __uint_as_float(z.x & 0xffff0000u);
      const float v2 = acc[g][2] * rl * __uint_as_float(z.y << 16), v3 = acc[g][3] * rl * __uint_as_float(z.y & 0xffff0000u);
      v2u w; w.x = cvtpk(v0, v1); w.y = cvtpk(v2, v3); *(GAS v2u*)(mr + g * 8) = w; }
  }
  __syncthreads();
}
}
__device__ __forceinline__ void p3_attention(Frame& F, char* lds, int probe) {
  if (!(probe & 16)) for (int u = F.vcu; u < NH * (MP / 256); u += F.G) { const int h = u >> 6, qb = u & 63; const int t0 = 8 - 4 * qb > 0 ? 8 - 4 * qb : 0;
    const int ts = qb < 2 ? t0 : (20 - 4 * (qb % 3)) % 12;
    att::attn_unit(F, lds, att::AUnit{h, 256 * qb, 256 * qb - 512, t0, 12, ts, 0, probe}); }
  if (!(probe & 8)) for (int wg = F.vcu; wg < NSB * NH / 2; wg += F.G) att::sample_pairs(F, lds, wg);
}
__device__ __forceinline__ void unpack8(const v4u w, float (&f)[8]) {
  f[0] = __uint_as_float(w.x << 16); f[1] = __uint_as_float(w.x & 0xffff0000u); f[2] = __uint_as_float(w.y << 16); f[3] = __uint_as_float(w.y & 0xffff0000u);
  f[4] = __uint_as_float(w.z << 16); f[5] = __uint_as_float(w.z & 0xffff0000u); f[6] = __uint_as_float(w.w << 16); f[7] = __uint_as_float(w.w & 0xffff0000u); }
__device__ __forceinline__ void p3_convmix(Frame& F) {
  const int gw = F.vcu * NWAVES + F.wave, NGW = F.G * NWAVES, lane = F.lane;
  constexpr int RB = 34; static_assert(MT % RB == 0 && (MT / RB) * 4 == 2048, "conv items");
  for (int it = gw; it < (MT / RB) * 4; it += NGW) {
    const int rb = it >> 2, c = 512 * (it & 3) + 8 * lane, r0 = RB * rb;
    float w0[8], w1[8], w2[8], cb[8], um2[8], um1[8];
    { const f32x4 a0 = *(const GAS f32x4*)(F.conv_w + c), a1 = *(const GAS f32x4*)(F.conv_w + c + 4), b0 = *(const GAS f32x4*)(F.conv_w + DC + c), b1 = *(const GAS f32x4*)(F.conv_w + DC + c + 4);
      const f32x4 c0 = *(const GAS f32x4*)(F.conv_w + 2 * DC + c), c1 = *(const GAS f32x4*)(F.conv_w + 2 * DC + c + 4), d0 = *(const GAS f32x4*)(F.conv_b + c), d1 = *(const GAS f32x4*)(F.conv_b + c + 4);
#pragma unroll
      for (int j = 0; j < 4; ++j) { w0[j] = a0[j]; w0[4 + j] = a1[j]; w1[j] = b0[j]; w1[4 + j] = b1[j]; w2[j] = c0[j]; w2[4 + j] = c1[j]; cb[j] = d0[j]; cb[4 + j] = d1[j]; } }
    if (r0 == 0) {
#pragma unroll
      for (int j = 0; j < 8; ++j) { um2[j] = 0.f; um1[j] = 0.f; } }
    else if (r0 > MP && ((r0 - MP) & 31) == 1) { const float* cc = F.cache_conv + (size_t)((r0 - MP) >> 5) * 2 * DC + DC + c;
#pragma unroll
      for (int j = 0; j < 8; ++j) um2[j] = cc[j];
      unpack8(*(const GAS v4u*)(F.U + (size_t)(r0 - 1) * DC + c), um1); }
    else if (r0 >= MP && ((r0 - MP) & 31) == 0) {
#pragma unroll
      for (int j = 0; j < 8; ++j) { um2[j] = 0.f; um1[j] = 0.f; } }
    else { unpack8(*(const GAS v4u*)(F.U + (size_t)(r0 - 2) * DC + c), um2); unpack8(*(const GAS v4u*)(F.U + (size_t)(r0 - 1) * DC + c), um1); }
    for (int g0 = 0; g0 < RB; g0 += 8) {
      const int nr = RB - g0 < 8 ? RB - g0 : 8;
      v4u ur[8], gr[8];
#pragma unroll
      for (int i = 0; i < 8; ++i) if (i < nr) { const size_t ro = (size_t)(r0 + g0 + i) * DC + c; ur[i] = *(const GAS v4u*)(F.U + ro); gr[i] = *(const GAS v4u*)(F.Gc + ro); }
#pragma unroll
      for (int i = 0; i < 8; ++i) if (i < nr) { const int r = r0 + g0 + i; float uu[8], gg[8], ov[8];
        if (r >= MP && ((r - MP) & 31) == 0) { const float* cc = F.cache_conv + (size_t)((r - MP) >> 5) * 2 * DC + c;
#pragma unroll
          for (int j = 0; j < 8; ++j) { um2[j] = cc[j]; um1[j] = cc[DC + j]; } }
        unpack8(ur[i], uu); unpack8(gr[i], gg);
#pragma unroll
        for (int j = 0; j < 8; ++j) { ov[j] = (cb[j] + w0[j] * um2[j] + w1[j] * um1[j] + w2[j] * uu[j]) * gg[j]; um2[j] = um1[j]; um1[j] = uu[j]; }
        v4u o; o.x = cvtpk(ov[0], ov[1]); o.y = cvtpk(ov[2], ov[3]); o.z = cvtpk(ov[4], ov[5]); o.w = cvtpk(ov[6], ov[7]);
        *(GAS v4u*)(F.MIX + (size_t)r * LDK + c) = o; }
    }
  }
}
struct Args { const float* in[16]; float* out; unsigned char* ws; int ph_lo, ph_hi; };
__global__ void __launch_bounds__(NWAVES * 64, 2) fwd(Args args) {
    extern __shared__ __attribute__((aligned(16))) unsigned char lds[];
    Frame F;
    F.lds = (LAS unsigned char*)lds;
    F.MISC = (volatile LAS unsigned*)(F.lds + MISC_OFF);
    F.tid = threadIdx.x; F.lane = F.tid & 63; F.wave = __builtin_amdgcn_readfirstlane(F.tid >> 6);
    F.G = gridDim.x; { const int bx = blockIdx.x; F.vcu = (F.G % 8 == 0) ? (bx % 8) * (F.G / 8) + bx / 8 : bx; }
    unsigned char* ws = args.ws;
    F.ctl = (gu32*)(ws + WS_CTL);
    F.x_prompt = args.in[0]; F.x_sample = args.in[1]; F.cache_k = args.in[2]; F.cache_v = args.in[3]; F.cache_conv = args.in[4]; F.c_prompt = args.in[5]; F.c_sample = args.in[6];
    F.g_norm = args.in[7]; F.w_ada = args.in[8]; F.b_ada = args.in[9]; F.w_in = args.in[10]; F.conv_w = args.in[11]; F.conv_b = args.in[12]; F.rel_bias = args.in[13]; F.w_out = args.in[14]; F.g_final = args.in[15];
    F.out = args.out;
    F.modA = (float*)(ws + WS_MOD); F.modB = (float*)(ws + WS_MOD + MOD_STRIDE); F.gate = (float*)(ws + WS_MOD + 2 * MOD_STRIDE);
    F.WT1 = (bf16*)(ws + WS_WT1); F.WT2 = (bf16*)(ws + WS_WT2); F.H = (bf16*)(ws + WS_H); F.MIX = (bf16*)(ws + WS_H);
    F.U = (bf16*)(ws + WS_U); F.Gc = (bf16*)(ws + WS_G); F.Q = (bf16*)(ws + WS_Q); F.SZ = (bf16*)(ws + WS_SZ); F.KA = (bf16*)(ws + WS_KA); F.VA = (bf16*)(ws + WS_VA); F.XN = (bf16*)(ws + WS_XN); F.PART = (float*)(ws + WS_PART);
    for (int u = F.tid; u < (LDS_BYTES - LDSCTL_OFF) / 4; u += NWAVES * 64) ((LAS unsigned*)(F.lds + LDSCTL_OFF))[u] = 0u;
    __syncthreads();
    XcdBarrier bar; bar.bar = (unsigned*)(F.ctl + CW_BAR); bar.x = 0; bar.st = nullptr;
    if (N_LAUNCHES != PER_PHASE) bar = xcd_barrier_post((unsigned*)(F.ctl + CW_BAR), F.MISC + 8);
#if defined(PROBE_STAMP)
    unsigned long long ta = 0, tb = 0;
#define STAMP(i) do { if ((i) == PROBE_STAMP || (PROBE_STAMP == 100 && (i) == 0)) ta = __builtin_amdgcn_s_memrealtime(); if ((i) == PROBE_STAMP + 1) tb = __builtin_amdgcn_s_memrealtime(); } while (0)
#define GRID_BAR(i) do { if (N_LAUNCHES != PER_PHASE) xcd_barrier(bar); STAMP(i); } while (0)
    STAMP(0);
#else
#define GRID_BAR(i) do { if (N_LAUNCHES != PER_PHASE) xcd_barrier(bar); } while (0)
#endif
    const int lo = args.ph_lo, hi = args.ph_hi;
    const bool splitk = (F.G == 256);
#define IN(k) (lo <= (k) && (k) < hi)
#define BOTH(k) (IN(k) && IN((k) + 1))
#ifndef PROBE_REPEAT
#define PROBE_REPEAT 0
#endif
#define REP(k) ((PROBE_REPEAT >> (4 * (k))) & 15)
#if defined(PROBE_P0SPLIT)
    if (IN(0)) { STAMP(20); p0_prologue(F, 1); xcd_barrier(bar); STAMP(21); p0_prologue(F, 2); GRID_BAR(1); STAMP(22); }
#else
    if (IN(0)) { for (int rep = 0; rep <= REP(0); ++rep) { p0_prologue(F, 0); if (BOTH(0)) GRID_BAR(1); } }
#endif
    if (IN(1)) { for (int rep = 0; rep <= REP(1); ++rep) { p1_hrows(F); if (BOTH(1)) GRID_BAR(2); } }
#if defined(PROBE_MFMA)
    if (IN(2)) {
        const bf16* ha = F.H + (size_t)(blockIdx.x * 64 + F.lane) * LDK + F.wave * 64; const bf16* wb = F.WT1 + (size_t)(blockIdx.x * 64 + F.lane) * LDK + F.wave * 64;
        bf16x8 a[8], b[8];
#pragma unroll
        for (int j = 0; j < 8; ++j) { a[j] = *(const bf16x8*)(ha + 8 * j); b[j] = *(const bf16x8*)(wb + 8 * j); }
        f32x4 acc[16];
#pragma unroll
        for (int j = 0; j < 16; ++j) acc[j] = (f32x4){0.f, 0.f, 0.f, 0.f};
        for (int it = 0; it < 17 * 64 * 4 / PROBE_MFMA; ++it) {
#pragma unroll
            for (int j = 0; j < 16; ++j) acc[j] = __builtin_amdgcn_mfma_f32_16x16x32_bf16(a[j & 7], b[(j >> 1) & 7], acc[j], 0, 0, 0);
        }
        float sacc = 0.f;
#pragma unroll
        for (int j = 0; j < 16; ++j) sacc += acc[j][0] + acc[j][1] + acc[j][2] + acc[j][3];
        if (sacc == 12345.678f) F.ctl[64] = 1u;
        GRID_BAR();
    }
#endif
    for (int rep = 0; rep <= REP(2); ++rep)
    if (IN(2)) {
        pg8::Gemm g{F.H, F.WT1, MT, NIN, DM, LDK};
#if defined(PROBE_GEMM)
        g.probe = rep ? PROBE_GEMM : 0;
#endif
        pg8::EpiIn E{F.U, F.Gc, F.Q, F.SZ, F.KA, F.VA, F.out};
        if (splitk) { typedef pg8::G1_ORDER G1; G1 S; S.init(MT, NIN, DM, (int)blockIdx.x); pg8::gemm_phase<pg8::EpiIn, G1, PG8_ALIGN, PG8_SP2>(F.lds + RING_OFF, g, S, E); }
        else { pg8::StaticOrder S; S.init(MT, NIN, DM, F.G, (int)blockIdx.x); pg8::gemm_phase<pg8::EpiIn, pg8::StaticOrder, PG8_ALIGN, PG8_SP2>(F.lds + RING_OFF, g, S, E); }
        if (BOTH(2)) GRID_BAR(3);
#if defined(PROBE_ADA_LATE)
        STAMP(30); p0_prologue(F, PROBE_ADA_LATE); xcd_barrier(bar); STAMP(31);
#endif
    }
    for (int rep = 0; rep <= REP(3); ++rep)
    if (IN(3)) {
#if defined(PROBE_P3) && PROBE_P3 == 1
        if (rep == 0) p3_convmix(F); p3_attention(F, (char*)lds + RING_OFF, rep ? PROBE_ATT : 0);
#elif defined(PROBE_P3) && PROBE_P3 == 2
        if (rep == 0) p3_attention(F, (char*)lds + RING_OFF, 0); p3_convmix(F);
#elif defined(PROBE_STAMP) && PROBE_STAMP >= 10
#if defined(PROBE_HOTKV)
        p3_attention(F, (char*)lds + RING_OFF, 8); xcd_barrier(bar);
        STAMP(10); p3_attention(F, (char*)lds + RING_OFF, 8 + 4 + PROBE_HOTKV); xcd_barrier(bar); STAMP(11);
#else
        STAMP(10); p3_attention(F, (char*)lds + RING_OFF, 8); xcd_barrier(bar); STAMP(11);
#endif
        p3_attention(F, (char*)lds + RING_OFF, 16); xcd_barrier(bar); STAMP(12); p3_convmix(F); xcd_barrier(bar); STAMP(13);
#else
        p3_attention(F, (char*)lds + RING_OFF, 0); p3_convmix(F);
#endif
        if (BOTH(3)) GRID_BAR(4); }
    for (int rep = 0; rep <= REP(4); ++rep)
    if (IN(4)) {
        pg8::Gemm g{F.MIX, F.WT2, MT, DM, DM, LDK};
#if defined(PROBE_GEMM)
        g.probe = 0;
#endif
        pg8::EpiOut E{F.gate, F.XN, F.PART};
        if (splitk) { pg8::TailSplitOrder S; S.init(F.G, (int)blockIdx.x); pg8::gemm_phase<pg8::EpiOut, pg8::TailSplitOrder, PG8_ALIGN, PG8_SP2>(F.lds + RING_OFF, g, S, E); }
        else { pg8::StaticOrder S; S.init(MT, DM, DM, F.G, (int)blockIdx.x); pg8::gemm_phase<pg8::EpiOut, pg8::StaticOrder, PG8_ALIGN, PG8_SP2>(F.lds + RING_OFF, g, S, E); }
        if (BOTH(4)) GRID_BAR(5);
    }
    if (IN(5)) { p5_final(F, splitk); }
#if defined(PROBE_STAMP)
    STAMP(6);
#if PROBE_STAMP == 100
    tb = __builtin_amdgcn_s_memrealtime();
#endif
    if (blockIdx.x == 0 && F.tid == 0) { const unsigned long long d = tb - ta, te = __builtin_amdgcn_s_memrealtime();
        while (__builtin_amdgcn_s_memrealtime() - te < 4ull * d) __builtin_amdgcn_s_sleep(32); }
#endif
#undef IN
#undef BOTH
}

extern "C" void kernel_launch(void* const* d_in, const int* in_sizes, int n_in, void* d_out, int out_size, void* d_ws, size_t ws_size, hipStream_t stream) {
    static int grid = 0;
    if (grid == 0) {
        if (n_in != 16 || in_sizes[0] != MP * DM || out_size != (int)O_END || ws_size < WS_END) {
            fprintf(stderr, "kernel_launch: shape mismatch: n_in %d in0 %d out %d ws %zu (need >= %zu); nothing launched\n", n_in, n_in > 0 ? in_sizes[0] : -1, out_size, ws_size, (size_t)WS_END); grid = -1; return; }
        int dev = 0, cus = 0, per_cu = 0;
        if (hipGetDevice(&dev) != hipSuccess || hipDeviceGetAttribute(&cus, hipDeviceAttributeMultiprocessorCount, dev) != hipSuccess) { fprintf(stderr, "kernel_launch: device query failed\n"); grid = -1; return; }
        if (hipFuncSetAttribute((const void*)fwd, hipFuncAttributeMaxDynamicSharedMemorySize, LDS_BYTES) != hipSuccess) { fprintf(stderr, "kernel_launch: hipFuncSetAttribute failed\n"); grid = -1; return; }
        if (hipOccupancyMaxActiveBlocksPerMultiprocessor(&per_cu, (const void*)fwd, NWAVES * 64, LDS_BYTES) != hipSuccess || per_cu < 1)
            fprintf(stderr, "kernel_launch: note: occupancy query reports %d workgroups per CU\n", per_cu);
        (void)hipGetLastError();
        grid = cus;
    }
    if (grid < 0) return;
    if (hipMemsetAsync((char*)d_ws + WS_CTL, 0, CTL_ZERO_BYTES, stream) != hipSuccess) { fprintf(stderr, "kernel_launch: memset failed\n"); return; }
    Args a{};
    for (int i = 0; i < 16; ++i) a.in[i] = (const float*)d_in[i];
    a.out = (float*)d_out; a.ws = (unsigned char*)d_ws;
    const int nl = (N_LAUNCHES == PER_PHASE) ? PER_PHASE : 1;
    for (int li = 0; li < nl; ++li) {
        a.ph_lo = (N_LAUNCHES == PER_PHASE) ? li : 0; a.ph_hi = (N_LAUNCHES == PER_PHASE) ? li + 1 : PER_PHASE;
        hipLaunchKernelGGL(fwd, dim3(grid), dim3(NWAVES * 64), LDS_BYTES, stream, a);
        const hipError_t le = hipPeekAtLastError();
        if (le != hipSuccess) { fprintf(stderr, "kernel_launch: launch %d failed: %s\n", li, hipGetErrorName(le)); break; }
    }
}
```

```cpp
#include <hip/hip_runtime.h>
#include <cstdio>
#include <cstdint>

#ifndef MK_N_LAUNCHES
#define MK_N_LAUNCHES 1
#endif
constexpr int N_LAUNCHES = MK_N_LAUNCHES;
constexpr int PER_PHASE = 6;

constexpr int DM = 4096, MP = 16384, NSB = 32, NST = 32, MS = NSB * NST, MT = MP + MS;
constexpr int LDK = DM + 64;
constexpr int NIN = 16384, DC = 2048, DA = 2048, NH = 16, HD = 128;
constexpr int KROWS = MT;
constexpr float NORM_EPS = 1e-6f;
constexpr float LOG2E = 1.4426950408889634f;
constexpr float QSCALE = 0.08838834764831845f * LOG2E;
constexpr size_t O_YP = 0, O_YS = (size_t)MP * DM, O_KP = O_YS + (size_t)MS * DM, O_VP = O_KP + 512 * 2048, O_CP = O_VP + 512 * 2048, O_KS = O_CP + 2 * 2048,
                 O_VS = O_KS + (size_t)MS * 2048, O_CS = O_VS + (size_t)MS * 2048, O_END = O_CS + (size_t)NSB * 2 * 2048;
static_assert(O_END == 77729792, "output size");

namespace pg8 {
#define PG8_LAS __attribute__((address_space(3)))
typedef unsigned short bf16_t;
typedef short bf16x8 __attribute__((ext_vector_type(8)));
typedef float f32x4 __attribute__((ext_vector_type(4)));
typedef unsigned u32x4 __attribute__((ext_vector_type(4)));
constexpr int BM = 256, BK = 64, HALF = 128, HTB = HALF * BK * 2  , STAGE_BYTES = 8 * HTB, NXCD = 8, WGM = 8;

__host__ __device__ __forceinline__ int lds_byte(int r, int c) { const int st = (r >> 4) * 2 + (c >> 5), rr = r & 15, cc = c & 31, ob = rr * 64 + cc * 2; return st * 1024 + (ob ^ (((ob >> 9) & 1) << 5)); }
__host__ __device__ __forceinline__ void stage_rc(int b, int& R, int& C) { const int st = b / 1024, sb = b % 1024, swz = sb ^ (((sb >> 9) & 1) << 5); R = (st >> 1) * 16 + swz / 64; C = (st & 1) * 32 + (swz % 64) / 2; }
__host__ __device__ __forceinline__ int perm32(int rho) { const int n = rho >> 4, i = rho & 15; return 8 * (i >> 2) + 4 * n + (i & 3); }

struct Unit { int pm, pn, kb, nt, part; };
struct Gemm { const bf16_t* A; const bf16_t* Bt; int M, N, K, ld;
#if defined(PROBE_GEMM)
    int probe;
#endif
};

struct StaticOrder {
    int nM, nN, nwg, G, c, nK;
#if defined(PROBE_HOT)
    int hot;
#endif
    __host__ __device__ void init(int M, int N, int K, int G_, int c_) { nM = M / BM; nN = N / BM; nK = K / BK; nwg = nM * nN; G = G_; c = c_;
#if defined(PROBE_HOT)
        hot = 0;
#endif
    }
    __host__ __device__ bool next(int i, Unit& u) const {
        const long L = (long)i * G + c; if (L >= nwg) return false;
#if defined(PROBE_HOT)
        if (hot) { const int l = c >> 3; u.pm = l & 7; u.pn = (l >> 3) + PROBE_HOT - 1; return true; }
#endif
        int wgid = (int)L; { const int q = nwg / NXCD, r = nwg % NXCD, xcd = wgid % NXCD, off = wgid / NXCD; wgid = (xcd < r ? xcd * (q + 1) : r * (q + 1) + (xcd - r) * q) + off; }
        const int nig = WGM * nN, gid = wgid / nig, fm = gid * WGM, gsz = (nM - fm) < WGM ? (nM - fm) : WGM;
        u.pm = fm + ((wgid % nig) % gsz); u.pn = (wgid % nig) / gsz; u.kb = 0; u.nt = nK; u.part = -1; return true;
    }
    __device__ __forceinline__ void a_ready(const Unit&) const {}
    __device__ __forceinline__ void done(const Unit&) const {}
};
__device__ __forceinline__ unsigned cvt_pk_bf16(float lo, float hi) { unsigned r; asm volatile("v_cvt_pk_bf16_f32 %0, %1, %2" : "=v"(r) : "v"(lo), "v"(hi)); return r; }
typedef float f32x2 __attribute__((ext_vector_type(2)));
__device__ __forceinline__ float silu_f(float x) { return x * __builtin_amdgcn_rcpf(1.0f + __builtin_amdgcn_exp2f(-1.4426950408889634f * x)); }
__device__ __forceinline__ f32x4 silu4(f32x4 v) { f32x4 r; r[0] = silu_f(v[0]); r[1] = silu_f(v[1]); r[2] = silu_f(v[2]); r[3] = silu_f(v[3]); return r; }
__device__ __forceinline__ u32x4 pack8(f32x4 v0, f32x4 v1) { u32x4 w; w.x = cvt_pk_bf16(v0[0], v0[1]); w.y = cvt_pk_bf16(v0[2], v0[3]); w.z = cvt_pk_bf16(v1[0], v1[1]); w.w = cvt_pk_bf16(v1[2], v1[3]); return w; }
__device__ __forceinline__ int krow_of(int row) { return row; }

struct EpiIn {
    static constexpr bool PERM = true, AFTER_DRAIN = false;
    bf16_t *U, *G, *Q, *SZ, *KA, *VA; float* out;
    __device__ __forceinline__ void operator()(const f32x4 (&acc)[2][2][4][2], const Unit& u, int wr, int wc, int fr, int fq) const {
        const int pn = u.pn, row0 = u.pm * BM + wr * 64 + fr;
        if (pn < 32) {
            const int col = (pn & 15) * 128 + wc * 32 + 8 * fq;
            if (pn < 16) {
#pragma unroll
                for (int ai = 0; ai < 2; ++ai)
#pragma unroll
                    for (int m = 0; m < 4; ++m) { const int row = row0 + ai * HALF + m * 16;
                        const f32x4 v0 = acc[ai][0][m][0] * acc[ai][1][m][0], v1 = acc[ai][0][m][1] * acc[ai][1][m][1];
                        *(u32x4*)(U + (size_t)row * DC + col) = pack8(v0, v1);
                        if (u.pm >= 63) { long o = -1;
                            if (row >= MP) { const int t = row & 31; if (t >= 30) o = (long)O_CS + (long)((((row - MP) >> 5) * 2 + (t - 30)) * 2048); }
                            else if (row >= MP - 2) o = (long)O_CP + (long)((row - (MP - 2)) * 2048);
                            if (o >= 0) { *(f32x4*)(out + o + col) = v0; *(f32x4*)(out + o + col + 4) = v1; } } }
            } else {
#pragma unroll
                for (int ai = 0; ai < 2; ++ai)
#pragma unroll
                    for (int m = 0; m < 4; ++m) { const int row = row0 + ai * HALF + m * 16;
                        const f32x4 v0 = acc[ai][0][m][0] * silu4(acc[ai][1][m][0]), v1 = acc[ai][0][m][1] * silu4(acc[ai][1][m][1]);
                        *(u32x4*)(G + (size_t)row * DC + col) = pack8(v0, v1); }
            }
        } else {
            const int part = (pn - 32) >> 3, colp = ((pn - 32) & 7) * 256 + wc * 32 + 8 * fq;
            if (part == 0) {
#pragma unroll
                for (int ai = 0; ai < 2; ++ai)
#pragma unroll
                    for (int m = 0; m < 4; ++m) { const int row = row0 + ai * HALF + m * 16;
#pragma unroll
                        for (int bj = 0; bj < 2; ++bj) *(u32x4*)(Q + (size_t)row * DA + colp + bj * HALF) = pack8(acc[ai][bj][m][0] * QSCALE, acc[ai][bj][m][1] * QSCALE); }
            } else if (part == 3) {
#pragma unroll
                for (int ai = 0; ai < 2; ++ai)
#pragma unroll
                    for (int m = 0; m < 4; ++m) { const int row = row0 + ai * HALF + m * 16;
#pragma unroll
                        for (int bj = 0; bj < 2; ++bj) *(u32x4*)(SZ + (size_t)row * DA + colp + bj * HALF) = pack8(silu4(acc[ai][bj][m][0]), silu4(acc[ai][bj][m][1])); }
            } else {
                bf16_t* dst = part == 1 ? KA : VA;
                float* odp = out + (part == 1 ? O_KP : O_VP); float* ods = out + (part == 1 ? O_KS : O_VS);
#pragma unroll
                for (int ai = 0; ai < 2; ++ai)
#pragma unroll
                    for (int m = 0; m < 4; ++m) { const int row = row0 + ai * HALF + m * 16; const size_t kr = (size_t)krow_of(row);
#pragma unroll
                        for (int bj = 0; bj < 2; ++bj) { *(u32x4*)(dst + kr * DA + colp + bj * HALF) = pack8(acc[ai][bj][m][0], acc[ai][bj][m][1]);
                            if (u.pm >= 62) { float* o = row >= MP ? ods + (size_t)(row - MP) * DA : odp + (size_t)(row - (MP - 512)) * DA;
                                *(f32x4*)(o + colp + bj * HALF) = acc[ai][bj][m][0]; *(f32x4*)(o + colp + bj * HALF + 4) = acc[ai][bj][m][1]; } } }
            }
        }
    }
};
struct EpiOut {
    static constexpr bool PERM = true, AFTER_DRAIN = false;
    const float* gate; bf16_t* XN; float* PART;
    __device__ __forceinline__ void operator()(const f32x4 (&acc)[2][2][4][2], const Unit& u, int wr, int wc, int fr, int fq) const {
        const int row0 = u.pm * BM + wr * 64 + fr, col = u.pn * BM + wc * 32 + 8 * fq;
        if (u.part >= 0) {
            float* pb = PART + (size_t)u.part * MS * DM;
#pragma unroll
            for (int ai = 0; ai < 2; ++ai)
#pragma unroll
                for (int m = 0; m < 4; ++m) { float* pr = pb + (size_t)(row0 + ai * HALF + m * 16 - MP) * DM + col;
#pragma unroll
                    for (int bj = 0; bj < 2; ++bj) { *(f32x4*)(pr + bj * HALF) = acc[ai][bj][m][0]; *(f32x4*)(pr + bj * HALF + 4) = acc[ai][bj][m][1]; } }
            return;
        }
        if (u.pm < MP / BM) {
            f32x4 g[2][2];
#pragma unroll
            for (int bj = 0; bj < 2; ++bj) { g[bj][0] = *(const f32x4*)(gate + col + bj * HALF); g[bj][1] = *(const f32x4*)(gate + col + bj * HALF + 4); }
#pragma unroll
            for (int ai = 0; ai < 2; ++ai)
#pragma unroll
                for (int m = 0; m < 4; ++m) { bf16_t* yr = XN + (size_t)(row0 + ai * HALF + m * 16) * DM + col;
#pragma unroll
                    for (int bj = 0; bj < 2; ++bj) *(u32x4*)(yr + bj * HALF) = pack8(g[bj][0] * acc[ai][bj][m][0], g[bj][1] * acc[ai][bj][m][1]); }
        } else {
#pragma unroll
            for (int ai = 0; ai < 2; ++ai)
#pragma unroll
                for (int m = 0; m < 4; ++m) { const int row = row0 + ai * HALF + m * 16; const float* gr = gate + (size_t)(1 + ((row - MP) >> 5)) * DM + col; bf16_t* yr = XN + (size_t)row * DM + col;
#pragma unroll
                    for (int bj = 0; bj < 2; ++bj) *(u32x4*)(yr + bj * HALF) = pack8(*(const f32x4*)(gr + bj * HALF) * acc[ai][bj][m][0], *(const f32x4*)(gr + bj * HALF + 4) * acc[ai][bj][m][1]); }
        }
    }
};
template <int XM, int XN, int RM, int RN, bool MFIRST> struct GridOrderT {
    static_assert(XM * XN == 8 && RM * RN == 32, "GridOrderT geometry");
    int nM, nN, nK, c;
    __device__ void init(int M, int N, int K, int c_) { nM = M / BM; nN = N / BM; nK = K / BK; c = c_; }
    __device__ bool next(int i, Unit& u) const {
        constexpr int BMc = XM * RM, BNc = XN * RN;
        const int x = c & 7, k = c >> 3, nq = nN / BNc, ng = (nM & ~15) / BMc, full = ng * nq;
        u.kb = 0; u.nt = nK; u.part = -1;
        if (i < full) { const int g = MFIRST ? i % ng : i / nq, q = MFIRST ? i / ng : i % nq;
            u.pm = BMc * g + RM * (x / XN) + (k % RM); u.pn = BNc * q + RN * (x % XN) + (k / RM); return true; }
        if (i == full && (nM & 15) == 4 && nN == 64) { u.pm = (nM & ~15) + (k & 3); u.pn = 8 * x + (k >> 2); return true; }
        return false;
    }
    __device__ __forceinline__ void a_ready(const Unit&) const {}
    __device__ __forceinline__ void done(const Unit&) const {}
};
typedef GridOrderT<4, 2, 4, 8, false> GridOrder;
#ifndef G1_ORDER
#define G1_ORDER GridOrderT<2, 4, 4, 8, false>
#endif
struct TailSplitOrder {
    GridOrder so; int c;
    __device__ void init(int G, int c_) { so.init(MP, DM, DM, c_); c = c_; (void)G; }
    __device__ bool next(int i, Unit& u) const {
        if (i < 4) return so.next(i, u);
        if (i > 4) return false;
        const int kq = c & 3, r = c >> 2; u.pm = MP / BM + (r & 3); u.pn = r >> 2; u.kb = kq * (DM / 4) * 2; u.nt = DM / 4 / BK; u.part = kq; return true;
    }
    __device__ __forceinline__ void a_ready(const Unit&) const {}
    __device__ __forceinline__ void done(const Unit&) const {}
};
template <class Epi, class Sched, bool ALIGN_EPI = false, bool SP2 = false>
__device__ __forceinline__ void gemm_phase(PG8_LAS unsigned char* lds, const Gemm g, const Sched& S, const Epi& E) {
    int tid_ = threadIdx.x; asm volatile("" : "+v"(tid_));
    const int tid = tid_, wid = __builtin_amdgcn_readfirstlane(tid >> 6), lane = tid & 63, wr = wid >> 2, wc = wid & 3, fr = lane & 15, fq = lane >> 4;
    const int LD = g.ld;
    unsigned voffA[2], voffB[2];
#pragma unroll
    for (int i = 0; i < 2; ++i) { int R, C; stage_rc(tid * 16 + i * 8192, R, C); const int Rb = Epi::PERM ? ((R & ~31) + perm32(R & 31)) : R;
        voffA[i] = (unsigned)(R * LD + C) * 2u; voffB[i] = (unsigned)(Rb * LD + C) * 2u; }
    const size_t kstep = (size_t)(BK * 2);
    const size_t hstep = (size_t)HALF * LD * 2;
    const size_t tstep = 2 * hstep;
    const unsigned ldsw = (unsigned)wid * 1024u;
    const int aoff = lds_byte(wr * 64 + fr, fq * 8), boff = lds_byte(wc * 32 + fr, fq * 8);
#define PG8_SA(b, h) (((b) * 2 + (h)) * HTB)
#define PG8_SB(b, h) ((4 + (b) * 2 + (h)) * HTB)
#if defined(PROBE_GEMM)
    const int pf = g.probe;
#define PG8_PF(b) if (!(pf & (b)))
#else
#define PG8_PF(b)
#endif
#define PG8_STAGE(bufoff, gbase, voff) do { PG8_PF(2) _Pragma("unroll") for (int _i = 0; _i < 2; ++_i) \
        __builtin_amdgcn_global_load_lds((const unsigned*)((const char*)(gbase) + (voff)[_i]), (PG8_LAS unsigned*)(lds + (bufoff) + ldsw + _i * 8192), 16, 0, 0); } while (0)
#define PG8_LDA(dst, b, h) do { _Pragma("unroll") for (int m = 0; m < 4; ++m) _Pragma("unroll") for (int k = 0; k < 2; ++k) dst[m][k] = *(const PG8_LAS bf16x8*)(lds + PG8_SA(b, h) + aoff + m * 2048 + k * 1024); } while (0)
#define PG8_LDB(dst, b, h) do { _Pragma("unroll") for (int n = 0; n < 2; ++n) _Pragma("unroll") for (int k = 0; k < 2; ++k) dst[n][k] = *(const PG8_LAS bf16x8*)(lds + PG8_SB(b, h) + boff + n * 2048 + k * 1024); } while (0)
#define PG8_MMA(ai, bj, At, Bt) do { __builtin_amdgcn_s_setprio(1); PG8_PF(1) _Pragma("unroll") for (int m = 0; m < 4; ++m) _Pragma("unroll") for (int n = 0; n < 2; ++n) _Pragma("unroll") for (int k = 0; k < 2; ++k) \
        acc[ai][bj][m][n] = __builtin_amdgcn_mfma_f32_16x16x32_bf16(Bt[n][k], At[m][k], acc[ai][bj][m][n], 0, 0, 0); __builtin_amdgcn_s_setprio(0); } while (0)
#define PG8_WAIT_V(n) asm volatile("s_waitcnt vmcnt(" #n ")" ::: "memory")
#define PG8_WAIT_L(n) asm volatile("s_waitcnt lgkmcnt(" #n ")" ::: "memory")
#define PG8_BAR __builtin_amdgcn_s_barrier()
#define PG8_SCHED __builtin_amdgcn_sched_barrier(0)
    Unit cur, nxt; int ui = 0;
    if (!S.next(0, cur)) return;
    f32x4 acc[2][2][4][2];
#pragma unroll
    for (int a = 0; a < 2; ++a)
#pragma unroll
        for (int b = 0; b < 2; ++b)
#pragma unroll
            for (int m = 0; m < 4; ++m)
#pragma unroll
                for (int n = 0; n < 2; ++n) acc[a][b][m][n] = (f32x4){0.f, 0.f, 0.f, 0.f};
    bf16x8 At[4][2], B0[2][2], B1[2][2];
    const char* cA = (const char*)g.A + (size_t)cur.pm * tstep + cur.kb; const char* cB = (const char*)g.Bt + (size_t)cur.pn * tstep + cur.kb;
    S.a_ready(cur);
    if constexpr (SP2) {
        PG8_STAGE(PG8_SB(0, 0), cB, voffB); PG8_STAGE(PG8_SB(0, 1), cB + hstep, voffB); PG8_STAGE(PG8_SA(0, 0), cA, voffA); PG8_STAGE(PG8_SA(0, 1), cA + hstep, voffA);
        if (wr == 1) PG8_BAR;
        PG8_WAIT_V(2); PG8_BAR;
        PG8_STAGE(PG8_SB(1, 0), cB + kstep, voffB); PG8_STAGE(PG8_SA(1, 0), cA + kstep, voffA); PG8_STAGE(PG8_SB(1, 1), cB + hstep + kstep, voffB);
        PG8_WAIT_V(6); PG8_BAR;
    } else {
        PG8_STAGE(PG8_SB(0, 0), cB, voffB); PG8_STAGE(PG8_SA(0, 0), cA, voffA); PG8_STAGE(PG8_SB(0, 1), cB + hstep, voffB); PG8_STAGE(PG8_SA(0, 1), cA + hstep, voffA);
        if (wr == 1) PG8_BAR;
        PG8_WAIT_V(4); PG8_BAR;
        PG8_STAGE(PG8_SB(1, 0), cB + kstep, voffB); PG8_STAGE(PG8_SA(1, 0), cA + kstep, voffA); PG8_STAGE(PG8_SB(1, 1), cB + hstep + kstep, voffB);
        PG8_WAIT_V(6); PG8_BAR;
    }
    for (;;) {
        const bool has_next = S.next(ui + 1, nxt);
        const char* nA = has_next ? (const char*)g.A + (size_t)nxt.pm * tstep + nxt.kb : cA; const char* nB = has_next ? (const char*)g.Bt + (size_t)nxt.pn * tstep + nxt.kb : cB;
        const int nt = cur.nt;
        for (int t = 0; t < nt; t += 2) {
            const bool last = (t == nt - 2);
            const char* a1 = cA + (size_t)(t + 1) * kstep;
            const char* a2 = last ? nA : cA + (size_t)(t + 2) * kstep; const char* b2 = last ? nB : cB + (size_t)(t + 2) * kstep;
            const char* a3 = a2 + kstep; const char* b3 = b2 + kstep;
            if (last && has_next) S.a_ready(nxt);
            if constexpr (SP2) {
            PG8_LDB(B0, 0, 0); PG8_LDB(B1, 0, 1); PG8_SCHED; PG8_LDA(At, 0, 0); PG8_STAGE(PG8_SA(1, 1), a1 + hstep, voffA);
            PG8_WAIT_V(8); PG8_WAIT_L(0); PG8_BAR; PG8_MMA(0, 0, At, B0); PG8_MMA(0, 1, At, B1); PG8_BAR; PG8_SCHED;
            PG8_LDA(At, 0, 1); PG8_STAGE(PG8_SB(0, 0), b2, voffB); PG8_STAGE(PG8_SB(0, 1), b2 + hstep, voffB); PG8_STAGE(PG8_SA(0, 0), a2, voffA);
            PG8_WAIT_V(8); PG8_WAIT_L(0); PG8_BAR; PG8_MMA(1, 0, At, B0); PG8_MMA(1, 1, At, B1); PG8_BAR; PG8_SCHED;
            PG8_LDB(B0, 1, 0); PG8_LDB(B1, 1, 1); PG8_SCHED; PG8_LDA(At, 1, 0); PG8_STAGE(PG8_SA(0, 1), a2 + hstep, voffA);
            PG8_WAIT_V(8); PG8_WAIT_L(0); PG8_BAR; PG8_MMA(0, 0, At, B0); PG8_MMA(0, 1, At, B1); PG8_BAR; PG8_SCHED;
            PG8_LDA(At, 1, 1); PG8_STAGE(PG8_SB(1, 0), b3, voffB); PG8_STAGE(PG8_SB(1, 1), b3 + hstep, voffB); PG8_STAGE(PG8_SA(1, 0), a3, voffA);
            PG8_WAIT_V(8); PG8_WAIT_L(0); PG8_BAR; PG8_MMA(1, 0, At, B0); PG8_MMA(1, 1, At, B1); PG8_BAR; PG8_SCHED;
            } else {
            PG8_LDB(B0, 0, 0); PG8_SCHED; PG8_LDA(At, 0, 0); PG8_STAGE(PG8_SA(1, 1), a1 + hstep, voffA);
            PG8_WAIT_L(8); PG8_BAR; PG8_WAIT_L(0); PG8_MMA(0, 0, At, B0); PG8_BAR; PG8_SCHED;
            PG8_LDB(B1, 0, 1); PG8_STAGE(PG8_SB(0, 0), b2, voffB);
            PG8_BAR; PG8_WAIT_L(0); PG8_MMA(0, 1, At, B1); PG8_BAR;
            PG8_LDA(At, 0, 1); PG8_STAGE(PG8_SA(0, 0), a2, voffA);
            PG8_BAR; PG8_WAIT_L(0); PG8_MMA(1, 0, At, B0); PG8_BAR; PG8_SCHED;
            PG8_STAGE(PG8_SB(0, 1), b2 + hstep, voffB);
            PG8_WAIT_V(6); PG8_BAR; PG8_MMA(1, 1, At, B1); PG8_BAR;
            PG8_LDB(B0, 1, 0); PG8_SCHED; PG8_LDA(At, 1, 0); PG8_STAGE(PG8_SA(0, 1), a2 + hstep, voffA);
            PG8_WAIT_L(8); PG8_BAR; PG8_WAIT_L(0); PG8_MMA(0, 0, At, B0); PG8_BAR; PG8_SCHED;
            PG8_LDB(B1, 1, 1); PG8_STAGE(PG8_SB(1, 0), b3, voffB);
            PG8_BAR; PG8_WAIT_L(0); PG8_MMA(0, 1, At, B1); PG8_BAR;
            PG8_LDA(At, 1, 1); PG8_STAGE(PG8_SA(1, 0), a3, voffA);
            PG8_BAR; PG8_WAIT_L(0); PG8_MMA(1, 0, At, B0); PG8_BAR; PG8_SCHED;
            PG8_STAGE(PG8_SB(1, 1), b3 + hstep, voffB);
            PG8_WAIT_V(6); PG8_BAR; PG8_MMA(1, 1, At, B1); PG8_BAR;
            }
        }
        if constexpr (ALIGN_EPI) { if (wr == 0) PG8_BAR; }
        if constexpr (!Epi::AFTER_DRAIN) { PG8_PF(8) E(acc, cur, wr, wc, fr, fq); S.done(cur); }
        if (!has_next) break;
#pragma unroll
        for (int a = 0; a < 2; ++a)
#pragma unroll
            for (int b = 0; b < 2; ++b)
#pragma unroll
                for (int m = 0; m < 4; ++m)
#pragma unroll
                    for (int n = 0; n < 2; ++n) acc[a][b][m][n] = (f32x4){0.f, 0.f, 0.f, 0.f};
        cur = nxt; cA = nA; cB = nB; ++ui;
        if constexpr (ALIGN_EPI) { if (wr == 1) PG8_BAR; }
    }
    PG8_WAIT_V(0);
    if constexpr (!ALIGN_EPI) { if (wr == 0) PG8_BAR; }
    PG8_BAR;
    if constexpr (Epi::AFTER_DRAIN) { E.fused(acc, cur, wr, wc, fr, fq, lds, wid, lane); S.done(cur); }
#undef PG8_SA
#undef PG8_SB
#undef PG8_STAGE
#undef PG8_LDA
#undef PG8_LDB
#undef PG8_MMA
#undef PG8_WAIT_V
#undef PG8_WAIT_L
#undef PG8_BAR
#undef PG8_SCHED
}
}

#ifndef PG8_SP2
#define PG8_SP2 true
#endif
#ifndef PG8_ALIGN
#define PG8_ALIGN true
#endif
constexpr size_t MiB = 1u << 20;
constexpr size_t WS_CTL = 0, CTL_ZERO_BYTES = 32768;
constexpr size_t WS_MOD = 2 * MiB;
constexpr size_t MOD_STRIDE = (size_t)33 * DM * 4;
constexpr size_t WS_WT2 = 4 * MiB;
constexpr size_t WS_WT1 = 38 * MiB;
constexpr size_t WS_H = 170 * MiB;
constexpr size_t WS_U = 310 * MiB, WS_G = 378 * MiB, WS_Q = 446 * MiB, WS_SZ = 514 * MiB;
constexpr size_t WS_KA = 582 * MiB, WS_VA = 718 * MiB, WS_END = 854 * MiB;
static_assert(WS_WT2 + (size_t)DM * LDK * 2 <= WS_WT1 && WS_WT1 + (size_t)NIN * LDK * 2 <= WS_H, "d_ws map (weights)");
static_assert(WS_MOD + 3 * MOD_STRIDE <= WS_WT2 && WS_H + (size_t)MT * LDK * 2 <= WS_U && WS_U + (size_t)MT * DC * 2 <= WS_G && WS_KA + (size_t)KROWS * DA * 2 <= WS_VA && WS_VA + (size_t)KROWS * DA * 2 <= WS_END, "d_ws map");
constexpr size_t WS_XN = WS_U;
constexpr size_t WS_PART = WS_Q;
static_assert(WS_XN + (size_t)MT * DM * 2 <= WS_Q && WS_PART + (size_t)4 * MS * DM * 4 <= WS_SZ, "d_ws overlays");
constexpr int CW_TMO = 0, CW_BAR = 4096;
constexpr int RING_OFF = 0, RING_BYTES = 131072;
constexpr int LDSCTL_OFF = RING_BYTES, MISC_OFF = LDSCTL_OFF + 320;
constexpr int LDS_BYTES = 147456;
constexpr int NWAVES = 8;

#define GAS __attribute__((address_space(1)))
#define LAS __attribute__((address_space(3)))
typedef unsigned short bf16;
typedef unsigned v4u __attribute__((ext_vector_type(4)));
typedef unsigned v2u __attribute__((ext_vector_type(2)));
typedef float f32x4 __attribute__((ext_vector_type(4)));
typedef float f32x16 __attribute__((ext_vector_type(16)));
typedef short bf16x8 __attribute__((ext_vector_type(8)));
typedef short s16x4 __attribute__((ext_vector_type(4)));
typedef GAS unsigned gu32;
#define RLX_AGENT __ATOMIC_RELAXED, __HIP_MEMORY_SCOPE_AGENT
#define LDS_WAIT() asm volatile("s_waitcnt lgkmcnt(0)" ::: "memory")
#define VM_WAIT() asm volatile("s_waitcnt vmcnt(0)" ::: "memory")
__device__ __forceinline__ unsigned cvtpk(float lo, float hi) { unsigned r; asm volatile("v_cvt_pk_bf16_f32 %0, %1, %2" : "=v"(r) : "v"(lo), "v"(hi)); return r; }
__device__ __forceinline__ float bf2f(unsigned short b) { return __uint_as_float(((unsigned)b) << 16); }
__device__ __forceinline__ float wave_sum(float v) {
#pragma unroll
    for (int o = 1; o < 64; o <<= 1) v += __shfl_xor(v, o);
    return v;
}
#define XB_TMO      128
#define XB_XCNT(j)  (256  + 64 * (j))
#define XB_XSUB(j)  (1280 + 64 * (j))
#define XB_XGEN(j)  (2304 + 64 * (j))
#define XB_TOP      3328
#define XB_TOPGEN   3392
#define XCD_BAR_WORDS 3456
#define XB_SPIN_CAP (1u << 18)

__device__ __forceinline__ unsigned xb_ld(unsigned* p)              { return __hip_atomic_load(p, __ATOMIC_RELAXED, __HIP_MEMORY_SCOPE_AGENT); }
__device__ __forceinline__ unsigned xb_add(unsigned* p, unsigned v) { return __hip_atomic_fetch_add(p, v, __ATOMIC_RELAXED, __HIP_MEMORY_SCOPE_AGENT); }
__device__ __forceinline__ unsigned xb_xcc_id() { return (unsigned)__builtin_amdgcn_s_getreg((3 << 11) | 20) & 0xFu; }
#define XB_SPIN(cond, bar) do { unsigned _sp = 0; while (cond) { __builtin_amdgcn_s_sleep(1); \
    if ((++_sp & 255u) == 0u) { if (xb_ld(&(bar)[XB_TMO])) break; if (_sp > XB_SPIN_CAP) { atomicAdd(&(bar)[XB_TMO], 1u); break; } } } } while (0)

struct XcdBarrier {
    unsigned* bar; unsigned x;
    volatile LAS unsigned* st;
};

__device__ __forceinline__ XcdBarrier xcd_barrier_post(unsigned* bar, volatile LAS unsigned* st) {
    XcdBarrier b; b.bar = bar; b.x = xb_xcc_id(); b.st = st;
    if (threadIdx.x == 0) (void)xb_add(&bar[XB_XCNT(b.x)], 1u);
    return b;
}
__device__ __forceinline__ void xcd_barrier_complete(unsigned* bar, unsigned x, unsigned& nloc, unsigned& nx) {
    const unsigned G = gridDim.x * gridDim.y * gridDim.z;
    unsigned sum, cnt, mine, sp = 0u;
    for (;;) {
        sum = 0u; cnt = 0u; mine = 0u;
#pragma unroll
        for (unsigned j = 0; j < 16; ++j) { const unsigned c = xb_ld(&bar[XB_XCNT(j)]); sum += c; cnt += (c > 0u) ? 1u : 0u; mine = (j == x) ? c : mine; }
        if (sum == G) break;
        __builtin_amdgcn_s_sleep(1);
        if ((++sp & 255u) == 0u) { if (xb_ld(&bar[XB_TMO])) break; if (sp > XB_SPIN_CAP) { atomicAdd(&bar[XB_TMO], 1u); break; } }
    }
    nloc = mine > 0u ? mine : 1u; nx = cnt > 0u ? cnt : 1u;
}

__device__ __forceinline__ void xcd_barrier(const XcdBarrier& b) {
    asm volatile("s_waitcnt vmcnt(0)" ::: "memory");
    __syncthreads();
    if (threadIdx.x == 0) {
        unsigned* bar = b.bar;
        __builtin_amdgcn_s_waitcnt(0);
        unsigned nloc = b.st[0], nx = b.st[1];
        if (nloc == 0u) { xcd_barrier_complete(bar, b.x, nloc, nx); b.st[0] = nloc; b.st[1] = nx; }
        const unsigned old = xb_add(&bar[XB_XSUB(b.x)], 1u);
        const unsigned gen = old / nloc;
        if (old + 1u == (gen + 1u) * nloc) {
            __builtin_amdgcn_fence(__ATOMIC_RELEASE, "agent");
            asm volatile("s_waitcnt vmcnt(0)" ::: "memory");
            const unsigned og = xb_add(&bar[XB_TOP], 1u);
            const unsigned tg = og / nx;
            if (og + 1u == (tg + 1u) * nx) xb_add(&bar[XB_TOPGEN], 1u);
            else XB_SPIN(xb_ld(&bar[XB_TOPGEN]) == tg, bar);
            __builtin_amdgcn_fence(__ATOMIC_ACQUIRE, "agent");
            xb_add(&bar[XB_XGEN(b.x)], 1u);
            asm volatile("s_waitcnt vmcnt(0)" ::: "memory");
        } else {
            XB_SPIN(xb_ld(&bar[XB_XGEN(b.x)]) == gen, bar);
            __builtin_amdgcn_fence(__ATOMIC_ACQUIRE, "agent");
            asm volatile("s_waitcnt vmcnt(0)" ::: "memory");
        }
    }
    __syncthreads();
}

struct Frame {
    LAS unsigned char* lds;
    volatile LAS unsigned* MISC;
    gu32* ctl;
    int tid, lane, wave, vcu, G;
    const float *x_prompt, *x_sample, *cache_k, *cache_v, *cache_conv, *c_prompt, *c_sample, *g_norm, *w_ada, *b_ada, *w_in, *conv_w, *conv_b, *rel_bias, *w_out, *g_final;
    float* out;
    float *modA, *modB, *gate;
    bf16 *WT1, *WT2, *H, *MIX, *U, *Gc, *Q, *SZ, *KA, *VA, *XN; float* PART;
};

__device__ __forceinline__ int win_src_col(int np) {
    const int tile = np >> 8, r = np & 255, half = r >> 7, c = r & 127;
    if (tile < 16) return (half ? 4096 : 0) + 128 * tile + c;
    if (tile < 32) return (half ? 6144 : 2048) + 128 * (tile - 16) + c;
    return np;
}
__device__ __forceinline__ void p0_transpose_item(const float* W, int K, int N, bf16* WT, int k0, int src_n0, int dst_n0, LAS float* scr, int lane) {
    const float* wp = W + (size_t)(k0 + (lane >> 3)) * N + src_n0 + 4 * (lane & 7); f32x4 v[8];
#pragma unroll
    for (int i = 0; i < 8; ++i) v[i] = *(const GAS f32x4*)(wp + (size_t)(8 * i) * N);
#pragma unroll
    for (int i = 0; i < 8; ++i) { LAS float* d = scr + (8 * i + (lane >> 3)) * 33 + 4 * (lane & 7); d[0] = v[i][0]; d[1] = v[i][1]; d[2] = v[i][2]; d[3] = v[i][3]; }
    LDS_WAIT(); asm volatile("" ::: "memory");
    const int c = lane & 7;
#pragma unroll
    for (int j = 0; j < 4; ++j) { const int n = (lane >> 3) + 8 * j; const LAS float* s = scr + (8 * c) * 33 + n;
        v4u o; o.x = cvtpk(s[0 * 33], s[1 * 33]); o.y = cvtpk(s[2 * 33], s[3 * 33]); o.z = cvtpk(s[4 * 33], s[5 * 33]); o.w = cvtpk(s[6 * 33], s[7 * 33]);
        *(GAS v4u*)(WT + (size_t)(dst_n0 + n) * LDK + k0 + 8 * c) = o; }
    LDS_WAIT(); asm volatile("" ::: "memory");
}
__device__ __forceinline__ void p0_ada_task(Frame& F, int task) {
    int tid_ = F.tid; asm volatile("" : "+v"(tid_));
    const int n0 = 64 * task, lane = tid_ & 63, w = F.wave, q = lane & 15, r = lane >> 4;
    LAS float* cs = (LAS float*)(F.lds + RING_OFF + w * 8704);
    f32x4 acc[2][4]; float ap[4] = {0.f, 0.f, 0.f, 0.f};
#pragma unroll
    for (int h = 0; h < 2; ++h)
#pragma unroll
        for (int e = 0; e < 4; ++e) acc[h][e] = (f32x4){0.f, 0.f, 0.f, 0.f};
    const float* wbase = F.w_ada + (size_t)r * (3 * DM) + n0 + 4 * q;
#define ADA_LOADW(WV, bt) do { _Pragma("unroll") for (int i = 0; i < 8; ++i) WV[i] = *(const GAS f32x4*)(wbase + (size_t)(512 * w + 32 * (bt) + 4 * i) * (3 * DM)); } while (0)
#define ADA_LOADC(ch) do { const int k0_ = 512 * w + 64 * (ch); _Pragma("unroll") for (int j = 0; j < 8; ++j) { const int idx = j * 64 + lane; \
        cr[j] = *(const GAS f32x4*)(F.c_sample + (size_t)(idx >> 4) * DM + k0_ + 4 * (idx & 15)); } cpr = F.c_prompt[k0_ + lane]; } while (0)
#define ADA_MMA(WV, hb) do { _Pragma("unroll") for (int i = 0; i < 8; ++i) { const int kk = 4 * (8 * (hb) + i) + r; \
        const float a0 = cs[q * 65 + kk], a1 = cs[(q + 16) * 65 + kk], cp = cs[32 * 65 + kk]; \
        _Pragma("unroll") for (int e = 0; e < 4; ++e) { acc[0][e] = __builtin_amdgcn_mfma_f32_16x16x4f32(a0, WV[i][e], acc[0][e], 0, 0, 0); \
            acc[1][e] = __builtin_amdgcn_mfma_f32_16x16x4f32(a1, WV[i][e], acc[1][e], 0, 0, 0); ap[e] = fmaf(cp, WV[i][e], ap[e]); } } } while (0)
    f32x4 wvA[8], wvB[8], cr[8]; float cpr;
    ADA_LOADC(0); ADA_LOADW(wvA, 0);
    for (int ch = 0; ch < 8; ++ch) {
#pragma unroll
        for (int j = 0; j < 8; ++j) { const int idx = j * 64 + lane; LAS float* d = cs + (idx >> 4) * 65 + 4 * (idx & 15); d[0] = cr[j][0]; d[1] = cr[j][1]; d[2] = cr[j][2]; d[3] = cr[j][3]; }
        cs[32 * 65 + lane] = cpr;
        LDS_WAIT(); asm volatile("" ::: "memory");
        if (ch + 1 < 8) ADA_LOADC(ch + 1);
        ADA_LOADW(wvB, 2 * ch + 1);
        ADA_MMA(wvA, 0);
        if (ch + 1 < 8) ADA_LOADW(wvA, 2 * ch + 2);
        ADA_MMA(wvB, 1);
        LDS_WAIT(); asm volatile("" ::: "memory");
    }
#undef ADA_LOADW
#undef ADA_LOADC
#undef ADA_MMA
#pragma unroll
    for (int e = 0; e < 4; ++e) { ap[e] += __shfl_xor(ap[e], 16); ap[e] += __shfl_xor(ap[e], 32); }
#pragma unroll
    for (int h = 0; h < 2; ++h)
#pragma unroll
        for (int e = 0; e < 4; ++e)
#pragma unroll
            for (int i = 0; i < 4; ++i) cs[(16 * h + 4 * r + i) * 64 + 4 * q + e] = acc[h][e][i];
    if (r == 0) {
#pragma unroll
        for (int e = 0; e < 4; ++e) cs[32 * 64 + 4 * q + e] = ap[e]; }
    LDS_WAIT(); __syncthreads();
    for (int idx = F.tid; idx < 33 * 64; idx += NWAVES * 64) {
        float s = 0.f;
#pragma unroll
        for (int qq = 0; qq < 8; ++qq) s += ((LAS float*)(F.lds + RING_OFF + qq * 8704))[idx];
        const int rr = idx >> 6, col = n0 + (idx & 63), bb = (rr == 32) ? 0 : 1 + rr;
        s += F.b_ada[col];
        if (col < DM) F.modB[(size_t)bb * DM + col] = s;
        else if (col < 2 * DM) F.modA[(size_t)bb * DM + col - DM] = F.g_norm[col - DM] * (1.f + s);
        else F.gate[(size_t)bb * DM + col - 2 * DM] = s;
    }
    __syncthreads();
}
__device__ __forceinline__ void p0_prologue(Frame& F, int mode) {
    constexpr int N_ADA = 3 * DM / 64;
    if (mode != 2) for (int t = F.vcu; t < N_ADA; t += F.G) p0_ada_task(F, t);
    if (mode == 1) return;
    LAS float* scr = (LAS float*)(F.lds + RING_OFF + F.wave * 16384);
    int tid_ = F.tid; asm volatile("" : "+v"(tid_));
    const int gw = F.vcu * NWAVES + F.wave, NGW = F.G * NWAVES, lane = tid_ & 63;
    constexpr int I_IN = (DM / 64) * (NIN / 32), I_OUT = (DM / 64) * (DM / 32);
    constexpr int NITEMS = I_IN + I_OUT;
    for (int it = gw; it < NITEMS; it += NGW) {
        int r = it;
        if (r < I_IN) { const int nblk = NIN / 32, kb = r / nblk, nb = r % nblk; p0_transpose_item(F.w_in, DM, NIN, F.WT1, 64 * kb, win_src_col(32 * nb), 32 * nb, scr, lane); continue; } r -= I_IN;
        { const int nblk = DM / 32, kb = r / nblk, nb = r % nblk; p0_transpose_item(F.w_out, DM, DM, F.WT2, 64 * kb, 32 * nb, 32 * nb, scr, lane); }
    }
}
__device__ __forceinline__ void p1_hrows(Frame& F) {
    int tid_ = F.tid; asm volatile("" : "+v"(tid_));
    const int gw = F.vcu * NWAVES + F.wave, NGW = F.G * NWAVES, lane = tid_ & 63;
    f32x4 A[16], B[16]; int cur_bb = -1;
    for (int m = gw; m < MT; m += NGW) {
        const float* xrow = m < MP ? F.x_prompt + (size_t)m * DM : F.x_sample + (size_t)(m - MP) * DM;
        const int bb = m < MP ? 0 : 1 + ((m - MP) >> 5);
        const GAS f32x4* xr = (const GAS f32x4*)xrow + lane;
        f32x4 v[16];
#pragma unroll
        for (int j = 0; j < 16; ++j) v[j] = xr[64 * j];
        if (bb != cur_bb) { cur_bb = bb;
            const GAS f32x4* ar = (const GAS f32x4*)(F.modA + (size_t)bb * DM) + lane; const GAS f32x4* br = (const GAS f32x4*)(F.modB + (size_t)bb * DM) + lane;
#pragma unroll
            for (int j = 0; j < 16; ++j) { A[j] = ar[64 * j]; B[j] = br[64 * j]; } }
        float s = 0.f;
#pragma unroll
        for (int j = 0; j < 16; ++j) s += (v[j].x * v[j].x + v[j].y * v[j].y) + (v[j].z * v[j].z + v[j].w * v[j].w);
        const float rstd = 1.0f / sqrtf(wave_sum(s) * (1.f / DM) + NORM_EPS);
        GAS v2u* o8 = (GAS v2u*)(F.H + (size_t)m * LDK) + lane;
#pragma unroll
        for (int j = 0; j < 16; ++j) { const f32x4 hv = (v[j] * rstd) * A[j] + B[j]; v2u o; o.x = cvtpk(hv.x, hv.y); o.y = cvtpk(hv.z, hv.w); o8[64 * j] = o; }
    }
}
__device__ __forceinline__ void p5_final(Frame& F, bool splitk) {
    int tid_ = F.tid; asm volatile("" : "+v"(tid_));
    const int gw = F.vcu * NWAVES + F.wave, NGW = F.G * NWAVES, lane = tid_ & 63;
    f32x4 gf[16];
#pragma unroll
    for (int j = 0; j < 8; ++j) { gf[2 * j] = *(const GAS f32x4*)(F.g_final + 512 * j + 8 * lane); gf[2 * j + 1] = *(const GAS f32x4*)(F.g_final + 512 * j + 8 * lane + 4); }
    for (int m = gw; m < MT; m += NGW) {
        f32x4 v[16];
        if (m >= MP && splitk) {
            const float* xr = F.x_sample + (size_t)(m - MP) * DM + 8 * lane; const float* gr = F.gate + (size_t)(1 + ((m - MP) >> 5)) * DM + 8 * lane;
            const float* pr = F.PART + (size_t)(m - MP) * DM + 8 * lane;
#pragma unroll
            for (int j = 0; j < 16; ++j) { const int o = 512 * (j >> 1) + 4 * (j & 1);
                const f32x4 p0 = *(const GAS f32x4*)(pr + o), p1 = *(const GAS f32x4*)(pr + (size_t)MS * DM + o), p2 = *(const GAS f32x4*)(pr + (size_t)2 * MS * DM + o), p3 = *(const GAS f32x4*)(pr + (size_t)3 * MS * DM + o);
                v[j] = *(const GAS f32x4*)(xr + o) + *(const GAS f32x4*)(gr + o) * ((p0 + p1) + (p2 + p3)); }
        } else {
            const bf16* xn = F.XN + (size_t)m * DM + 8 * lane; v4u w[8];
            const float* xr = (m < MP ? F.x_prompt + (size_t)m * DM : F.x_sample + (size_t)(m - MP) * DM) + 8 * lane;
#pragma unroll
            for (int j = 0; j < 8; ++j) w[j] = *(const GAS v4u*)(xn + 512 * j);
#pragma unroll
            for (int j = 0; j < 16; ++j) v[j] = *(const GAS f32x4*)(xr + 512 * (j >> 1) + 4 * (j & 1));
#pragma unroll
            for (int j = 0; j < 8; ++j) { v[2 * j] += (f32x4){__uint_as_float(w[j].x << 16), __uint_as_float(w[j].x & 0xffff0000u), __uint_as_float(w[j].y << 16), __uint_as_float(w[j].y & 0xffff0000u)};
                v[2 * j + 1] += (f32x4){__uint_as_float(w[j].z << 16), __uint_as_float(w[j].z & 0xffff0000u), __uint_as_float(w[j].w << 16), __uint_as_float(w[j].w & 0xffff0000u)}; }
        }
        float s = 0.f;
#pragma unroll
        for (int j = 0; j < 16; ++j) s += (v[j].x * v[j].x + v[j].y * v[j].y) + (v[j].z * v[j].z + v[j].w * v[j].w);
        const float rstd = 1.0f / sqrtf(wave_sum(s) * (1.f / DM) + NORM_EPS);
        float* yr = F.out + (size_t)m * DM + 8 * lane;
#pragma unroll
        for (int j = 0; j < 16; ++j) *(GAS f32x4*)(yr + 512 * (j >> 1) + 4 * (j & 1)) = (v[j] * rstd) * gf[j];
    }
}
namespace att {
constexpr int SHM_V = 16384, SHM_K = 16384, OFF_V = 0, OFF_K = 4 * SHM_V, OFF_BT = RING_BYTES + 8192;
static_assert(OFF_K + 4 * SHM_K <= RING_BYTES && OFF_BT + 2560 <= LDS_BYTES, "attention LDS map");
constexpr float THRL = 8.f * 1.4426950408889634f;
#define KSWZ(row, colB) ((row) * 256 + ((colB) ^ (((row) & 7) << 4)))
#define SBAR() __builtin_amdgcn_sched_barrier(0)
__device__ __forceinline__ int crow(int r, int hi) { return (r & 3) + 8 * (r >> 2) + 4 * hi; }
__device__ __forceinline__ int v_st(int k, int c) { const int kk = (k & ~0xC) | ((k & 4) << 1) | ((k & 8) >> 1); return ((kk >> 3) * 4 + (c >> 5)) * 512 + ((kk & 7) * 32 + (c & 31)) * 2; }
__device__ __forceinline__ int v_rd_base(int lane) { return ((lane & 3) << 3) | (((lane >> 2) & 3) << 6) | (((lane >> 4) & 1) << 5) | (((lane >> 5) & 1) << 8); }
constexpr int v_rd_off(int d0, int ks, int half) { return d0 * 512 + ks * 4096 + half * 2048; }
template <int OFF> __device__ __forceinline__ s16x4 tr_read(int vb) { s16x4 r; asm volatile("ds_read_b64_tr_b16 %0, %1 offset:%2" : "=&v"(r) : "v"(vb), "i"(OFF) : "memory"); return r; }
#define PK(L, H) (bf16x8){L[0], L[1], L[2], L[3], H[0], H[1], H[2], H[3]}
#define RD8(D0, X) const s16x4 X##l0 = tr_read<v_rd_off(D0, 0, 0)>(vb), X##h0 = tr_read<v_rd_off(D0, 0, 1)>(vb), X##l1 = tr_read<v_rd_off(D0, 1, 0)>(vb), X##h1 = tr_read<v_rd_off(D0, 1, 1)>(vb), \
                            X##l2 = tr_read<v_rd_off(D0, 2, 0)>(vb), X##h2 = tr_read<v_rd_off(D0, 2, 1)>(vb), X##l3 = tr_read<v_rd_off(D0, 3, 0)>(vb), X##h3 = tr_read<v_rd_off(D0, 3, 1)>(vb)
#define MM4(OD, X) do { OD = __builtin_amdgcn_mfma_f32_32x32x16_bf16(PK(X##l0, X##h0), pa0, OD, 0, 0, 0); OD = __builtin_amdgcn_mfma_f32_32x32x16_bf16(PK(X##l1, X##h1), pa1, OD, 0, 0, 0); \
                        OD = __builtin_amdgcn_mfma_f32_32x32x16_bf16(PK(X##l2, X##h2), pa2, OD, 0, 0, 0); OD = __builtin_amdgcn_mfma_f32_32x32x16_bf16(PK(X##l3, X##h3), pa3, OD, 0, 0, 0); } while (0)
__device__ __forceinline__ void pv_all(f32x16 (&o)[4], int vb, bf16x8 pa0, bf16x8 pa1, bf16x8 pa2, bf16x8 pa3) {
  RD8(0, a); RD8(1, b);
  asm volatile("s_waitcnt lgkmcnt(8)" ::: "memory"); SBAR(); MM4(o[0], a); SBAR();
  RD8(2, c);
  asm volatile("s_waitcnt lgkmcnt(8)" ::: "memory"); SBAR(); MM4(o[1], b); SBAR();
  RD8(3, d);
  asm volatile("s_waitcnt lgkmcnt(8)" ::: "memory"); SBAR(); MM4(o[2], c); SBAR();
  asm volatile("s_waitcnt lgkmcnt(0)" ::: "memory"); SBAR(); MM4(o[3], d);
}
#undef PK
#undef RD8
#undef MM4
struct AUnit { int h, qrow0, krow0, t0, T, ts, sample, probe; };
__device__ __forceinline__ void attn_unit(Frame& F, char* lds, const AUnit u) {
  int tid_ = F.tid; asm volatile("" : "+v"(tid_));
  const int tid = tid_, wid = F.wave, lane = tid & 63, r32 = lane & 31, hi = lane >> 5;
  bf16* V_lds = (bf16*)(lds + OFF_V); bf16* K_lds = (bf16*)(lds + OFF_K);
  float* btab = (float*)(lds + OFF_BT);
  for (int i = tid; i < 640; i += 512) { const int bi = i + 192 < 512 ? i + 192 : 512; btab[i] = F.rel_bias[u.h * 513 + bi] * LOG2E; }
  const bool wact = u.sample ? (wid == 0) : true;
  const int lo = u.sample ? 0 : (wid >> 1), hi_t = lo + 8, ibase = u.sample ? 0 : 32 * (wid & 1);
  const int qrow = u.qrow0 + (u.sample ? 0 : 32 * wid);
  float m_reg = -1e30f, l_reg = 0.f; f32x16 o[4] = {}; bf16x8 qr[8];
  { const bf16* Qw = F.Q + (size_t)(qrow + r32) * DA + u.h * HD + hi * 8;
#pragma unroll
    for (int d0 = 0; d0 < 8; ++d0) qr[d0] = *(const bf16x8*)(Qw + d0 * 16); }
  const int sr = tid >> 4, sc = (tid & 15) * 8, vst0 = v_st(sr, sc), vst1 = v_st(32 + sr, sc);
  const int vb0 = (int)(uintptr_t)V_lds + v_rd_base(lane);
  bf16x8 xv0, xv1, xk0, xk1, yv0, yv1, yk0, yk1;
#define SLOAD(S, t) do { const size_t off_ = (size_t)(u.krow0 + 64 * (t) + sr) * DA + u.h * HD + sc; \
    S##v0 = *(const bf16x8*)(F.VA + off_); S##v1 = *(const bf16x8*)(F.VA + off_ + 32 * DA); S##k0 = *(const bf16x8*)(F.KA + off_); S##k1 = *(const bf16x8*)(F.KA + off_ + 32 * DA); } while (0)
#define SWRITE(b, S) do { *(bf16x8*)((char*)V_lds + (b) * SHM_V + vst0) = S##v0; *(bf16x8*)((char*)V_lds + (b) * SHM_V + vst1) = S##v1; const int kc = sc * 2; \
    *(bf16x8*)((char*)K_lds + (b) * SHM_K + KSWZ(sr, kc)) = S##k0; *(bf16x8*)((char*)K_lds + (b) * SHM_K + KSWZ(32 + sr, kc)) = S##k1; } while (0)
#define WGBAR() do { asm volatile("s_waitcnt lgkmcnt(0)" ::: "memory"); __builtin_amdgcn_s_barrier(); asm volatile("" ::: "memory"); } while (0)
  const int ns = u.T - u.t0;
#define TILE_AT(s_) (u.ts + (s_) < u.T ? u.ts + (s_) : u.ts + (s_) - ns)
  SLOAD(x, u.ts); SLOAD(y, TILE_AT(1)); SWRITE(0, x); SWRITE(1, y);
#define COMPUTE(t, cur) do { if (wact && (t) >= lo && (t) <= hi_t && !(u.probe & 1)) { \
      const int dt = (t) - lo; f32x16 p0, p1; \
      if (dt <= 3) { const float c = btab[639]; _Pragma("unroll") for (int r = 0; r < 16; ++r) { p0[r] = c; p1[r] = c; } } \
      else { const float* bp = btab + (517 - 64 * dt + ibase + r32 - 4 * hi); \
        _Pragma("unroll") for (int r = 0; r < 16; ++r) { const int kk = (r & 3) + 8 * (r >> 2); p0[r] = bp[59 - kk]; p1[r] = bp[27 - kk]; } } \
      if (u.sample && (t) == 8) { _Pragma("unroll") for (int r = 0; r < 16; ++r) p1[r] = -1e30f; } \
      { const bf16* Ks = (const bf16*)((const char*)K_lds + (cur) * SHM_K); \
        _Pragma("unroll") for (int d0 = 0; d0 < 8; ++d0) { const int cb = (d0 * 16 + hi * 8) * 2; \
          const bf16x8 b0 = *(const bf16x8*)((const char*)Ks + KSWZ(r32, cb)), b1 = *(const bf16x8*)((const char*)Ks + KSWZ(32 + r32, cb)); \
          p0 = __builtin_amdgcn_mfma_f32_32x32x16_bf16(b0, qr[d0], p0, 0, 0, 0); \
          p1 = __builtin_amdgcn_mfma_f32_32x32x16_bf16(b1, qr[d0], p1, 0, 0, 0); } } \
      float pmax = p0[0]; \
      _Pragma("unroll") for (int r = 1; r < 16; ++r) pmax = fmaxf(pmax, p0[r]); \
      _Pragma("unroll") for (int r = 0; r < 16; ++r) pmax = fmaxf(pmax, p1[r]); \
      { auto rr = __builtin_amdgcn_permlane32_swap(__float_as_uint(pmax), __float_as_uint(pmax), false, false); pmax = fmaxf(__uint_as_float(rr[0]), __uint_as_float(rr[1])); } \
      float mn, alpha; \
      if (__all(pmax - m_reg <= THRL)) { mn = m_reg; alpha = 1.f; } \
      else { mn = fmaxf(m_reg, pmax); alpha = __builtin_amdgcn_exp2f(m_reg - mn); m_reg = mn; } \
      float ps = 0.f; \
      _Pragma("unroll") for (int r = 0; r < 16; ++r) { p0[r] = __builtin_amdgcn_exp2f(p0[r] - mn); p1[r] = __builtin_amdgcn_exp2f(p1[r] - mn); ps += p0[r] + p1[r]; } \
      { auto rr = __builtin_amdgcn_permlane32_swap(__float_as_uint(ps), __float_as_uint(ps), false, false); ps = __uint_as_float(rr[0]) + __uint_as_float(rr[1]); } \
      if (__any(alpha < 1.f)) { _Pragma("unroll") for (int d = 0; d < 4; ++d) _Pragma("unroll") for (int r = 0; r < 16; ++r) o[d][r] *= alpha; } \
      l_reg = l_reg * alpha + ps; \
      bf16x8 pa0, pa1, pa2, pa3; \
      PK4(p0, 0, pa0); PK4(p0, 8, pa1); PK4(p1, 0, pa2); PK4(p1, 8, pa3); \
      pv_all(o, vb0 + (cur) * SHM_V, pa0, pa1, pa2, pa3); } } while (0)
#define PK4(P, BASE, OUT) do { unsigned a0 = cvtpk(P[BASE + 0], P[BASE + 1]), a1 = cvtpk(P[BASE + 2], P[BASE + 3]);   \
    unsigned b0 = cvtpk(P[BASE + 4], P[BASE + 5]), b1 = cvtpk(P[BASE + 6], P[BASE + 7]);                              \
    auto r0 = __builtin_amdgcn_permlane32_swap(a0, b0, false, false); auto r1 = __builtin_amdgcn_permlane32_swap(a1, b1, false, false); \
    v4u w_ = {r0[0], r1[0], r0[1], r1[1]}; OUT = *reinterpret_cast<bf16x8*>(&w_); } while (0)
#define STEP2(s_, cur) do { WGBAR(); const int ta_ = TILE_AT(s_), tb_ = TILE_AT((s_) + 1); const bool more_ = (s_) + 2 < ns && !(u.probe & 2); \
    if (more_) { SLOAD(x, TILE_AT((s_) + 2)); SLOAD(y, TILE_AT((s_) + 3)); } COMPUTE(ta_, 2 * (cur)); COMPUTE(tb_, 2 * (cur) + 1); \
    if (more_) { SWRITE(2 * ((cur) ^ 1), x); SWRITE(2 * ((cur) ^ 1) + 1, y); } } while (0)
  for (int s = 0; s < ns; s += 4) { STEP2(s, 0); if (s + 2 < ns) STEP2(s + 2, 1); }
#undef TILE_AT
#undef STEP2
#undef PK4
#undef COMPUTE
#undef WGBAR
#undef SLOAD
#undef SWRITE
  if (wact && !(u.probe & 4)) {
    const float rl = __builtin_amdgcn_rcpf(l_reg); const int orow = qrow + r32;
    const bf16* szr = F.SZ + (size_t)orow * DA + u.h * HD + 4 * hi; bf16* mr = F.MIX + (size_t)orow * LDK + DC + u.h * HD + 4 * hi;
    v2u sz[16];
#pragma unroll
    for (int d0 = 0; d0 < 4; ++d0)
#pragma unroll
      for (int g = 0; g < 4; ++g) sz[d0 * 4 + g] = *(const GAS v2u*)(szr + d0 * 32 + g * 8);
#pragma unroll
    for (int d0 = 0; d0 < 4; ++d0)
#pragma unroll
      for (int g = 0; g < 4; ++g) { const v2u z = sz[d0 * 4 + g];
        const float v0 = o[d0][4 * g + 0] * rl * __uint_as_float(z.x << 16), v1 = o[d0][4 * g + 1] * rl * __uint_as_float(z.x & 0xffff0000u);
        const float v2 = o[d0][4 * g + 2] * rl * __uint_as_float(z.y << 16), v3 = o[d0][4 * g + 3] * rl * __uint_as_float(z.y & 0xffff0000u);
        v2u w; w.x = cvtpk(v0, v1); w.y = cvtpk(v2, v3); *(GAS v2u*)(mr + d0 * 32 + g * 8) = w; }
  }
  __syncthreads();
}
}
namespace att {
constexpr int SOFF_ML = RING_BYTES + 1024, SOFF_BT = SOFF_ML + 8 * 256;
static_assert(SOFF_BT + 2 * 2560 <= LDS_BYTES && SOFF_ML >= MISC_OFF + 128, "sample attention LDS map");
__device__ __forceinline__ void sample_pairs(Frame& F, char* lds, int wg) {
  int tid_ = F.tid; asm volatile("" : "+v"(tid_));
  const int tid = tid_, wid = F.wave, lane = tid & 63, r32 = lane & 31, hi = lane >> 5, q4 = wid & 3, pr = wid >> 2;
  const int pair = 2 * wg + pr, b = pair >> 4, h = pair & 15;
  char* wreg = lds + wid * 16384;
  float* btab = (float*)(lds + SOFF_BT + pr * 2560);
  float* ml = (float*)(lds + SOFF_ML);
  { const int t4 = tid & 255; const int hh = (2 * wg + (tid >> 8)) & 15; float* bt = (float*)(lds + SOFF_BT + (tid >> 8) * 2560);
    for (int i = t4; i < 640; i += 256) { const int bi = i + 192 < 512 ? i + 192 : 512; bt[i] = F.rel_bias[hh * 513 + bi] * LOG2E; } }
  bf16x8 qr[8];
  { const bf16* Qw = F.Q + (size_t)(MP + 32 * b + r32) * DA + h * HD + hi * 8;
#pragma unroll
    for (int d0 = 0; d0 < 8; ++d0) qr[d0] = *(const bf16x8*)(Qw + d0 * 16); }
  float m_reg = -1e30f, l_reg = 0.f; f32x16 o[4] = {};
  const int vb = (int)(uintptr_t)(wreg + 8192) + v_rd_base(lane);
  __syncthreads();
  const int nsub = q4 == 3 ? 5 : 4;
  int kwf[4], kwb[2];
#pragma unroll
  for (int j = 0; j < 4; ++j) kwf[j] = hi * 256 + ((8 * r32) ^ (((2 * j + hi) & 7) << 4));
#pragma unroll
  for (int j = 0; j < 2; ++j) kwb[j] = (lane >> 4) * 256 + ((16 * (lane & 15)) ^ (((4 * j + (lane >> 4)) & 7) << 4));
  const int vwf = hi * 64 + ((4 * r32) >> 5) * 512 + ((4 * r32) & 31) * 2, vwb = (lane >> 4) * 64 + ((8 * (lane & 15)) >> 5) * 512 + ((8 * (lane & 15)) & 31) * 2;
  const unsigned lofs = (unsigned)(hi * (NH * HD) + 4 * r32) * 4u;
  const unsigned lofb = (unsigned)((lane >> 4) * DA + 8 * (lane & 15)) * 2u;
  for (int s = 0; s < nsub; ++s) {
    const int jbase = s < 4 ? 128 * q4 + 32 * s : 512;
    if (s < 4) { const char* kg = (const char*)(F.cache_k + ((size_t)(b * 512 + jbase) * NH + h) * HD);
#pragma unroll
      for (int hf = 0; hf < 2; ++hf) { f32x4 kv[8];
#pragma unroll
        for (int i = 0; i < 8; ++i) kv[i] = *(const GAS f32x4*)(kg + (size_t)(8 * hf + i) * (2 * NH * HD * 4) + lofs);
#pragma unroll
        for (int i = 0; i < 8; ++i) { v2u w; w.x = cvtpk(kv[i][0], kv[i][1]); w.y = cvtpk(kv[i][2], kv[i][3]); *(v2u*)(wreg + kwf[i & 3] + (8 * hf + i) * 512) = w; } } }
    else { const char* kg = (const char*)(F.KA + (size_t)(MP + 32 * b) * DA + h * HD); v4u kv[8];
#pragma unroll
      for (int i = 0; i < 8; ++i) kv[i] = *(const GAS v4u*)(kg + (size_t)i * (4 * DA * 2) + lofb);
#pragma unroll
      for (int i = 0; i < 8; ++i) *(v4u*)(wreg + kwb[i & 1] + i * 1024) = kv[i]; }
    f32x4 vvA[8]; const char* vg0 = (const char*)(F.cache_v + ((size_t)(b * 512 + (s < 4 ? jbase : 0)) * NH + h) * HD);
    if (s < 4) {
#pragma unroll
      for (int i = 0; i < 8; ++i) vvA[i] = *(const GAS f32x4*)(vg0 + (size_t)i * (2 * NH * HD * 4) + lofs); }
    asm volatile("s_waitcnt lgkmcnt(0)" ::: "memory");
    f32x16 p0;
    { const float* bp = btab + (549 + r32 - 4 * hi - jbase);
#pragma unroll
      for (int r = 0; r < 16; ++r) { const int kk = (r & 3) + 8 * (r >> 2); p0[r] = bp[27 - kk]; } }
#pragma unroll
    for (int d0 = 0; d0 < 8; ++d0) { const bf16x8 kf = *(const bf16x8*)(wreg + KSWZ(r32, (d0 * 16 + hi * 8) * 2)); p0 = __builtin_amdgcn_mfma_f32_32x32x16_bf16(kf, qr[d0], p0, 0, 0, 0); }
    float pmax = p0[0];
#pragma unroll
    for (int r = 1; r < 16; ++r) pmax = fmaxf(pmax, p0[r]);
    { auto rr = __builtin_amdgcn_permlane32_swap(__float_as_uint(pmax), __float_as_uint(pmax), false, false); pmax = fmaxf(__uint_as_float(rr[0]), __uint_as_float(rr[1])); }
    float mn, alpha;
    if (__all(pmax - m_reg <= THRL)) { mn = m_reg; alpha = 1.f; }
    else { mn = fmaxf(m_reg, pmax); alpha = __builtin_amdgcn_exp2f(m_reg - mn); m_reg = mn; }
    float ps = 0.f;
#pragma unroll
    for (int r = 0; r < 16; ++r) { p0[r] = __builtin_amdgcn_exp2f(p0[r] - mn); ps += p0[r]; }
    { auto rr = __builtin_amdgcn_permlane32_swap(__float_as_uint(ps), __float_as_uint(ps), false, false); ps = __uint_as_float(rr[0]) + __uint_as_float(rr[1]); }
    if (__any(alpha < 1.f)) {
#pragma unroll
      for (int d = 0; d < 4; ++d)
#pragma unroll
        for (int r = 0; r < 16; ++r) o[d][r] *= alpha; }
    l_reg = l_reg * alpha + ps;
    bf16x8 pa0, pa1;
#define PK4(P, BASE, OUT) do { unsigned a0 = cvtpk(P[BASE + 0], P[BASE + 1]), a1 = cvtpk(P[BASE + 2], P[BASE + 3]);   \
    unsigned b0 = cvtpk(P[BASE + 4], P[BASE + 5]), b1 = cvtpk(P[BASE + 6], P[BASE + 7]);                              \
    auto r0 = __builtin_amdgcn_permlane32_swap(a0, b0, false, false); auto r1 = __builtin_amdgcn_permlane32_swap(a1, b1, false, false); \
    v4u w_ = {r0[0], r1[0], r0[1], r1[1]}; OUT = *reinterpret_cast<bf16x8*>(&w_); } while (0)
    PK4(p0, 0, pa0); PK4(p0, 8, pa1);
#undef PK4
    if (s < 4) { f32x4 vvB[8];
#pragma unroll
      for (int i = 0; i < 8; ++i) vvB[i] = *(const GAS f32x4*)(vg0 + (size_t)(8 + i) * (2 * NH * HD * 4) + lofs);
#pragma unroll
      for (int i = 0; i < 8; ++i) { v2u w; w.x = cvtpk(vvA[i][0], vvA[i][1]); w.y = cvtpk(vvA[i][2], vvA[i][3]);
        *(v2u*)(wreg + 8192 + vwf + ((i >> 1) & 1) * 2048 + ((i >> 2) & 1) * 256 + (i & 1) * 128) = w; }
#pragma unroll
      for (int i = 0; i < 8; ++i) { v2u w; w.x = cvtpk(vvB[i][0], vvB[i][1]); w.y = cvtpk(vvB[i][2], vvB[i][3]);
        *(v2u*)(wreg + 8192 + vwf + 4096 + ((i >> 1) & 1) * 2048 + ((i >> 2) & 1) * 256 + (i & 1) * 128) = w; } }
    else { const char* vg = (const char*)(F.VA + (size_t)(MP + 32 * b) * DA + h * HD); v4u vn[8];
#pragma unroll
      for (int i = 0; i < 8; ++i) vn[i] = *(const GAS v4u*)(vg + (size_t)i * (4 * DA * 2) + lofb);
#pragma unroll
      for (int i = 0; i < 8; ++i) *(v4u*)(wreg + 8192 + vwb + ((i >> 2) & 1) * 4096 + (i & 1) * 2048 + ((i >> 1) & 1) * 256) = vn[i]; }
    asm volatile("s_waitcnt lgkmcnt(0)" ::: "memory");
#define PK(L, H) (bf16x8){L[0], L[1], L[2], L[3], H[0], H[1], H[2], H[3]}
#define PVB(D0) do { const s16x4 l0 = tr_read<v_rd_off(D0, 0, 0)>(vb), h0 = tr_read<v_rd_off(D0, 0, 1)>(vb), l1 = tr_read<v_rd_off(D0, 1, 0)>(vb), h1 = tr_read<v_rd_off(D0, 1, 1)>(vb); \
      asm volatile("s_waitcnt lgkmcnt(0)" ::: "memory"); SBAR(); \
      o[D0] = __builtin_amdgcn_mfma_f32_32x32x16_bf16(PK(l0, h0), pa0, o[D0], 0, 0, 0); o[D0] = __builtin_amdgcn_mfma_f32_32x32x16_bf16(PK(l1, h1), pa1, o[D0], 0, 0, 0); } while (0)
    PVB(0); PVB(1); PVB(2); PVB(3);
#undef PVB
#undef PK
    asm volatile("s_waitcnt lgkmcnt(0)" ::: "memory");
  }
#pragma unroll
  for (int d0 = 0; d0 < 4; ++d0)
#pragma unroll
    for (int g = 0; g < 4; ++g) *(f32x4*)(wreg + d0 * 4096 + lane * 64 + g * 16) = (f32x4){o[d0][4 * g], o[d0][4 * g + 1], o[d0][4 * g + 2], o[d0][4 * g + 3]};
  if (hi == 0) { ml[wid * 64 + r32] = m_reg; ml[wid * 64 + 32 + r32] = l_reg; }
  asm volatile("s_waitcnt lgkmcnt(0)" ::: "memory"); __syncthreads();
  { float mj[4], lj[4], M = -1e30f;
#pragma unroll
    for (int j = 0; j < 4; ++j) { mj[j] = ml[(4 * pr + j) * 64 + r32]; lj[j] = ml[(4 * pr + j) * 64 + 32 + r32]; M = fmaxf(M, mj[j]); }
    float L = 0.f, wj[4];
#pragma unroll
    for (int j = 0; j < 4; ++j) { wj[j] = __builtin_amdgcn_exp2f(mj[j] - M); L += wj[j] * lj[j]; }
    const float rl = __builtin_amdgcn_rcpf(L);
    f32x4 acc[4];
#pragma unroll
    for (int g = 0; g < 4; ++g) acc[g] = (f32x4){0.f, 0.f, 0.f, 0.f};
#pragma unroll
    for (int j = 0; j < 4; ++j) { const char* pj = lds + (4 * pr + j) * 16384 + q4 * 4096 + lane * 64;
#pragma unroll
      for (int g = 0; g < 4; ++g) acc[g] += *(const f32x4*)(pj + g * 16) * wj[j]; }
    const int orow = MP + 32 * b + r32;
    const bf16* szr = F.SZ + (size_t)orow * DA + h * HD + 32 * q4 + 4 * hi; bf16* mr = F.MIX + (size_t)orow * LDK + DC + h * HD + 32 * q4 + 4 * hi;
    v2u sz[4];
#pragma unroll
    for (int g = 0; g < 4; ++g) sz[g] = *(const GAS v2u*)(szr + g * 8);
#pragma unroll
    for (int g = 0; g < 4; ++g) { const v2u z = sz[g];
      const float v0 = acc[g][0] * rl * __uint_as_float(z.x << 16), v1 = acc[g][1] * rl * __uint_as_float(z.x & 0xffff0000u);
      const float v2 = acc[g][2] * rl * __uint_as_float(z.y << 16), v3 = acc[g][3] * rl * __uint_as_float(z.y & 0xffff0000u);
      v2u w; w.x = cvtpk(v0, v1); w.y = cvtpk(v2, v3); *(GAS v2u*)(mr + g * 8) = w; }
  }
  __syncthreads();
}
}
__device__ __forceinline__ void p3_attention(Frame& F, char* lds, int probe) {
  if (!(probe & 16)) for (int u = F.vcu; u < NH * (MP / 256); u += F.G) { const int h = u >> 6, qb = u & 63; const int t0 = 8 - 4 * qb > 0 ? 8 - 4 * qb : 0;
    const int ts = qb < 2 ? t0 : (20 - 4 * (qb % 3)) % 12;
    att::attn_unit(F, lds, att::AUnit{h, 256 * qb, 256 * qb - 512, t0, 12, ts, 0, probe}); }
  if (!(probe & 8)) for (int wg = F.vcu; wg < NSB * NH / 2; wg += F.G) att::sample_pairs(F, lds, wg);
}
__device__ __forceinline__ void unpack8(const v4u w, float (&f)[8]) {
  f[0] = __uint_as_float(w.x << 16); f[1] = __uint_as_float(w.x & 0xffff0000u); f[2] = __uint_as_float(w.y << 16); f[3] = __uint_as_float(w.y & 0xffff0000u);
  f[4] = __uint_as_float(w.z << 16); f[5] = __uint_as_float(w.z & 0xffff0000u); f[6] = __uint_as_float(w.w << 16); f[7] = __uint_as_float(w.w & 0xffff0000u); }
__device__ __forceinline__ void p3_convmix(Frame& F) {
  const int gw = F.vcu * NWAVES + F.wave, NGW = F.G * NWAVES, lane = F.lane;
  constexpr int RB = 34; static_assert(MT % RB == 0 && (MT / RB) * 4 == 2048, "conv items");
  for (int it = gw; it < (MT / RB) * 4; it += NGW) {
    const int rb = it >> 2, c = 512 * (it & 3) + 8 * lane, r0 = RB * rb;
    float w0[8], w1[8], w2[8], cb[8], um2[8], um1[8];
    { const f32x4 a0 = *(const GAS f32x4*)(F.conv_w + c), a1 = *(const GAS f32x4*)(F.conv_w + c + 4), b0 = *(const GAS f32x4*)(F.conv_w + DC + c), b1 = *(const GAS f32x4*)(F.conv_w + DC + c + 4);
      const f32x4 c0 = *(const GAS f32x4*)(F.conv_w + 2 * DC + c), c1 = *(const GAS f32x4*)(F.conv_w + 2 * DC + c + 4), d0 = *(const GAS f32x4*)(F.conv_b + c), d1 = *(const GAS f32x4*)(F.conv_b + c + 4);
#pragma unroll
      for (int j = 0; j < 4; ++j) { w0[j] = a0[j]; w0[4 + j] = a1[j]; w1[j] = b0[j]; w1[4 + j] = b1[j]; w2[j] = c0[j]; w2[4 + j] = c1[j]; cb[j] = d0[j]; cb[4 + j] = d1[j]; } }
    if (r0 == 0) {
#pragma unroll
      for (int j = 0; j < 8; ++j) { um2[j] = 0.f; um1[j] = 0.f; } }
    else if (r0 > MP && ((r0 - MP) & 31) == 1) { const float* cc = F.cache_conv + (size_t)((r0 - MP) >> 5) * 2 * DC + DC + c;
#pragma unroll
      for (int j = 0; j < 8; ++j) um2[j] = cc[j];
      unpack8(*(const GAS v4u*)(F.U + (size_t)(r0 - 1) * DC + c), um1); }
    else if (r0 >= MP && ((r0 - MP) & 31) == 0) {
#pragma unroll
      for (int j = 0; j < 8; ++j) { um2[j] = 0.f; um1[j] = 0.f; } }
    else { unpack8(*(const GAS v4u*)(F.U + (size_t)(r0 - 2) * DC + c), um2); unpack8(*(const GAS v4u*)(F.U + (size_t)(r0 - 1) * DC + c), um1); }
    for (int g0 = 0; g0 < RB; g0 += 8) {
      const int nr = RB - g0 < 8 ? RB - g0 : 8;
      v4u ur[8], gr[8];
#pragma unroll
      for (int i = 0; i < 8; ++i) if (i < nr) { const size_t ro = (size_t)(r0 + g0 + i) * DC + c; ur[i] = *(const GAS v4u*)(F.U + ro); gr[i] = *(const GAS v4u*)(F.Gc + ro); }
#pragma unroll
      for (int i = 0; i < 8; ++i) if (i < nr) { const int r = r0 + g0 + i; float uu[8], gg[8], ov[8];
        if (r >= MP && ((r - MP) & 31) == 0) { const float* cc = F.cache_conv + (size_t)((r - MP) >> 5) * 2 * DC + c;
#pragma unroll
          for (int j = 0; j < 8; ++j) { um2[j] = cc[j]; um1[j] = cc[DC + j]; } }
        unpack8(ur[i], uu); unpack8(gr[i], gg);
#pragma unroll
        for (int j = 0; j < 8; ++j) { ov[j] = (cb[j] + w0[j] * um2[j] + w1[j] * um1[j] + w2[j] * uu[j]) * gg[j]; um2[j] = um1[j]; um1[j] = uu[j]; }
        v4u o; o.x = cvtpk(ov[0], ov[1]); o.y = cvtpk(ov[2], ov[3]); o.z = cvtpk(ov[4], ov[5]); o.w = cvtpk(ov[6], ov[7]);
        *(GAS v4u*)(F.MIX + (size_t)r * LDK + c) = o; }
    }
  }
}
struct Args { const float* in[16]; float* out; unsigned char* ws; int ph_lo, ph_hi; };
__global__ void __launch_bounds__(NWAVES * 64, 2) fwd(Args args) {
    extern __shared__ __attribute__((aligned(16))) unsigned char lds[];
    Frame F;
    F.lds = (LAS unsigned char*)lds;
    F.MISC = (volatile LAS unsigned*)(F.lds + MISC_OFF);
    F.tid = threadIdx.x; F.lane = F.tid & 63; F.wave = __builtin_amdgcn_readfirstlane(F.tid >> 6);
    F.G = gridDim.x; { const int bx = blockIdx.x; F.vcu = (F.G % 8 == 0) ? (bx % 8) * (F.G / 8) + bx / 8 : bx; }
    unsigned char* ws = args.ws;
    F.ctl = (gu32*)(ws + WS_CTL);
    F.x_prompt = args.in[0]; F.x_sample = args.in[1]; F.cache_k = args.in[2]; F.cache_v = args.in[3]; F.cache_conv = args.in[4]; F.c_prompt = args.in[5]; F.c_sample = args.in[6];
    F.g_norm = args.in[7]; F.w_ada = args.in[8]; F.b_ada = args.in[9]; F.w_in = args.in[10]; F.conv_w = args.in[11]; F.conv_b = args.in[12]; F.rel_bias = args.in[13]; F.w_out = args.in[14]; F.g_final = args.in[15];
    F.out = args.out;
    F.modA = (float*)(ws + WS_MOD); F.modB = (float*)(ws + WS_MOD + MOD_STRIDE); F.gate = (float*)(ws + WS_MOD + 2 * MOD_STRIDE);
    F.WT1 = (bf16*)(ws + WS_WT1); F.WT2 = (bf16*)(ws + WS_WT2); F.H = (bf16*)(ws + WS_H); F.MIX = (bf16*)(ws + WS_H);
    F.U = (bf16*)(ws + WS_U); F.Gc = (bf16*)(ws + WS_G); F.Q = (bf16*)(ws + WS_Q); F.SZ = (bf16*)(ws + WS_SZ); F.KA = (bf16*)(ws + WS_KA); F.VA = (bf16*)(ws + WS_VA); F.XN = (bf16*)(ws + WS_XN); F.PART = (float*)(ws + WS_PART);
    for (int u = F.tid; u < (LDS_BYTES - LDSCTL_OFF) / 4; u += NWAVES * 64) ((LAS unsigned*)(F.lds + LDSCTL_OFF))[u] = 0u;
    __syncthreads();
    XcdBarrier bar; bar.bar = (unsigned*)(F.ctl + CW_BAR); bar.x = 0; bar.st = nullptr;
    if (N_LAUNCHES != PER_PHASE) bar = xcd_barrier_post((unsigned*)(F.ctl + CW_BAR), F.MISC + 8);
#if defined(PROBE_STAMP)
    unsigned long long ta = 0, tb = 0;
#define STAMP(i) do { if ((i) == PROBE_STAMP || (PROBE_STAMP == 100 && (i) == 0)) ta = __builtin_amdgcn_s_memrealtime(); if ((i) == PROBE_STAMP + 1) tb = __builtin_amdgcn_s_memrealtime(); } while (0)
#define GRID_BAR(i) do { if (N_LAUNCHES != PER_PHASE) xcd_barrier(bar); STAMP(i); } while (0)
    STAMP(0);
#else
#define GRID_BAR(i) do { if (N_LAUNCHES != PER_PHASE) xcd_barrier(bar); } while (0)
#endif
    const int lo = args.ph_lo, hi = args.ph_hi;
    const bool splitk = (F.G == 256);
#define IN(k) (lo <= (k) && (k) < hi)
#define BOTH(k) (IN(k) && IN((k) + 1))
#ifndef PROBE_REPEAT
#define PROBE_REPEAT 0
#endif
#define REP(k) ((PROBE_REPEAT >> (4 * (k))) & 15)
#if defined(PROBE_P0SPLIT)
    if (IN(0)) { STAMP(20); p0_prologue(F, 1); xcd_barrier(bar); STAMP(21); p0_prologue(F, 2); GRID_BAR(1); STAMP(22); }
#else
    if (IN(0)) { for (int rep = 0; rep <= REP(0); ++rep) { p0_prologue(F, 0); if (BOTH(0)) GRID_BAR(1); } }
#endif
    if (IN(1)) { for (int rep = 0; rep <= REP(1); ++rep) { p1_hrows(F); if (BOTH(1)) GRID_BAR(2); } }
#if defined(PROBE_MFMA)
    if (IN(2)) {
        const bf16* ha = F.H + (size_t)(blockIdx.x * 64 + F.lane) * LDK + F.wave * 64; const bf16* wb = F.WT1 + (size_t)(blockIdx.x * 64 + F.lane) * LDK + F.wave * 64;
        bf16x8 a[8], b[8];
#pragma unroll
        for (int j = 0; j < 8; ++j) { a[j] = *(const bf16x8*)(ha + 8 * j); b[j] = *(const bf16x8*)(wb + 8 * j); }
        f32x4 acc[16];
#pragma unroll
        for (int j = 0; j < 16; ++j) acc[j] = (f32x4){0.f, 0.f, 0.f, 0.f};
        for (int it = 0; it < 17 * 64 * 4 / PROBE_MFMA; ++it) {
#pragma unroll
            for (int j = 0; j < 16; ++j) acc[j] = __builtin_amdgcn_mfma_f32_16x16x32_bf16(a[j & 7], b[(j >> 1) & 7], acc[j], 0, 0, 0);
        }
        float sacc = 0.f;
#pragma unroll
        for (int j = 0; j < 16; ++j) sacc += acc[j][0] + acc[j][1] + acc[j][2] + acc[j][3];
        if (sacc == 12345.678f) F.ctl[64] = 1u;
        GRID_BAR();
    }
#endif
    for (int rep = 0; rep <= REP(2); ++rep)
    if (IN(2)) {
        pg8::Gemm g{F.H, F.WT1, MT, NIN, DM, LDK};
#if defined(PROBE_GEMM)
        g.probe = rep ? PROBE_GEMM : 0;
#endif
        pg8::EpiIn E{F.U, F.Gc, F.Q, F.SZ, F.KA, F.VA, F.out};
        if (splitk) { typedef pg8::G1_ORDER G1; G1 S; S.init(MT, NIN, DM, (int)blockIdx.x); pg8::gemm_phase<pg8::EpiIn, G1, PG8_ALIGN, PG8_SP2>(F.lds + RING_OFF, g, S, E); }
        else { pg8::StaticOrder S; S.init(MT, NIN, DM, F.G, (int)blockIdx.x); pg8::gemm_phase<pg8::EpiIn, pg8::StaticOrder, PG8_ALIGN, PG8_SP2>(F.lds + RING_OFF, g, S, E); }
        if (BOTH(2)) GRID_BAR(3);
#if defined(PROBE_ADA_LATE)
        STAMP(30); p0_prologue(F, PROBE_ADA_LATE); xcd_barrier(bar); STAMP(31);
#endif
    }
    for (int rep = 0; rep <= REP(3); ++rep)
    if (IN(3)) {
#if defined(PROBE_P3) && PROBE_P3 == 1
        if (rep == 0) p3_convmix(F); p3_attention(F, (char*)lds + RING_OFF, rep ? PROBE_ATT : 0);
#elif defined(PROBE_P3) && PROBE_P3 == 2
        if (rep == 0) p3_attention(F, (char*)lds + RING_OFF, 0); p3_convmix(F);
#elif defined(PROBE_STAMP) && PROBE_STAMP >= 10
#if defined(PROBE_HOTKV)
        p3_attention(F, (char*)lds + RING_OFF, 8); xcd_barrier(bar);
        STAMP(10); p3_attention(F, (char*)lds + RING_OFF, 8 + 4 + PROBE_HOTKV); xcd_barrier(bar); STAMP(11);
#else
        STAMP(10); p3_attention(F, (char*)lds + RING_OFF, 8); xcd_barrier(bar); STAMP(11);
#endif
        p3_attention(F, (char*)lds + RING_OFF, 16); xcd_barrier(bar); STAMP(12); p3_convmix(F); xcd_barrier(bar); STAMP(13);
#else
        p3_attention(F, (char*)lds + RING_OFF, 0); p3_convmix(F);
#endif
        if (BOTH(3)) GRID_BAR(4); }
    for (int rep = 0; rep <= REP(4); ++rep)
    if (IN(4)) {
        pg8::Gemm g{F.MIX, F.WT2, MT, DM, DM, LDK};
#if defined(PROBE_GEMM)
        g.probe = 0;
#endif
        pg8::EpiOut E{F.gate, F.XN, F.PART};
        if (splitk) { pg8::TailSplitOrder S; S.init(F.G, (int)blockIdx.x); pg8::gemm_phase<pg8::EpiOut, pg8::TailSplitOrder, PG8_ALIGN, PG8_SP2>(F.lds + RING_OFF, g, S, E); }
        else { pg8::StaticOrder S; S.init(MT, DM, DM, F.G, (int)blockIdx.x); pg8::gemm_phase<pg8::EpiOut, pg8::StaticOrder, PG8_ALIGN, PG8_SP2>(F.lds + RING_OFF, g, S, E); }
        if (BOTH(4)) GRID_BAR(5);
    }
    if (IN(5)) { p5_final(F, splitk); }
#if defined(PROBE_STAMP)
    STAMP(6);
#if PROBE_STAMP == 100
    tb = __builtin_amdgcn_s_memrealtime();
#endif
    if (blockIdx.x == 0 && F.tid == 0) { const unsigned long long d = tb - ta, te = __builtin_amdgcn_s_memrealtime();
        while (__builtin_amdgcn_s_memrealtime() - te < 4ull * d) __builtin_amdgcn_s_sleep(32); }
#endif
#undef IN
#undef BOTH
}

extern "C" void kernel_launch(void* const* d_in, const int* in_sizes, int n_in, void* d_out, int out_size, void* d_ws, size_t ws_size, hipStream_t stream) {
    static int grid = 0;
    if (grid == 0) {
        if (n_in != 16 || in_sizes[0] != MP * DM || out_size != (int)O_END || ws_size < WS_END) {
            fprintf(stderr, "kernel_launch: shape mismatch: n_in %d in0 %d out %d ws %zu (need >= %zu); nothing launched\n", n_in, n_in > 0 ? in_sizes[0] : -1, out_size, ws_size, (size_t)WS_END); grid = -1; return; }
        int dev = 0, cus = 0, per_cu = 0;
        if (hipGetDevice(&dev) != hipSuccess || hipDeviceGetAttribute(&cus, hipDeviceAttributeMultiprocessorCount, dev) != hipSuccess) { fprintf(stderr, "kernel_launch: device query failed\n"); grid = -1; return; }
        if (hipFuncSetAttribute((const void*)fwd, hipFuncAttributeMaxDynamicSharedMemorySize, LDS_BYTES) != hipSuccess) { fprintf(stderr, "kernel_launch: hipFuncSetAttribute failed\n"); grid = -1; return; }
        if (hipOccupancyMaxActiveBlocksPerMultiprocessor(&per_cu, (const void*)fwd, NWAVES * 64, LDS_BYTES) != hipSuccess || per_cu < 1)
            fprintf(stderr, "kernel_launch: note: occupancy query reports %d workgroups per CU\n", per_cu);
        (void)hipGetLastError();
        grid = cus;
    }
    if (grid < 0) return;
    if (hipMemsetAsync((char*)d_ws + WS_CTL, 0, CTL_ZERO_BYTES, stream) != hipSuccess) { fprintf(stderr, "kernel_launch: memset failed\n"); return; }
    Args a{};
    for (int i = 0; i < 16; ++i) a.in[i] = (const float*)d_in[i];
    a.out = (float*)d_out; a.ws = (unsigned char*)d_ws;
    const int nl = (N_LAUNCHES == PER_PHASE) ? PER_PHASE : 1;
    for (int li = 0; li < nl; ++li) {
        a.ph_lo = (N_LAUNCHES == PER_PHASE) ? li : 0; a.ph_hi = (N_LAUNCHES == PER_PHASE) ? li + 1 : PER_PHASE;
        hipLaunchKernelGGL(fwd, dim3(grid), dim3(NWAVES * 64), LDS_BYTES, stream, a);
        const hipError_t le = hipPeekAtLastError();
        if (le != hipSuccess) { fprintf(stderr, "kernel_launch: launch %d failed: %s\n", li, hipGetErrorName(le)); break; }
    }
}
```

```cpp
#include <hip/hip_runtime.h>
#include <cstdio>
#include <cstdint>

#ifndef MK_N_LAUNCHES
#define MK_N_LAUNCHES 1
#endif
constexpr int N_LAUNCHES = MK_N_LAUNCHES;
constexpr int PER_PHASE = 6;

constexpr int DM = 4096, MP = 16384, NSB = 32, NST = 32, MS = NSB * NST, MT = MP + MS;
constexpr int LDK = DM + 64;
constexpr int NIN = 16384, DC = 2048, DA = 2048, NH = 16, HD = 128;
constexpr int KROWS = MT;
constexpr float NORM_EPS = 1e-6f;
constexpr float LOG2E = 1.4426950408889634f;
constexpr float QSCALE = 0.08838834764831845f * LOG2E;
constexpr size_t O_YP = 0, O_YS = (size_t)MP * DM, O_KP = O_YS + (size_t)MS * DM, O_VP = O_KP + 512 * 2048, O_CP = O_VP + 512 * 2048, O_KS = O_CP + 2 * 2048,
                 O_VS = O_KS + (size_t)MS * 2048, O_CS = O_VS + (size_t)MS * 2048, O_END = O_CS + (size_t)NSB * 2 * 2048;
static_assert(O_END == 77729792, "output size");

namespace pg8 {
#define PG8_LAS __attribute__((address_space(3)))
typedef unsigned short bf16_t;
typedef short bf16x8 __attribute__((ext_vector_type(8)));
typedef float f32x4 __attribute__((ext_vector_type(4)));
typedef unsigned u32x4 __attribute__((ext_vector_type(4)));
constexpr int BM = 256, BK = 64, HALF = 128, HTB = HALF * BK * 2  , STAGE_BYTES = 8 * HTB, NXCD = 8, WGM = 8;

__host__ __device__ __forceinline__ int lds_byte(int r, int c) { const int st = (r >> 4) * 2 + (c >> 5), rr = r & 15, cc = c & 31, ob = rr * 64 + cc * 2; return st * 1024 + (ob ^ (((ob >> 9) & 1) << 5)); }
__host__ __device__ __forceinline__ void stage_rc(int b, int& R, int& C) { const int st = b / 1024, sb = b % 1024, swz = sb ^ (((sb >> 9) & 1) << 5); R = (st >> 1) * 16 + swz / 64; C = (st & 1) * 32 + (swz % 64) / 2; }
__host__ __device__ __forceinline__ int perm32(int rho) { const int n = rho >> 4, i = rho & 15; return 8 * (i >> 2) + 4 * n + (i & 3); }

struct Unit { int pm, pn, kb, nt, part; };
struct Gemm { const bf16_t* A; const bf16_t* Bt; int M, N, K, ld;
#if defined(PROBE_GEMM)
    int probe;
#endif
};

struct StaticOrder {
    int nM, nN, nwg, G, c, nK;
#if defined(PROBE_HOT)
    int hot;
#endif
    __host__ __device__ void init(int M, int N, int K, int G_, int c_) { nM = M / BM; nN = N / BM; nK = K / BK; nwg = nM * nN; G = G_; c = c_;
#if defined(PROBE_HOT)
        hot = 0;
#endif
    }
    __host__ __device__ bool next(int i, Unit& u) const {
        const long L = (long)i * G + c; if (L >= nwg) return false;
#if defined(PROBE_HOT)
        if (hot) { const int l = c >> 3; u.pm = l & 7; u.pn = (l >> 3) + PROBE_HOT - 1; return true; }
#endif
        int wgid = (int)L; { const int q = nwg / NXCD, r = nwg % NXCD, xcd = wgid % NXCD, off = wgid / NXCD; wgid = (xcd < r ? xcd * (q + 1) : r * (q + 1) + (xcd - r) * q) + off; }
        const int nig = WGM * nN, gid = wgid / nig, fm = gid * WGM, gsz = (nM - fm) < WGM ? (nM - fm) : WGM;
        u.pm = fm + ((wgid % nig) % gsz); u.pn = (wgid % nig) / gsz; u.kb = 0; u.nt = nK; u.part = -1; return true;
    }
    __device__ __forceinline__ void a_ready(const Unit&) const {}
    __device__ __forceinline__ void done(const Unit&) const {}
};
__device__ __forceinline__ unsigned cvt_pk_bf16(float lo, float hi) { unsigned r; asm volatile("v_cvt_pk_bf16_f32 %0, %1, %2" : "=v"(r) : "v"(lo), "v"(hi)); return r; }
typedef float f32x2 __attribute__((ext_vector_type(2)));
__device__ __forceinline__ float silu_f(float x) { return x * __builtin_amdgcn_rcpf(1.0f + __builtin_amdgcn_exp2f(-1.4426950408889634f * x)); }
__device__ __forceinline__ f32x4 silu4(f32x4 v) { f32x4 r; r[0] = silu_f(v[0]); r[1] = silu_f(v[1]); r[2] = silu_f(v[2]); r[3] = silu_f(v[3]); return r; }
__device__ __forceinline__ u32x4 pack8(f32x4 v0, f32x4 v1) { u32x4 w; w.x = cvt_pk_bf16(v0[0], v0[1]); w.y = cvt_pk_bf16(v0[2], v0[3]); w.z = cvt_pk_bf16(v1[0], v1[1]); w.w = cvt_pk_bf16(v1[2], v1[3]); return w; }
__device__ __forceinline__ int krow_of(int row) { return row; }

struct EpiIn {
    static constexpr bool PERM = true, AFTER_DRAIN = false;
    bf16_t *U, *G, *Q, *SZ, *KA, *VA; float* out;
    __device__ __forceinline__ void operator()(const f32x4 (&acc)[2][2][4][2], const Unit& u, int wr, int wc, int fr, int fq) const {
        const int pn = u.pn, row0 = u.pm * BM + wr * 64 + fr;
        if (pn < 32) {
            const int col = (pn & 15) * 128 + wc * 32 + 8 * fq;
            if (pn < 16) {
#pragma unroll
                for (int ai = 0; ai < 2; ++ai)
#pragma unroll
                    for (int m = 0; m < 4; ++m) { const int row = row0 + ai * HALF + m * 16;
                        const f32x4 v0 = acc[ai][0][m][0] * acc[ai][1][m][0], v1 = acc[ai][0][m][1] * acc[ai][1][m][1];
                        *(u32x4*)(U + (size_t)row * DC + col) = pack8(v0, v1);
                        if (u.pm >= 63) { long o = -1;
                            if (row >= MP) { const int t = row & 31; if (t >= 30) o = (long)O_CS + (long)((((row - MP) >> 5) * 2 + (t - 30)) * 2048); }
                            else if (row >= MP - 2) o = (long)O_CP + (long)((row - (MP - 2)) * 2048);
                            if (o >= 0) { *(f32x4*)(out + o + col) = v0; *(f32x4*)(out + o + col + 4) = v1; } } }
            } else {
#pragma unroll
                for (int ai = 0; ai < 2; ++ai)
#pragma unroll
                    for (int m = 0; m < 4; ++m) { const int row = row0 + ai * HALF + m * 16;
                        const f32x4 v0 = acc[ai][0][m][0] * silu4(acc[ai][1][m][0]), v1 = acc[ai][0][m][1] * silu4(acc[ai][1][m][1]);
                        *(u32x4*)(G + (size_t)row * DC + col) = pack8(v0, v1); }
            }
        } else {
            const int part = (pn - 32) >> 3, colp = ((pn - 32) & 7) * 256 + wc * 32 + 8 * fq;
            if (part == 0) {
#pragma unroll
                for (int ai = 0; ai < 2; ++ai)
#pragma unroll
                    for (int m = 0; m < 4; ++m) { const int row = row0 + ai * HALF + m * 16;
#pragma unroll
                        for (int bj = 0; bj < 2; ++bj) *(u32x4*)(Q + (size_t)row * DA + colp + bj * HALF) = pack8(acc[ai][bj][m][0] * QSCALE, acc[ai][bj][m][1] * QSCALE); }
            } else if (part == 3) {
#pragma unroll
                for (int ai = 0; ai < 2; ++ai)
#pragma unroll
                    for (int m = 0; m < 4; ++m) { const int row = row0 + ai * HALF + m * 16;
#pragma unroll
                        for (int bj = 0; bj < 2; ++bj) *(u32x4*)(SZ + (size_t)row * DA + colp + bj * HALF) = pack8(silu4(acc[ai][bj][m][0]), silu4(acc[ai][bj][m][1])); }
            } else {
                bf16_t* dst = part == 1 ? KA : VA;
                float* odp = out + (part == 1 ? O_KP : O_VP); float* ods = out + (part == 1 ? O_KS : O_VS);
#pragma unroll
                for (int ai = 0; ai < 2; ++ai)
#pragma unroll
                    for (int m = 0; m < 4; ++m) { const int row = row0 + ai * HALF + m * 16; const size_t kr = (size_t)krow_of(row);
#pragma unroll
                        for (int bj = 0; bj < 2; ++bj) { *(u32x4*)(dst + kr * DA + colp + bj * HALF) = pack8(acc[ai][bj][m][0], acc[ai][bj][m][1]);
                            if (u.pm >= 62) { float* o = row >= MP ? ods + (size_t)(row - MP) * DA : odp + (size_t)(row - (MP - 512)) * DA;
                                *(f32x4*)(o + colp + bj * HALF) = acc[ai][bj][m][0]; *(f32x4*)(o + colp + bj * HALF + 4) = acc[ai][bj][m][1]; } } }
            }
        }
    }
};
struct EpiOut {
    static constexpr bool PERM = true, AFTER_DRAIN = false;
    const float* gate; bf16_t* XN; bf16_t* PART;
    __device__ __forceinline__ void operator()(const f32x4 (&acc)[2][2][4][2], const Unit& u, int wr, int wc, int fr, int fq) const {
        const int row0 = u.pm * BM + wr * 64 + fr, col = u.pn * BM + wc * 32 + 8 * fq;
        if (u.part >= 0) {
            bf16_t* pb = PART + (size_t)u.part * MS * DM;
#pragma unroll
            for (int ai = 0; ai < 2; ++ai)
#pragma unroll
                for (int m = 0; m < 4; ++m) { bf16_t* pr = pb + (size_t)(row0 + ai * HALF + m * 16 - MP) * DM + col;
#pragma unroll
                    for (int bj = 0; bj < 2; ++bj) *(u32x4*)(pr + bj * HALF) = pack8(acc[ai][bj][m][0], acc[ai][bj][m][1]); }
            return;
        }
        if (u.pm < MP / BM) {
            f32x4 g[2][2];
#pragma unroll
            for (int bj = 0; bj < 2; ++bj) { g[bj][0] = *(const f32x4*)(gate + col + bj * HALF); g[bj][1] = *(const f32x4*)(gate + col + bj * HALF + 4); }
#pragma unroll
            for (int ai = 0; ai < 2; ++ai)
#pragma unroll
                for (int m = 0; m < 4; ++m) { bf16_t* yr = XN + (size_t)(row0 + ai * HALF + m * 16) * DM + col;
#pragma unroll
                    for (int bj = 0; bj < 2; ++bj) *(u32x4*)(yr + bj * HALF) = pack8(g[bj][0] * acc[ai][bj][m][0], g[bj][1] * acc[ai][bj][m][1]); }
        } else {
#pragma unroll
            for (int ai = 0; ai < 2; ++ai)
#pragma unroll
                for (int m = 0; m < 4; ++m) { const int row = row0 + ai * HALF + m * 16; const float* gr = gate + (size_t)(1 + ((row - MP) >> 5)) * DM + col; bf16_t* yr = XN + (size_t)row * DM + col;
#pragma unroll
                    for (int bj = 0; bj < 2; ++bj) *(u32x4*)(yr + bj * HALF) = pack8(*(const f32x4*)(gr + bj * HALF) * acc[ai][bj][m][0], *(const f32x4*)(gr + bj * HALF + 4) * acc[ai][bj][m][1]); }
        }
    }
};
template <int XM, int XN, int RM, int RN, bool MFIRST> struct GridOrderT {
    static_assert(XM * XN == 8 && RM * RN == 32, "GridOrderT geometry");
    int nM, nN, nK, c;
    __device__ void init(int M, int N, int K, int c_) { nM = M / BM; nN = N / BM; nK = K / BK; c = c_; }
    __device__ bool next(int i, Unit& u) const {
        constexpr int BMc = XM * RM, BNc = XN * RN;
        const int x = c & 7, k = c >> 3, nq = nN / BNc, ng = (nM & ~15) / BMc, full = ng * nq;
        u.kb = 0; u.nt = nK; u.part = -1;
#ifdef PROBE_G1X
        if (nN == 64 && i > full && i <= full + PROBE_G1X) i -= full + 1;
#endif
        if (i < full) { const int g = MFIRST ? i % ng : i / nq, q = MFIRST ? i / ng : i % nq;
            u.pm = BMc * g + RM * (x / XN) + (k % RM); u.pn = BNc * q + RN * (x % XN) + (k / RM); return true; }
        if (i == full && (nM & 15) == 4 && nN == 64) { u.pm = (nM & ~15) + (k & 3); u.pn = 8 * x + (k >> 2); return true; }
        return false;
    }
    __device__ __forceinline__ void a_ready(const Unit&) const {}
    __device__ __forceinline__ void done(const Unit&) const {}
};
typedef GridOrderT<4, 2, 4, 8, false> GridOrder;
#ifndef G1_ORDER
#define G1_ORDER GridOrderT<2, 4, 4, 8, false>
#endif
struct TailSplitOrder {
    GridOrder so; int c;
    __device__ void init(int G, int c_) { so.init(MP, DM, DM, c_); c = c_; (void)G; }
    __device__ bool next(int i, Unit& u) const {
        if (i < 4) return so.next(i, u);
#ifdef PROBE_TAIL2
        if (i > 4 + PROBE_TAIL2) return false;
#else
        if (i > 4) return false;
#endif
        const int kq = c & 3, r = c >> 2; u.pm = MP / BM + (r & 3); u.pn = r >> 2; u.kb = kq * (DM / 4) * 2; u.nt = DM / 4 / BK; u.part = kq; return true;
    }
    __device__ __forceinline__ void a_ready(const Unit&) const {}
    __device__ __forceinline__ void done(const Unit&) const {}
};
template <class Epi, class Sched, bool ALIGN_EPI = false, bool SP2 = false>
__device__ __forceinline__ void gemm_phase(PG8_LAS unsigned char* lds, const Gemm g, const Sched& S, const Epi& E) {
    int tid_ = threadIdx.x; asm volatile("" : "+v"(tid_));
    const int tid = tid_, wid = __builtin_amdgcn_readfirstlane(tid >> 6), lane = tid & 63, wr = wid >> 2, wc = wid & 3, fr = lane & 15, fq = lane >> 4;
    const int LD = g.ld;
    unsigned voffA[2], voffB[2];
#pragma unroll
    for (int i = 0; i < 2; ++i) { int R, C; stage_rc(tid * 16 + i * 8192, R, C); const int Rb = Epi::PERM ? ((R & ~31) + perm32(R & 31)) : R;
        voffA[i] = (unsigned)(R * LD + C) * 2u; voffB[i] = (unsigned)(Rb * LD + C) * 2u; }
    const size_t kstep = (size_t)(BK * 2);
    const size_t hstep = (size_t)HALF * LD * 2;
    const size_t tstep = 2 * hstep;
    const unsigned ldsw = (unsigned)wid * 1024u;
    const int aoff = lds_byte(wr * 64 + fr, fq * 8), boff = lds_byte(wc * 32 + fr, fq * 8);
#define PG8_SA(b, h) (((b) * 2 + (h)) * HTB)
#define PG8_SB(b, h) ((4 + (b) * 2 + (h)) * HTB)
#if defined(PROBE_GEMM)
    const int pf = g.probe;
#define PG8_PF(b) if (!(pf & (b)))
#else
#define PG8_PF(b)
#endif
#define PG8_STAGE(bufoff, gbase, voff) do { PG8_PF(2) _Pragma("unroll") for (int _i = 0; _i < 2; ++_i) \
        __builtin_amdgcn_global_load_lds((const unsigned*)((const char*)(gbase) + (voff)[_i]), (PG8_LAS unsigned*)(lds + (bufoff) + ldsw + _i * 8192), 16, 0, 0); } while (0)
#define PG8_LDA(dst, b, h) do { _Pragma("unroll") for (int m = 0; m < 4; ++m) _Pragma("unroll") for (int k = 0; k < 2; ++k) dst[m][k] = *(const PG8_LAS bf16x8*)(lds + PG8_SA(b, h) + aoff + m * 2048 + k * 1024); } while (0)
#define PG8_LDB(dst, b, h) do { _Pragma("unroll") for (int n = 0; n < 2; ++n) _Pragma("unroll") for (int k = 0; k < 2; ++k) dst[n][k] = *(const PG8_LAS bf16x8*)(lds + PG8_SB(b, h) + boff + n * 2048 + k * 1024); } while (0)
#define PG8_MMA(ai, bj, At, Bt) do { __builtin_amdgcn_s_setprio(1); PG8_PF(1) _Pragma("unroll") for (int m = 0; m < 4; ++m) _Pragma("unroll") for (int n = 0; n < 2; ++n) _Pragma("unroll") for (int k = 0; k < 2; ++k) \
        acc[ai][bj][m][n] = __builtin_amdgcn_mfma_f32_16x16x32_bf16(Bt[n][k], At[m][k], acc[ai][bj][m][n], 0, 0, 0); __builtin_amdgcn_s_setprio(0); } while (0)
#define PG8_WAIT_V(n) asm volatile("s_waitcnt vmcnt(" #n ")" ::: "memory")
#define PG8_WAIT_L(n) asm volatile("s_waitcnt lgkmcnt(" #n ")" ::: "memory")
#define PG8_BAR __builtin_amdgcn_s_barrier()
#define PG8_SCHED __builtin_amdgcn_sched_barrier(0)
    Unit cur, nxt; int ui = 0;
    if (!S.next(0, cur)) return;
    f32x4 acc[2][2][4][2];
#pragma unroll
    for (int a = 0; a < 2; ++a)
#pragma unroll
        for (int b = 0; b < 2; ++b)
#pragma unroll
            for (int m = 0; m < 4; ++m)
#pragma unroll
                for (int n = 0; n < 2; ++n) acc[a][b][m][n] = (f32x4){0.f, 0.f, 0.f, 0.f};
    bf16x8 At[4][2], B0[2][2], B1[2][2];
    const char* cA = (const char*)g.A + (size_t)cur.pm * tstep + cur.kb; const char* cB = (const char*)g.Bt + (size_t)cur.pn * tstep + cur.kb;
    S.a_ready(cur);
    if constexpr (SP2) {
        PG8_STAGE(PG8_SB(0, 0), cB, voffB); PG8_STAGE(PG8_SB(0, 1), cB + hstep, voffB); PG8_STAGE(PG8_SA(0, 0), cA, voffA); PG8_STAGE(PG8_SA(0, 1), cA + hstep, voffA);
        if (wr == 1) PG8_BAR;
        PG8_WAIT_V(2); PG8_BAR;
        PG8_STAGE(PG8_SB(1, 0), cB + kstep, voffB); PG8_STAGE(PG8_SA(1, 0), cA + kstep, voffA); PG8_STAGE(PG8_SB(1, 1), cB + hstep + kstep, voffB);
        PG8_WAIT_V(6); PG8_BAR;
    } else {
        PG8_STAGE(PG8_SB(0, 0), cB, voffB); PG8_STAGE(PG8_SA(0, 0), cA, voffA); PG8_STAGE(PG8_SB(0, 1), cB + hstep, voffB); PG8_STAGE(PG8_SA(0, 1), cA + hstep, voffA);
        if (wr == 1) PG8_BAR;
        PG8_WAIT_V(4); PG8_BAR;
        PG8_STAGE(PG8_SB(1, 0), cB + kstep, voffB); PG8_STAGE(PG8_SA(1, 0), cA + kstep, voffA); PG8_STAGE(PG8_SB(1, 1), cB + hstep + kstep, voffB);
        PG8_WAIT_V(6); PG8_BAR;
    }
    for (;;) {
        const bool has_next = S.next(ui + 1, nxt);
        const char* nA = has_next ? (const char*)g.A + (size_t)nxt.pm * tstep + nxt.kb : cA; const char* nB = has_next ? (const char*)g.Bt + (size_t)nxt.pn * tstep + nxt.kb : cB;
        const int nt = cur.nt;
        for (int t = 0; t < nt; t += 2) {
            const bool last = (t == nt - 2);
            const char* a1 = cA + (size_t)(t + 1) * kstep;
            const char* a2 = last ? nA : cA + (size_t)(t + 2) * kstep; const char* b2 = last ? nB : cB + (size_t)(t + 2) * kstep;
            const char* a3 = a2 + kstep; const char* b3 = b2 + kstep;
            if (last && has_next) S.a_ready(nxt);
            if constexpr (SP2) {
            PG8_LDB(B0, 0, 0); PG8_LDB(B1, 0, 1); PG8_SCHED; PG8_LDA(At, 0, 0); PG8_STAGE(PG8_SA(1, 1), a1 + hstep, voffA);
            PG8_WAIT_V(8); PG8_WAIT_L(0); PG8_BAR; PG8_MMA(0, 0, At, B0); PG8_MMA(0, 1, At, B1); PG8_BAR; PG8_SCHED;
            PG8_LDA(At, 0, 1); PG8_STAGE(PG8_SB(0, 0), b2, voffB); PG8_STAGE(PG8_SB(0, 1), b2 + hstep, voffB); PG8_STAGE(PG8_SA(0, 0), a2, voffA);
            PG8_WAIT_V(8); PG8_WAIT_L(0); PG8_BAR; PG8_MMA(1, 0, At, B0); PG8_MMA(1, 1, At, B1); PG8_BAR; PG8_SCHED;
            PG8_LDB(B0, 1, 0); PG8_LDB(B1, 1, 1); PG8_SCHED; PG8_LDA(At, 1, 0); PG8_STAGE(PG8_SA(0, 1), a2 + hstep, voffA);
            PG8_WAIT_V(8); PG8_WAIT_L(0); PG8_BAR; PG8_MMA(0, 0, At, B0); PG8_MMA(0, 1, At, B1); PG8_BAR; PG8_SCHED;
            PG8_LDA(At, 1, 1); PG8_STAGE(PG8_SB(1, 0), b3, voffB); PG8_STAGE(PG8_SB(1, 1), b3 + hstep, voffB); PG8_STAGE(PG8_SA(1, 0), a3, voffA);
            PG8_WAIT_V(8); PG8_WAIT_L(0); PG8_BAR; PG8_MMA(1, 0, At, B0); PG8_MMA(1, 1, At, B1); PG8_BAR; PG8_SCHED;
            } else {
            PG8_LDB(B0, 0, 0); PG8_SCHED; PG8_LDA(At, 0, 0); PG8_STAGE(PG8_SA(1, 1), a1 + hstep, voffA);
            PG8_WAIT_L(8); PG8_BAR; PG8_WAIT_L(0); PG8_MMA(0, 0, At, B0); PG8_BAR; PG8_SCHED;
            PG8_LDB(B1, 0, 1); PG8_STAGE(PG8_SB(0, 0), b2, voffB);
            PG8_BAR; PG8_WAIT_L(0); PG8_MMA(0, 1, At, B1); PG8_BAR;
            PG8_LDA(At, 0, 1); PG8_STAGE(PG8_SA(0, 0), a2, voffA);
            PG8_BAR; PG8_WAIT_L(0); PG8_MMA(1, 0, At, B0); PG8_BAR; PG8_SCHED;
            PG8_STAGE(PG8_SB(0, 1), b2 + hstep, voffB);
            PG8_WAIT_V(6); PG8_BAR; PG8_MMA(1, 1, At, B1); PG8_BAR;
            PG8_LDB(B0, 1, 0); PG8_SCHED; PG8_LDA(At, 1, 0); PG8_STAGE(PG8_SA(0, 1), a2 + hstep, voffA);
            PG8_WAIT_L(8); PG8_BAR; PG8_WAIT_L(0); PG8_MMA(0, 0, At, B0); PG8_BAR; PG8_SCHED;
            PG8_LDB(B1, 1, 1); PG8_STAGE(PG8_SB(1, 0), b3, voffB);
            PG8_BAR; PG8_WAIT_L(0); PG8_MMA(0, 1, At, B1); PG8_BAR;
            PG8_LDA(At, 1, 1); PG8_STAGE(PG8_SA(1, 0), a3, voffA);
            PG8_BAR; PG8_WAIT_L(0); PG8_MMA(1, 0, At, B0); PG8_BAR; PG8_SCHED;
            PG8_STAGE(PG8_SB(1, 1), b3 + hstep, voffB);
            PG8_WAIT_V(6); PG8_BAR; PG8_MMA(1, 1, At, B1); PG8_BAR;
            }
        }
        if constexpr (ALIGN_EPI) { if (wr == 0) PG8_BAR; }
        if constexpr (!Epi::AFTER_DRAIN) { PG8_PF(8) E(acc, cur, wr, wc, fr, fq); S.done(cur); }
        if (!has_next) break;
#pragma unroll
        for (int a = 0; a < 2; ++a)
#pragma unroll
            for (int b = 0; b < 2; ++b)
#pragma unroll
                for (int m = 0; m < 4; ++m)
#pragma unroll
                    for (int n = 0; n < 2; ++n) acc[a][b][m][n] = (f32x4){0.f, 0.f, 0.f, 0.f};
        cur = nxt; cA = nA; cB = nB; ++ui;
        if constexpr (ALIGN_EPI) { if (wr == 1) PG8_BAR; }
    }
    PG8_WAIT_V(0);
    if constexpr (!ALIGN_EPI) { if (wr == 0) PG8_BAR; }
    PG8_BAR;
    if constexpr (Epi::AFTER_DRAIN) { E.fused(acc, cur, wr, wc, fr, fq, lds, wid, lane); S.done(cur); }
#undef PG8_SA
#undef PG8_SB
#undef PG8_STAGE
#undef PG8_LDA
#undef PG8_LDB
#undef PG8_MMA
#undef PG8_WAIT_V
#undef PG8_WAIT_L
#undef PG8_BAR
#undef PG8_SCHED
}
}

#ifndef PG8_SP2
#define PG8_SP2 true
#endif
#ifndef PG8_ALIGN
#define PG8_ALIGN true
#endif
constexpr size_t MiB = 1u << 20;
constexpr size_t WS_CTL = 0, CTL_ZERO_BYTES = 32768;
constexpr size_t WS_MOD = 2 * MiB;
constexpr size_t MOD_STRIDE = (size_t)33 * DM * 4;
constexpr size_t WS_WT2 = 4 * MiB;
constexpr size_t WS_WT1 = 38 * MiB;
constexpr size_t WS_H = 170 * MiB;
constexpr size_t WS_U = 310 * MiB, WS_G = 378 * MiB, WS_Q = 446 * MiB, WS_SZ = 514 * MiB;
constexpr size_t WS_KA = 582 * MiB, WS_VA = 718 * MiB, WS_END = 854 * MiB;
static_assert(WS_WT2 + (size_t)DM * LDK * 2 <= WS_WT1 && WS_WT1 + (size_t)NIN * LDK * 2 <= WS_H, "d_ws map (weights)");
static_assert(WS_MOD + 3 * MOD_STRIDE <= WS_WT2 && WS_H + (size_t)MT * LDK * 2 <= WS_U && WS_U + (size_t)MT * DC * 2 <= WS_G && WS_KA + (size_t)KROWS * DA * 2 <= WS_VA && WS_VA + (size_t)KROWS * DA * 2 <= WS_END, "d_ws map");
constexpr size_t WS_XN = WS_U;
constexpr size_t WS_PART = WS_Q;
static_assert(WS_XN + (size_t)MT * DM * 2 <= WS_Q && WS_PART + (size_t)4 * MS * DM * 4 <= WS_SZ, "d_ws overlays");
constexpr int CW_TMO = 0, CW_BAR = 4096;
constexpr int RING_OFF = 0, RING_BYTES = 131072;
constexpr int LDSCTL_OFF = RING_BYTES, MISC_OFF = LDSCTL_OFF + 320;
constexpr int LDS_BYTES = 147456;
constexpr int NWAVES = 8;

#define GAS __attribute__((address_space(1)))
#define LAS __attribute__((address_space(3)))
typedef unsigned short bf16;
typedef unsigned v4u __attribute__((ext_vector_type(4)));
typedef unsigned v2u __attribute__((ext_vector_type(2)));
typedef float f32x4 __attribute__((ext_vector_type(4)));
typedef float f32x16 __attribute__((ext_vector_type(16)));
typedef short bf16x8 __attribute__((ext_vector_type(8)));
typedef short s16x4 __attribute__((ext_vector_type(4)));
typedef GAS unsigned gu32;
#define RLX_AGENT __ATOMIC_RELAXED, __HIP_MEMORY_SCOPE_AGENT
#define LDS_WAIT() asm volatile("s_waitcnt lgkmcnt(0)" ::: "memory")
#define VM_WAIT() asm volatile("s_waitcnt vmcnt(0)" ::: "memory")
__device__ __forceinline__ unsigned cvtpk(float lo, float hi) { unsigned r; asm volatile("v_cvt_pk_bf16_f32 %0, %1, %2" : "=v"(r) : "v"(lo), "v"(hi)); return r; }
__device__ __forceinline__ float bf2f(unsigned short b) { return __uint_as_float(((unsigned)b) << 16); }
__device__ __forceinline__ float wave_sum(float v) {
#pragma unroll
    for (int o = 1; o < 64; o <<= 1) v += __shfl_xor(v, o);
    return v;
}
#define XB_TMO      128
#define XB_XCNT(j)  (256  + 64 * (j))
#define XB_XSUB(j)  (1280 + 64 * (j))
#define XB_XGEN(j)  (2304 + 64 * (j))
#define XB_TOP      3328
#define XB_TOPGEN   3392
#define XCD_BAR_WORDS 3456
#define XB_SPIN_CAP (1u << 18)

__device__ __forceinline__ unsigned xb_ld(unsigned* p)              { return __hip_atomic_load(p, __ATOMIC_RELAXED, __HIP_MEMORY_SCOPE_AGENT); }
__device__ __forceinline__ unsigned xb_add(unsigned* p, unsigned v) { return __hip_atomic_fetch_add(p, v, __ATOMIC_RELAXED, __HIP_MEMORY_SCOPE_AGENT); }
__device__ __forceinline__ unsigned xb_xcc_id() { return (unsigned)__builtin_amdgcn_s_getreg((3 << 11) | 20) & 0xFu; }
#define XB_SPIN(cond, bar) do { unsigned _sp = 0; while (cond) { __builtin_amdgcn_s_sleep(1); \
    if ((++_sp & 255u) == 0u) { if (xb_ld(&(bar)[XB_TMO])) break; if (_sp > XB_SPIN_CAP) { atomicAdd(&(bar)[XB_TMO], 1u); break; } } } } while (0)

struct XcdBarrier {
    unsigned* bar; unsigned x;
    volatile LAS unsigned* st;
};

__device__ __forceinline__ XcdBarrier xcd_barrier_post(unsigned* bar, volatile LAS unsigned* st) {
    XcdBarrier b; b.bar = bar; b.x = xb_xcc_id(); b.st = st;
    if (threadIdx.x == 0) (void)xb_add(&bar[XB_XCNT(b.x)], 1u);
    return b;
}
__device__ __forceinline__ void xcd_barrier_complete(unsigned* bar, unsigned x, unsigned& nloc, unsigned& nx) {
    const unsigned G = gridDim.x * gridDim.y * gridDim.z;
    unsigned sum, cnt, mine, sp = 0u;
    for (;;) {
        sum = 0u; cnt = 0u; mine = 0u;
#pragma unroll
        for (unsigned j = 0; j < 16; ++j) { const unsigned c = xb_ld(&bar[XB_XCNT(j)]); sum += c; cnt += (c > 0u) ? 1u : 0u; mine = (j == x) ? c : mine; }
        if (sum == G) break;
        __builtin_amdgcn_s_sleep(1);
        if ((++sp & 255u) == 0u) { if (xb_ld(&bar[XB_TMO])) break; if (sp > XB_SPIN_CAP) { atomicAdd(&bar[XB_TMO], 1u); break; } }
    }
    nloc = mine > 0u ? mine : 1u; nx = cnt > 0u ? cnt : 1u;
}

__device__ __forceinline__ void xcd_barrier(const XcdBarrier& b) {
    asm volatile("s_waitcnt vmcnt(0)" ::: "memory");
    __syncthreads();
    if (threadIdx.x == 0) {
        unsigned* bar = b.bar;
        __builtin_amdgcn_s_waitcnt(0);
        unsigned nloc = b.st[0], nx = b.st[1];
        if (nloc == 0u) { xcd_barrier_complete(bar, b.x, nloc, nx); b.st[0] = nloc; b.st[1] = nx; }
        const unsigned old = xb_add(&bar[XB_XSUB(b.x)], 1u);
        const unsigned gen = old / nloc;
        if (old + 1u == (gen + 1u) * nloc) {
            __builtin_amdgcn_fence(__ATOMIC_RELEASE, "agent");
            asm volatile("s_waitcnt vmcnt(0)" ::: "memory");
            const unsigned og = xb_add(&bar[XB_TOP], 1u);
            const unsigned tg = og / nx;
            if (og + 1u == (tg + 1u) * nx) xb_add(&bar[XB_TOPGEN], 1u);
            else XB_SPIN(xb_ld(&bar[XB_TOPGEN]) == tg, bar);
            __builtin_amdgcn_fence(__ATOMIC_ACQUIRE, "agent");
            xb_add(&bar[XB_XGEN(b.x)], 1u);
            asm volatile("s_waitcnt vmcnt(0)" ::: "memory");
        } else {
            XB_SPIN(xb_ld(&bar[XB_XGEN(b.x)]) == gen, bar);
            __builtin_amdgcn_fence(__ATOMIC_ACQUIRE, "agent");
            asm volatile("s_waitcnt vmcnt(0)" ::: "memory");
        }
    }
    __syncthreads();
}

struct Frame {
    LAS unsigned char* lds;
    volatile LAS unsigned* MISC;
    gu32* ctl;
    int tid, lane, wave, vcu, G;
    const float *x_prompt, *x_sample, *cache_k, *cache_v, *cache_conv, *c_prompt, *c_sample, *g_norm, *w_ada, *b_ada, *w_in, *conv_w, *conv_b, *rel_bias, *w_out, *g_final;
    float* out;
    float *modA, *modB, *gate;
    bf16 *WT1, *WT2, *H, *MIX, *U, *Gc, *Q, *SZ, *KA, *VA, *XN, *PART;
};

__device__ __forceinline__ int win_src_col(int np) {
    const int tile = np >> 8, r = np & 255, half = r >> 7, c = r & 127;
    if (tile < 16) return (half ? 4096 : 0) + 128 * tile + c;
    if (tile < 32) return (half ? 6144 : 2048) + 128 * (tile - 16) + c;
    return np;
}
__device__ __forceinline__ void p0_transpose_item(const float* W, int K, int N, bf16* WT, int k0, int src_n0, int dst_n0, LAS float* scr, int lane) {
    const float* wp = W + (size_t)(k0 + (lane >> 3)) * N + src_n0 + 4 * (lane & 7); f32x4 v[8];
#pragma unroll
    for (int i = 0; i < 8; ++i) v[i] = __builtin_nontemporal_load((const GAS f32x4*)(wp + (size_t)(8 * i) * N));
#pragma unroll
    for (int i = 0; i < 8; ++i) { LAS float* d = scr + (8 * i + (lane >> 3)) * 33 + 4 * (lane & 7); d[0] = v[i][0]; d[1] = v[i][1]; d[2] = v[i][2]; d[3] = v[i][3]; }
    LDS_WAIT(); asm volatile("" ::: "memory");
    const int c = lane & 7;
#pragma unroll
    for (int j = 0; j < 4; ++j) { const int n = (lane >> 3) + 8 * j; const LAS float* s = scr + (8 * c) * 33 + n;
        v4u o; o.x = cvtpk(s[0 * 33], s[1 * 33]); o.y = cvtpk(s[2 * 33], s[3 * 33]); o.z = cvtpk(s[4 * 33], s[5 * 33]); o.w = cvtpk(s[6 * 33], s[7 * 33]);
        *(GAS v4u*)(WT + (size_t)(dst_n0 + n) * LDK + k0 + 8 * c) = o; }
    LDS_WAIT(); asm volatile("" ::: "memory");
}
__device__ __forceinline__ void p0_ada_task(Frame& F, int task) {
    int tid_ = F.tid; asm volatile("" : "+v"(tid_));
    const int n0 = 64 * task, lane = tid_ & 63, w = F.wave, q = lane & 15, r = lane >> 4;
    LAS float* cs = (LAS float*)(F.lds + RING_OFF + w * 8704);
    f32x4 acc[2][4]; float ap[4] = {0.f, 0.f, 0.f, 0.f};
#pragma unroll
    for (int h = 0; h < 2; ++h)
#pragma unroll
        for (int e = 0; e < 4; ++e) acc[h][e] = (f32x4){0.f, 0.f, 0.f, 0.f};
    const float* wbase = F.w_ada + (size_t)r * (3 * DM) + n0 + 4 * q;
#define ADA_LOADW(WV, bt) do { _Pragma("unroll") for (int i = 0; i < 8; ++i) WV[i] = __builtin_nontemporal_load((const GAS f32x4*)(wbase + (size_t)(512 * w + 32 * (bt) + 4 * i) * (3 * DM))); } while (0)
#define ADA_LOADC(ch) do { const int k0_ = 512 * w + 64 * (ch); _Pragma("unroll") for (int j = 0; j < 8; ++j) { const int idx = j * 64 + lane; \
        cr[j] = *(const GAS f32x4*)(F.c_sample + (size_t)(idx >> 4) * DM + k0_ + 4 * (idx & 15)); } cpr = F.c_prompt[k0_ + lane]; } while (0)
#define ADA_MMA(WV, hb) do { _Pragma("unroll") for (int i = 0; i < 8; ++i) { const int kk = 4 * (8 * (hb) + i) + r; \
        const float a0 = cs[q * 65 + kk], a1 = cs[(q + 16) * 65 + kk], cp = cs[32 * 65 + kk]; \
        _Pragma("unroll") for (int e = 0; e < 4; ++e) { acc[0][e] = __builtin_amdgcn_mfma_f32_16x16x4f32(a0, WV[i][e], acc[0][e], 0, 0, 0); \
            acc[1][e] = __builtin_amdgcn_mfma_f32_16x16x4f32(a1, WV[i][e], acc[1][e], 0, 0, 0); ap[e] = fmaf(cp, WV[i][e], ap[e]); } } } while (0)
    f32x4 wvA[8], wvB[8], cr[8]; float cpr;
    ADA_LOADC(0); ADA_LOADW(wvA, 0);
    for (int ch = 0; ch < 8; ++ch) {
#pragma unroll
        for (int j = 0; j < 8; ++j) { const int idx = j * 64 + lane; LAS float* d = cs + (idx >> 4) * 65 + 4 * (idx & 15); d[0] = cr[j][0]; d[1] = cr[j][1]; d[2] = cr[j][2]; d[3] = cr[j][3]; }
        cs[32 * 65 + lane] = cpr;
        LDS_WAIT(); asm volatile("" ::: "memory");
        if (ch + 1 < 8) ADA_LOADC(ch + 1);
        ADA_LOADW(wvB, 2 * ch + 1);
        ADA_MMA(wvA, 0);
        if (ch + 1 < 8) ADA_LOADW(wvA, 2 * ch + 2);
        ADA_MMA(wvB, 1);
        LDS_WAIT(); asm volatile("" ::: "memory");
    }
#undef ADA_LOADW
#undef ADA_LOADC
#undef ADA_MMA
#pragma unroll
    for (int e = 0; e < 4; ++e) { ap[e] += __shfl_xor(ap[e], 16); ap[e] += __shfl_xor(ap[e], 32); }
#pragma unroll
    for (int h = 0; h < 2; ++h)
#pragma unroll
        for (int e = 0; e < 4; ++e)
#pragma unroll
            for (int i = 0; i < 4; ++i) cs[(16 * h + 4 * r + i) * 64 + 4 * q + e] = acc[h][e][i];
    if (r == 0) {
#pragma unroll
        for (int e = 0; e < 4; ++e) cs[32 * 64 + 4 * q + e] = ap[e]; }
    LDS_WAIT(); __syncthreads();
    for (int idx = F.tid; idx < 33 * 64; idx += NWAVES * 64) {
        float s = 0.f;
#pragma unroll
        for (int qq = 0; qq < 8; ++qq) s += ((LAS float*)(F.lds + RING_OFF + qq * 8704))[idx];
        const int rr = idx >> 6, col = n0 + (idx & 63), bb = (rr == 32) ? 0 : 1 + rr;
        s += F.b_ada[col];
        if (col < DM) F.modB[(size_t)bb * DM + col] = s;
        else if (col < 2 * DM) F.modA[(size_t)bb * DM + col - DM] = F.g_norm[col - DM] * (1.f + s);
        else F.gate[(size_t)bb * DM + col - 2 * DM] = s;
    }
    __syncthreads();
}
__device__ __forceinline__ void p0_prologue(Frame& F, int mode) {
    constexpr int N_ADA = 3 * DM / 64;
    if (mode != 2) for (int t = F.vcu; t < N_ADA; t += F.G) p0_ada_task(F, t);
    if (mode == 1) return;
    LAS float* scr = (LAS float*)(F.lds + RING_OFF + F.wave * 16384);
    int tid_ = F.tid; asm volatile("" : "+v"(tid_));
    const int gw = F.vcu * NWAVES + F.wave, NGW = F.G * NWAVES, lane = tid_ & 63;
    constexpr int I_IN = (DM / 64) * (NIN / 32);
    const bool weighted = F.G == 256; const int W3 = 3, NV = weighted ? (N_ADA + (256 - N_ADA) * W3) : F.G;
    const int nmine = (weighted && F.vcu >= N_ADA) ? W3 : 1, v0 = (weighted && F.vcu >= N_ADA) ? N_ADA + (F.vcu - N_ADA) * W3 : F.vcu;
    (void)gw; (void)NGW;
    for (int j = 0; j < nmine; ++j)
        for (int it = (v0 + j) * NWAVES + F.wave; it < I_IN; it += NV * NWAVES) { const int nblk = NIN / 32, kb = it / nblk, nb = it % nblk;
            p0_transpose_item(F.w_in, DM, NIN, F.WT1, 64 * kb, win_src_col(32 * nb), 32 * nb, scr, lane); }
}
__device__ __forceinline__ void p3_wout(Frame& F) {
    int tid_ = F.tid; asm volatile("" : "+v"(tid_));
    LAS float* scr = (LAS float*)(F.lds + RING_OFF + F.wave * 16384);
    const int gw = F.vcu * NWAVES + F.wave, NGW = F.G * NWAVES, lane = tid_ & 63;
    constexpr int I_OUT = (DM / 64) * (DM / 32);
    __syncthreads();
    for (int it = gw; it < I_OUT; it += NGW) { const int nblk = DM / 32, kb = it / nblk, nb = it % nblk; p0_transpose_item(F.w_out, DM, DM, F.WT2, 64 * kb, 32 * nb, 32 * nb, scr, lane); }
    __syncthreads();
}
__device__ __forceinline__ void p1_hrows(Frame& F) {
    int tid_ = F.tid; asm volatile("" : "+v"(tid_));
    const int gw = F.vcu * NWAVES + F.wave, NGW = F.G * NWAVES, lane = tid_ & 63;
    f32x4 A[16], B[16]; int cur_bb = -1;
    for (int mi = gw; mi < MT; mi += NGW) {
        const int m = MT - 1 - mi;
        const float* xrow = m < MP ? F.x_prompt + (size_t)m * DM : F.x_sample + (size_t)(m - MP) * DM;
        const int bb = m < MP ? 0 : 1 + ((m - MP) >> 5);
        const GAS f32x4* xr = (const GAS f32x4*)xrow + lane;
        f32x4 v[16];
#pragma unroll
        for (int j = 0; j < 16; ++j) v[j] = __builtin_nontemporal_load(xr + 64 * j);
        if (bb != cur_bb) { cur_bb = bb;
            const GAS f32x4* ar = (const GAS f32x4*)(F.modA + (size_t)bb * DM) + lane; const GAS f32x4* br = (const GAS f32x4*)(F.modB + (size_t)bb * DM) + lane;
#pragma unroll
            for (int j = 0; j < 16; ++j) { A[j] = ar[64 * j]; B[j] = br[64 * j]; } }
        float s = 0.f;
#pragma unroll
        for (int j = 0; j < 16; ++j) s += (v[j].x * v[j].x + v[j].y * v[j].y) + (v[j].z * v[j].z + v[j].w * v[j].w);
        const float rstd = 1.0f / sqrtf(wave_sum(s) * (1.f / DM) + NORM_EPS);
        GAS v2u* o8 = (GAS v2u*)(F.H + (size_t)m * LDK) + lane;
#pragma unroll
        for (int j = 0; j < 16; ++j) { const f32x4 hv = (v[j] * rstd) * A[j] + B[j]; v2u o; o.x = cvtpk(hv.x, hv.y); o.y = cvtpk(hv.z, hv.w); o8[64 * j] = o; }
    }
}
__device__ __forceinline__ void p5_final(Frame& F, bool splitk) {
    int tid_ = F.tid; asm volatile("" : "+v"(tid_));
    const int gw = F.vcu * NWAVES + F.wave, NGW = F.G * NWAVES, lane = tid_ & 63;
    f32x4 gf[16];
#pragma unroll
    for (int j = 0; j < 8; ++j) { gf[2 * j] = *(const GAS f32x4*)(F.g_final + 512 * j + 8 * lane); gf[2 * j + 1] = *(const GAS f32x4*)(F.g_final + 512 * j + 8 * lane + 4); }
    for (int mi = gw; mi < MT; mi += NGW) {
        const int m = MT - 1 - mi;
        f32x4 v[16];
        if (m >= MP && splitk) {
            const float* xr = F.x_sample + (size_t)(m - MP) * DM + 8 * lane; const float* gr = F.gate + (size_t)(1 + ((m - MP) >> 5)) * DM + 8 * lane;
            const bf16* pr = F.PART + (size_t)(m - MP) * DM + 8 * lane;
#pragma unroll
            for (int j = 0; j < 8; ++j) { const int o = 512 * j; f32x4 s0 = {0.f, 0.f, 0.f, 0.f}, s1 = {0.f, 0.f, 0.f, 0.f};
#pragma unroll
                for (int q = 0; q < 4; ++q) { const v4u w = *(const GAS v4u*)(pr + (size_t)q * MS * DM + o);
                    s0 += (f32x4){__uint_as_float(w.x << 16), __uint_as_float(w.x & 0xffff0000u), __uint_as_float(w.y << 16), __uint_as_float(w.y & 0xffff0000u)};
                    s1 += (f32x4){__uint_as_float(w.z << 16), __uint_as_float(w.z & 0xffff0000u), __uint_as_float(w.w << 16), __uint_as_float(w.w & 0xffff0000u)}; }
                v[2 * j] = *(const GAS f32x4*)(xr + o) + *(const GAS f32x4*)(gr + o) * s0; v[2 * j + 1] = *(const GAS f32x4*)(xr + o + 4) + *(const GAS f32x4*)(gr + o + 4) * s1; }
        } else {
            const bf16* xn = F.XN + (size_t)m * DM + 8 * lane; v4u w[8];
            const float* xr = (m < MP ? F.x_prompt + (size_t)m * DM : F.x_sample + (size_t)(m - MP) * DM) + 8 * lane;
#pragma unroll
            for (int j = 0; j < 8; ++j) w[j] = *(const GAS v4u*)(xn + 512 * j);
#pragma unroll
            for (int j = 0; j < 16; ++j) v[j] = *(const GAS f32x4*)(xr + 512 * (j >> 1) + 4 * (j & 1));
#pragma unroll
            for (int j = 0; j < 8; ++j) { v[2 * j] += (f32x4){__uint_as_float(w[j].x << 16), __uint_as_float(w[j].x & 0xffff0000u), __uint_as_float(w[j].y << 16), __uint_as_float(w[j].y & 0xffff0000u)};
                v[2 * j + 1] += (f32x4){__uint_as_float(w[j].z << 16), __uint_as_float(w[j].z & 0xffff0000u), __uint_as_float(w[j].w << 16), __uint_as_float(w[j].w & 0xffff0000u)}; }
        }
        float s = 0.f;
#pragma unroll
        for (int j = 0; j < 16; ++j) s += (v[j].x * v[j].x + v[j].y * v[j].y) + (v[j].z * v[j].z + v[j].w * v[j].w);
        const float rstd = 1.0f / sqrtf(wave_sum(s) * (1.f / DM) + NORM_EPS);
        float* yr = F.out + (size_t)m * DM + 8 * lane;
#pragma unroll
        for (int j = 0; j < 16; ++j) *(GAS f32x4*)(yr + 512 * (j >> 1) + 4 * (j & 1)) = (v[j] * rstd) * gf[j];
    }
}
namespace att {
constexpr int SHM_V = 16384, SHM_K = 16384, OFF_V = 0, OFF_K = 4 * SHM_V, OFF_BT = RING_BYTES + 8192;
static_assert(OFF_K + 4 * SHM_K <= RING_BYTES && OFF_BT + 2 * 2560 <= LDS_BYTES, "attention LDS map");
constexpr float THRL = 8.f * 1.4426950408889634f;
#define KSWZ(row, colB) ((row) * 256 + ((colB) ^ (((row) & 7) << 4)))
#define SBAR() __builtin_amdgcn_sched_barrier(0)
__device__ __forceinline__ int crow(int r, int hi) { return (r & 3) + 8 * (r >> 2) + 4 * hi; }
__device__ __forceinline__ int v_st(int k, int c) { const int kk = (k & ~0xC) | ((k & 4) << 1) | ((k & 8) >> 1); return ((kk >> 3) * 4 + (c >> 5)) * 512 + ((kk & 7) * 32 + (c & 31)) * 2; }
__device__ __forceinline__ int v_rd_base(int lane) { return ((lane & 3) << 3) | (((lane >> 2) & 3) << 6) | (((lane >> 4) & 1) << 5) | (((lane >> 5) & 1) << 8); }
constexpr int v_rd_off(int d0, int ks, int half) { return d0 * 512 + ks * 4096 + half * 2048; }
template <int OFF> __device__ __forceinline__ s16x4 tr_read(int vb) { s16x4 r; asm volatile("ds_read_b64_tr_b16 %0, %1 offset:%2" : "=&v"(r) : "v"(vb), "i"(OFF) : "memory"); return r; }
#define PK(L, H) (bf16x8){L[0], L[1], L[2], L[3], H[0], H[1], H[2], H[3]}
#define RD8(D0, X) const s16x4 X##l0 = tr_read<v_rd_off(D0, 0, 0)>(vb), X##h0 = tr_read<v_rd_off(D0, 0, 1)>(vb), X##l1 = tr_read<v_rd_off(D0, 1, 0)>(vb), X##h1 = tr_read<v_rd_off(D0, 1, 1)>(vb), \
                            X##l2 = tr_read<v_rd_off(D0, 2, 0)>(vb), X##h2 = tr_read<v_rd_off(D0, 2, 1)>(vb), X##l3 = tr_read<v_rd_off(D0, 3, 0)>(vb), X##h3 = tr_read<v_rd_off(D0, 3, 1)>(vb)
#define MM4(OD, X) do { OD = __builtin_amdgcn_mfma_f32_32x32x16_bf16(PK(X##l0, X##h0), pa0, OD, 0, 0, 0); OD = __builtin_amdgcn_mfma_f32_32x32x16_bf16(PK(X##l1, X##h1), pa1, OD, 0, 0, 0); \
                        OD = __builtin_amdgcn_mfma_f32_32x32x16_bf16(PK(X##l2, X##h2), pa2, OD, 0, 0, 0); OD = __builtin_amdgcn_mfma_f32_32x32x16_bf16(PK(X##l3, X##h3), pa3, OD, 0, 0, 0); } while (0)
__device__ __forceinline__ void pv_all(f32x16 (&o)[4], int vb, bf16x8 pa0, bf16x8 pa1, bf16x8 pa2, bf16x8 pa3) {
  RD8(0, a); RD8(1, b);
  asm volatile("s_waitcnt lgkmcnt(8)" ::: "memory"); SBAR(); MM4(o[0], a); SBAR();
  RD8(2, c);
  asm volatile("s_waitcnt lgkmcnt(8)" ::: "memory"); SBAR(); MM4(o[1], b); SBAR();
  RD8(3, d);
  asm volatile("s_waitcnt lgkmcnt(8)" ::: "memory"); SBAR(); MM4(o[2], c); SBAR();
  asm volatile("s_waitcnt lgkmcnt(0)" ::: "memory"); SBAR(); MM4(o[3], d);
}
#undef PK
#undef RD8
#undef MM4
struct AUnit { int h, qrow0, krow0, t0, T, ts, sample, probe; };
__device__ __forceinline__ void attn_prompt_units(Frame& F, char* lds, int probe, int i0, int i1) {
  int tid_ = F.tid; asm volatile("" : "+v"(tid_));
  const int tid = tid_, wid = F.wave, lane = tid & 63, r32 = lane & 31, hi = lane >> 5;
  bf16* V_lds = (bf16*)(lds + OFF_V); bf16* K_lds = (bf16*)(lds + OFF_K);
  const int lo = wid >> 1, hi_t = lo + 8, ibase = 32 * (wid & 1);
  const int sr = tid >> 4, sc = (tid & 15) * 8, vst0 = v_st(sr, sc), vst1 = v_st(32 + sr, sc);
  const int vb0 = (int)(uintptr_t)V_lds + v_rd_base(lane);
  bf16x8 xv0, xv1, xk0, xk1, qr[8]; float bt0 = 0.f, bt1 = 0.f;
  constexpr int NU = NH * (MP / 256);
#define UNIT_OF(un_, H_, QB_, T0_, TS_, K0_) const int H_ = (un_) >> 6, QB_ = (un_) & 63, T0_ = 8 - 4 * QB_ > 0 ? 8 - 4 * QB_ : 0, TS_ = QB_ < 2 ? T0_ : (20 - 4 * (QB_ % 3)) % 12, K0_ = 256 * QB_ - 512
#define SLOADU(k0_, h_, t) do { const size_t off_ = (size_t)((k0_) + 64 * (t) + sr) * DA + (h_) * HD + sc; \
    xv0 = *(const bf16x8*)(F.VA + off_); xv1 = *(const bf16x8*)(F.VA + off_ + 32 * DA); xk0 = *(const bf16x8*)(F.KA + off_); xk1 = *(const bf16x8*)(F.KA + off_ + 32 * DA); } while (0)
#define SWRITE(b) do { *(bf16x8*)((char*)V_lds + (b) * SHM_V + vst0) = xv0; *(bf16x8*)((char*)V_lds + (b) * SHM_V + vst1) = xv1; const int kc = sc * 2; \
    *(bf16x8*)((char*)K_lds + (b) * SHM_K + KSWZ(sr, kc)) = xk0; *(bf16x8*)((char*)K_lds + (b) * SHM_K + KSWZ(32 + sr, kc)) = xk1; } while (0)
#define WGBAR() do { asm volatile("s_waitcnt lgkmcnt(0)" ::: "memory"); __builtin_amdgcn_s_barrier(); asm volatile("" ::: "memory"); } while (0)
#define PREFETCH_UNIT(un_) do { UNIT_OF(un_, h_, qb_, t0_, ts_, k0_); (void)t0_; \
    { const int b0_ = tid + 192 < 512 ? tid + 192 : 512; bt0 = F.rel_bias[h_ * 513 + b0_]; bt1 = tid < 128 ? F.rel_bias[h_ * 513 + 512] : 0.f; } \
    { const bf16* Qw = F.Q + (size_t)(256 * qb_ + 32 * wid + r32) * DA + h_ * HD + hi * 8; _Pragma("unroll") for (int d0 = 0; d0 < 8; ++d0) qr[d0] = *(const bf16x8*)(Qw + d0 * 16); } \
    SLOADU(k0_, h_, ts_); } while (0)
#define PK4(P, BASE, OUT) do { unsigned a0 = cvtpk(P[BASE + 0], P[BASE + 1]), a1 = cvtpk(P[BASE + 2], P[BASE + 3]);   \
    unsigned b0 = cvtpk(P[BASE + 4], P[BASE + 5]), b1 = cvtpk(P[BASE + 6], P[BASE + 7]);                              \
    auto r0 = __builtin_amdgcn_permlane32_swap(a0, b0, false, false); auto r1 = __builtin_amdgcn_permlane32_swap(a1, b1, false, false); \
    v4u w_ = {r0[0], r1[0], r0[1], r1[1]}; OUT = *reinterpret_cast<bf16x8*>(&w_); } while (0)
  int un = F.vcu + i0 * F.G, ui = i0;
  if (un < NU && ui < i1) PREFETCH_UNIT(un);
  for (; un < NU && ui < i1; un += F.G, ++ui) {
    UNIT_OF(un, uh, uqb, ut0, uts, uk0);
    float* btab = (float*)(lds + OFF_BT + (ui & 1) * 2560);
    btab[tid] = bt0 * LOG2E; if (tid < 128) btab[tid + 512] = bt1 * LOG2E;
    const int ns = 12 - ut0, qrow = 256 * uqb + 32 * wid;
#define TILE_AT(s_) (uts + (s_) < 12 ? uts + (s_) : uts + (s_) - ns)
    SWRITE(0); if (1 < ns) SLOADU(uk0, uh, TILE_AT(1));
    float m_reg = -1e30f, l_reg = 0.f; f32x16 o[4] = {};
    { int sl = 0;
      for (int s_ = 0; s_ < ns; ++s_) {
        const int sn_ = sl == 2 ? 0 : sl + 1, t = TILE_AT(s_);
        WGBAR();
        if (s_ + 1 < ns && !(probe & 2)) { SWRITE(sn_); if (s_ + 2 < ns) SLOADU(uk0, uh, TILE_AT(s_ + 2)); }
        if (t >= lo && t <= hi_t && !(probe & 1)) {
          const int dt = t - lo; f32x16 p0, p1;
          if (dt <= 3) { const float c = btab[639];
#pragma unroll
            for (int r = 0; r < 16; ++r) { p0[r] = c; p1[r] = c; } }
          else { const float* bp = btab + (517 - 64 * dt + ibase + r32 - 4 * hi);
#pragma unroll
            for (int r = 0; r < 16; ++r) { const int kk = (r & 3) + 8 * (r >> 2); p0[r] = bp[59 - kk]; p1[r] = bp[27 - kk]; } }
          { const char* Ks = (const char*)K_lds + sl * SHM_K;
#if defined(ATT_SETPRIO)
            __builtin_amdgcn_s_setprio(1);
#endif
#pragma unroll
            for (int d0 = 0; d0 < 8; ++d0) { const int cb = (d0 * 16 + hi * 8) * 2;
              const bf16x8 b0 = *(const bf16x8*)(Ks + KSWZ(r32, cb)), b1 = *(const bf16x8*)(Ks + KSWZ(32 + r32, cb));
              p0 = __builtin_amdgcn_mfma_f32_32x32x16_bf16(b0, qr[d0], p0, 0, 0, 0);
              p1 = __builtin_amdgcn_mfma_f32_32x32x16_bf16(b1, qr[d0], p1, 0, 0, 0); }
#if defined(ATT_SETPRIO)
            __builtin_amdgcn_s_setprio(0);
#endif
          }
          float pmax = p0[0];
#pragma unroll
          for (int r = 1; r < 16; ++r) pmax = fmaxf(pmax, p0[r]);
#pragma unroll
          for (int r = 0; r < 16; ++r) pmax = fmaxf(pmax, p1[r]);
          { auto rr = __builtin_amdgcn_permlane32_swap(__float_as_uint(pmax), __float_as_uint(pmax), false, false); pmax = fmaxf(__uint_as_float(rr[0]), __uint_as_float(rr[1])); }
          float mn, alpha;
          if (__all(pmax - m_reg <= THRL)) { mn = m_reg; alpha = 1.f; }
          else { mn = fmaxf(m_reg, pmax); alpha = __builtin_amdgcn_exp2f(m_reg - mn); m_reg = mn; }
          float ps = 0.f;
#pragma unroll
          for (int r = 0; r < 16; ++r) { p0[r] = __builtin_amdgcn_exp2f(p0[r] - mn); p1[r] = __builtin_amdgcn_exp2f(p1[r] - mn); ps += p0[r] + p1[r]; }
          { auto rr = __builtin_amdgcn_permlane32_swap(__float_as_uint(ps), __float_as_uint(ps), false, false); ps = __uint_as_float(rr[0]) + __uint_as_float(rr[1]); }
          if (__any(alpha < 1.f)) {
#pragma unroll
            for (int d = 0; d < 4; ++d)
#pragma unroll
              for (int r = 0; r < 16; ++r) o[d][r] *= alpha; }
          l_reg = l_reg * alpha + ps;
          bf16x8 pa0, pa1, pa2, pa3;
          PK4(p0, 0, pa0); PK4(p0, 8, pa1); PK4(p1, 0, pa2); PK4(p1, 8, pa3);
#if defined(ATT_SETPRIO)
          __builtin_amdgcn_s_setprio(1);
#endif
          pv_all(o, vb0 + sl * SHM_V, pa0, pa1, pa2, pa3);
#if defined(ATT_SETPRIO)
          __builtin_amdgcn_s_setprio(0);
#endif
        }
        sl = sn_;
      } }
#undef TILE_AT
    WGBAR();
    char* st = lds + wid * 8192;
    { const float rl = __builtin_amdgcn_rcpf(l_reg);
#pragma unroll
      for (int d0 = 0; d0 < 4; ++d0)
#pragma unroll
        for (int g = 0; g < 4; ++g) { v2u w; w.x = cvtpk(o[d0][4 * g + 0] * rl, o[d0][4 * g + 1] * rl); w.y = cvtpk(o[d0][4 * g + 2] * rl, o[d0][4 * g + 3] * rl);
          *(v2u*)(st + r32 * 256 + (((4 * d0 + g) ^ (r32 & 15)) << 4) + 8 * hi) = w; } }
    const int rr = lane >> 4, ch = lane & 15;
    const bf16* szr = F.SZ + (size_t)(qrow + rr) * DA + uh * HD + 8 * ch; bf16* mr = F.MIX + (size_t)(qrow + rr) * LDK + DC + uh * HD + 8 * ch;
    v4u zz[8];
#pragma unroll
    for (int it = 0; it < 8; ++it) zz[it] = *(const GAS v4u*)(szr + (size_t)(4 * it) * DA);
    if (un + F.G < NU && ui + 1 < i1) PREFETCH_UNIT(un + F.G);
    asm volatile("s_waitcnt lgkmcnt(0)" ::: "memory");
    if (!(probe & 4)) {
#pragma unroll
      for (int it = 0; it < 8; ++it) { const int row = 4 * it + rr; const v4u ov = *(const v4u*)(st + row * 256 + ((ch ^ (row & 15)) << 4)); const v4u z = zz[it]; v4u w;
        w.x = cvtpk(__uint_as_float(ov.x << 16) * __uint_as_float(z.x << 16), __uint_as_float(ov.x & 0xffff0000u) * __uint_as_float(z.x & 0xffff0000u));
        w.y = cvtpk(__uint_as_float(ov.y << 16) * __uint_as_float(z.y << 16), __uint_as_float(ov.y & 0xffff0000u) * __uint_as_float(z.y & 0xffff0000u));
        w.z = cvtpk(__uint_as_float(ov.z << 16) * __uint_as_float(z.z << 16), __uint_as_float(ov.z & 0xffff0000u) * __uint_as_float(z.z & 0xffff0000u));
        w.w = cvtpk(__uint_as_float(ov.w << 16) * __uint_as_float(z.w << 16), __uint_as_float(ov.w & 0xffff0000u) * __uint_as_float(z.w & 0xffff0000u));
        *(GAS v4u*)(mr + (size_t)(4 * it) * LDK) = w; }
    }
    WGBAR();
  }
#undef PK4
#undef PREFETCH_UNIT
#undef WGBAR
#undef SWRITE
#undef SLOADU
#undef UNIT_OF
}
}
namespace att {
constexpr int SOFF_ML = RING_BYTES + 1024, SOFF_BT = SOFF_ML + 8 * 256;
static_assert(SOFF_BT + 2 * 2560 <= LDS_BYTES && SOFF_ML >= MISC_OFF + 128, "sample attention LDS map");
__device__ __forceinline__ void sample_pairs(Frame& F, char* lds, int wg) {
  int tid_ = F.tid; asm volatile("" : "+v"(tid_));
  const int tid = tid_, wid = F.wave, lane = tid & 63, r32 = lane & 31, hi = lane >> 5, q4 = wid & 3, pr = wid >> 2;
  const int pair = 2 * wg + pr, b = pair >> 4, h = pair & 15;
  char* wreg = lds + wid * 16384;
  float* btab = (float*)(lds + SOFF_BT + pr * 2560);
  float* ml = (float*)(lds + SOFF_ML);
  { const int t4 = tid & 255; const int hh = (2 * wg + (tid >> 8)) & 15; float* bt = (float*)(lds + SOFF_BT + (tid >> 8) * 2560);
    for (int i = t4; i < 640; i += 256) { const int bi = i + 192 < 512 ? i + 192 : 512; bt[i] = F.rel_bias[hh * 513 + bi] * LOG2E; } }
  bf16x8 qr[8];
  { const bf16* Qw = F.Q + (size_t)(MP + 32 * b + r32) * DA + h * HD + hi * 8;
#pragma unroll
    for (int d0 = 0; d0 < 8; ++d0) qr[d0] = *(const bf16x8*)(Qw + d0 * 16); }
  float m_reg = -1e30f, l_reg = 0.f; f32x16 o[4] = {};
  const int vb = (int)(uintptr_t)(wreg + 8192) + v_rd_base(lane);
  __syncthreads();
  const int nsub = q4 == 3 ? 5 : 4;
  int kwf[4], kwb[2];
#pragma unroll
  for (int j = 0; j < 4; ++j) kwf[j] = hi * 256 + ((8 * r32) ^ (((2 * j + hi) & 7) << 4));
#pragma unroll
  for (int j = 0; j < 2; ++j) kwb[j] = (lane >> 4) * 256 + ((16 * (lane & 15)) ^ (((4 * j + (lane >> 4)) & 7) << 4));
  const int vwf = hi * 64 + ((4 * r32) >> 5) * 512 + ((4 * r32) & 31) * 2, vwb = (lane >> 4) * 64 + ((8 * (lane & 15)) >> 5) * 512 + ((8 * (lane & 15)) & 31) * 2;
  const unsigned lofs = (unsigned)(hi * (NH * HD) + 4 * r32) * 4u;
  const unsigned lofb = (unsigned)((lane >> 4) * DA + 8 * (lane & 15)) * 2u;
  for (int s = 0; s < nsub; ++s) {
    const int jbase = s < 4 ? 128 * q4 + 32 * s : 512;
    if (s < 4) { const char* kg = (const char*)(F.cache_k + ((size_t)(b * 512 + jbase) * NH + h) * HD);
#pragma unroll
      for (int hf = 0; hf < 2; ++hf) { f32x4 kv[8];
#pragma unroll
        for (int i = 0; i < 8; ++i) kv[i] = __builtin_nontemporal_load((const GAS f32x4*)(kg + (size_t)(8 * hf + i) * (2 * NH * HD * 4) + lofs));
#pragma unroll
        for (int i = 0; i < 8; ++i) { v2u w; w.x = cvtpk(kv[i][0], kv[i][1]); w.y = cvtpk(kv[i][2], kv[i][3]); *(v2u*)(wreg + kwf[i & 3] + (8 * hf + i) * 512) = w; } } }
    else { const char* kg = (const char*)(F.KA + (size_t)(MP + 32 * b) * DA + h * HD); v4u kv[8];
#pragma unroll
      for (int i = 0; i < 8; ++i) kv[i] = *(const GAS v4u*)(kg + (size_t)i * (4 * DA * 2) + lofb);
#pragma unroll
      for (int i = 0; i < 8; ++i) *(v4u*)(wreg + kwb[i & 1] + i * 1024) = kv[i]; }
    f32x4 vvA[8]; const char* vg0 = (const char*)(F.cache_v + ((size_t)(b * 512 + (s < 4 ? jbase : 0)) * NH + h) * HD);
    if (s < 4) {
#pragma unroll
      for (int i = 0; i < 8; ++i) vvA[i] = __builtin_nontemporal_load((const GAS f32x4*)(vg0 + (size_t)i * (2 * NH * HD * 4) + lofs)); }
    asm volatile("s_waitcnt lgkmcnt(0)" ::: "memory");
    f32x16 p0;
    { const float* bp = btab + (549 + r32 - 4 * hi - jbase);
#pragma unroll
      for (int r = 0; r < 16; ++r) { const int kk = (r & 3) + 8 * (r >> 2); p0[r] = bp[27 - kk]; } }
#pragma unroll
    for (int d0 = 0; d0 < 8; ++d0) { const bf16x8 kf = *(const bf16x8*)(wreg + KSWZ(r32, (d0 * 16 + hi * 8) * 2)); p0 = __builtin_amdgcn_mfma_f32_32x32x16_bf16(kf, qr[d0], p0, 0, 0, 0); }
    float pmax = p0[0];
#pragma unroll
    for (int r = 1; r < 16; ++r) pmax = fmaxf(pmax, p0[r]);
    { auto rr = __builtin_amdgcn_permlane32_swap(__float_as_uint(pmax), __float_as_uint(pmax), false, false); pmax = fmaxf(__uint_as_float(rr[0]), __uint_as_float(rr[1])); }
    float mn, alpha;
    if (__all(pmax - m_reg <= THRL)) { mn = m_reg; alpha = 1.f; }
    else { mn = fmaxf(m_reg, pmax); alpha = __builtin_amdgcn_exp2f(m_reg - mn); m_reg = mn; }
    float ps = 0.f;
#pragma unroll
    for (int r = 0; r < 16; ++r) { p0[r] = __builtin_amdgcn_exp2f(p0[r] - mn); ps += p0[r]; }
    { auto rr = __builtin_amdgcn_permlane32_swap(__float_as_uint(ps), __float_as_uint(ps), false, false); ps = __uint_as_float(rr[0]) + __uint_as_float(rr[1]); }
    if (__any(alpha < 1.f)) {
#pragma unroll
      for (int d = 0; d < 4; ++d)
#pragma unroll
        for (int r = 0; r < 16; ++r) o[d][r] *= alpha; }
    l_reg = l_reg * alpha + ps;
    bf16x8 pa0, pa1;
#define PK4(P, BASE, OUT) do { unsigned a0 = cvtpk(P[BASE + 0], P[BASE + 1]), a1 = cvtpk(P[BASE + 2], P[BASE + 3]);   \
    unsigned b0 = cvtpk(P[BASE + 4], P[BASE + 5]), b1 = cvtpk(P[BASE + 6], P[BASE + 7]);                              \
    auto r0 = __builtin_amdgcn_permlane32_swap(a0, b0, false, false); auto r1 = __builtin_amdgcn_permlane32_swap(a1, b1, false, false); \
    v4u w_ = {r0[0], r1[0], r0[1], r1[1]}; OUT = *reinterpret_cast<bf16x8*>(&w_); } while (0)
    PK4(p0, 0, pa0); PK4(p0, 8, pa1);
#undef PK4
    if (s < 4) { f32x4 vvB[8];
#pragma unroll
      for (int i = 0; i < 8; ++i) vvB[i] = __builtin_nontemporal_load((const GAS f32x4*)(vg0 + (size_t)(8 + i) * (2 * NH * HD * 4) + lofs));
#pragma unroll
      for (int i = 0; i < 8; ++i) { v2u w; w.x = cvtpk(vvA[i][0], vvA[i][1]); w.y = cvtpk(vvA[i][2], vvA[i][3]);
        *(v2u*)(wreg + 8192 + vwf + ((i >> 1) & 1) * 2048 + ((i >> 2) & 1) * 256 + (i & 1) * 128) = w; }
#pragma unroll
      for (int i = 0; i < 8; ++i) { v2u w; w.x = cvtpk(vvB[i][0], vvB[i][1]); w.y = cvtpk(vvB[i][2], vvB[i][3]);
        *(v2u*)(wreg + 8192 + vwf + 4096 + ((i >> 1) & 1) * 2048 + ((i >> 2) & 1) * 256 + (i & 1) * 128) = w; } }
    else { const char* vg = (const char*)(F.VA + (size_t)(MP + 32 * b) * DA + h * HD); v4u vn[8];
#pragma unroll
      for (int i = 0; i < 8; ++i) vn[i] = *(const GAS v4u*)(vg + (size_t)i * (4 * DA * 2) + lofb);
#pragma unroll
      for (int i = 0; i < 8; ++i) *(v4u*)(wreg + 8192 + vwb + ((i >> 2) & 1) * 4096 + (i & 1) * 2048 + ((i >> 1) & 1) * 256) = vn[i]; }
    asm volatile("s_waitcnt lgkmcnt(0)" ::: "memory");
#define PK(L, H) (bf16x8){L[0], L[1], L[2], L[3], H[0], H[1], H[2], H[3]}
#define PVB(D0) do { const s16x4 l0 = tr_read<v_rd_off(D0, 0, 0)>(vb), h0 = tr_read<v_rd_off(D0, 0, 1)>(vb), l1 = tr_read<v_rd_off(D0, 1, 0)>(vb), h1 = tr_read<v_rd_off(D0, 1, 1)>(vb); \
      asm volatile("s_waitcnt lgkmcnt(0)" ::: "memory"); SBAR(); \
      o[D0] = __builtin_amdgcn_mfma_f32_32x32x16_bf16(PK(l0, h0), pa0, o[D0], 0, 0, 0); o[D0] = __builtin_amdgcn_mfma_f32_32x32x16_bf16(PK(l1, h1), pa1, o[D0], 0, 0, 0); } while (0)
    PVB(0); PVB(1); PVB(2); PVB(3);
#undef PVB
#undef PK
    asm volatile("s_waitcnt lgkmcnt(0)" ::: "memory");
  }
#pragma unroll
  for (int d0 = 0; d0 < 4; ++d0)
#pragma unroll
    for (int g = 0; g < 4; ++g) *(f32x4*)(wreg + d0 * 4096 + lane * 64 + g * 16) = (f32x4){o[d0][4 * g], o[d0][4 * g + 1], o[d0][4 * g + 2], o[d0][4 * g + 3]};
  if (hi == 0) { ml[wid * 64 + r32] = m_reg; ml[wid * 64 + 32 + r32] = l_reg; }
  asm volatile("s_waitcnt lgkmcnt(0)" ::: "memory"); __syncthreads();
  { float mj[4], lj[4], M = -1e30f;
#pragma unroll
    for (int j = 0; j < 4; ++j) { mj[j] = ml[(4 * pr + j) * 64 + r32]; lj[j] = ml[(4 * pr + j) * 64 + 32 + r32]; M = fmaxf(M, mj[j]); }
    float L = 0.f, wj[4];
#pragma unroll
    for (int j = 0; j < 4; ++j) { wj[j] = __builtin_amdgcn_exp2f(mj[j] - M); L += wj[j] * lj[j]; }
    const float rl = __builtin_amdgcn_rcpf(L);
    f32x4 acc[4];
#pragma unroll
    for (int g = 0; g < 4; ++g) acc[g] = (f32x4){0.f, 0.f, 0.f, 0.f};
#pragma unroll
    for (int j = 0; j < 4; ++j) { const char* pj = lds + (4 * pr + j) * 16384 + q4 * 4096 + lane * 64;
#pragma unroll
      for (int g = 0; g < 4; ++g) acc[g] += *(const f32x4*)(pj + g * 16) * wj[j]; }
    const int orow = MP + 32 * b + r32;
    const bf16* szr = F.SZ + (size_t)orow * DA + h * HD + 32 * q4 + 4 * hi; bf16* mr = F.MIX + (size_t)orow * LDK + DC + h * HD + 32 * q4 + 4 * hi;
    v2u sz[4];
#pragma unroll
    for (int g = 0; g < 4; ++g) sz[g] = *(const GAS v2u*)(szr + g * 8);
#pragma unroll
    for (int g = 0; g < 4; ++g) { const v2u z = sz[g];
      const float v0 = acc[g][0] * rl * __uint_as_float(z.x << 16), v1 = acc[g][1] * rl * __uint_as_float(z.x & 0xffff0000u);
      const float v2 = acc[g][2] * rl * __uint_as_float(z.y << 16), v3 = acc[g][3] * rl * __uint_as_float(z.y & 0xffff0000u);
      v2u w; w.x = cvtpk(v0, v1); w.y = cvtpk(v2, v3); *(GAS v2u*)(mr + g * 8) = w; }
  }
  __syncthreads();
}
}
__device__ __forceinline__ void p3_attention(Frame& F, char* lds, int probe, int i0 = 0, int i1 = 1 << 20) {
  if (!(probe & 16)) att::attn_prompt_units(F, lds, probe, i0, i1);
  if (!(probe & 8)) for (int wg = F.vcu; wg < NSB * NH / 2; wg += F.G) att::sample_pairs(F, lds, wg);
}
__device__ __forceinline__ void unpack8(const v4u w, float (&f)[8]) {
  f[0] = __uint_as_float(w.x << 16); f[1] = __uint_as_float(w.x & 0xffff0000u); f[2] = __uint_as_float(w.y << 16); f[3] = __uint_as_float(w.y & 0xffff0000u);
  f[4] = __uint_as_float(w.z << 16); f[5] = __uint_as_float(w.z & 0xffff0000u); f[6] = __uint_as_float(w.w << 16); f[7] = __uint_as_float(w.w & 0xffff0000u); }
__device__ __forceinline__ void p3_convmix(Frame& F) {
  const int gw = F.vcu * NWAVES + F.wave, NGW = F.G * NWAVES, lane = F.lane;
  constexpr int RB = 34; static_assert(MT % RB == 0 && (MT / RB) * 4 == 2048, "conv items");
  for (int it = gw; it < (MT / RB) * 4; it += NGW) {
    const int rb = it >> 2, c = 512 * (it & 3) + 8 * lane, r0 = RB * rb;
    float w0[8], w1[8], w2[8], cb[8], um2[8], um1[8];
    { const f32x4 a0 = *(const GAS f32x4*)(F.conv_w + c), a1 = *(const GAS f32x4*)(F.conv_w + c + 4), b0 = *(const GAS f32x4*)(F.conv_w + DC + c), b1 = *(const GAS f32x4*)(F.conv_w + DC + c + 4);
      const f32x4 c0 = *(const GAS f32x4*)(F.conv_w + 2 * DC + c), c1 = *(const GAS f32x4*)(F.conv_w + 2 * DC + c + 4), d0 = *(const GAS f32x4*)(F.conv_b + c), d1 = *(const GAS f32x4*)(F.conv_b + c + 4);
#pragma unroll
      for (int j = 0; j < 4; ++j) { w0[j] = a0[j]; w0[4 + j] = a1[j]; w1[j] = b0[j]; w1[4 + j] = b1[j]; w2[j] = c0[j]; w2[4 + j] = c1[j]; cb[j] = d0[j]; cb[4 + j] = d1[j]; } }
    if (r0 == 0) {
#pragma unroll
      for (int j = 0; j < 8; ++j) { um2[j] = 0.f; um1[j] = 0.f; } }
    else if (r0 > MP && ((r0 - MP) & 31) == 1) { const float* cc = F.cache_conv + (size_t)((r0 - MP) >> 5) * 2 * DC + DC + c;
#pragma unroll
      for (int j = 0; j < 8; ++j) um2[j] = cc[j];
      unpack8(*(const GAS v4u*)(F.U + (size_t)(r0 - 1) * DC + c), um1); }
    else if (r0 >= MP && ((r0 - MP) & 31) == 0) {
#pragma unroll
      for (int j = 0; j < 8; ++j) { um2[j] = 0.f; um1[j] = 0.f; } }
    else { unpack8(*(const GAS v4u*)(F.U + (size_t)(r0 - 2) * DC + c), um2); unpack8(*(const GAS v4u*)(F.U + (size_t)(r0 - 1) * DC + c), um1); }
    for (int g0 = 0; g0 < RB; g0 += 8) {
      const int nr = RB - g0 < 8 ? RB - g0 : 8;
      v4u ur[8], gr[8];
#pragma unroll
      for (int i = 0; i < 8; ++i) if (i < nr) { const size_t ro = (size_t)(r0 + g0 + i) * DC + c; ur[i] = __builtin_nontemporal_load((const GAS v4u*)(F.U + ro)); gr[i] = __builtin_nontemporal_load((const GAS v4u*)(F.Gc + ro)); }
#pragma unroll
      for (int i = 0; i < 8; ++i) if (i < nr) { const int r = r0 + g0 + i; float uu[8], gg[8], ov[8];
        if (r >= MP && ((r - MP) & 31) == 0) { const float* cc = F.cache_conv + (size_t)((r - MP) >> 5) * 2 * DC + c;
#pragma unroll
          for (int j = 0; j < 8; ++j) { um2[j] = cc[j]; um1[j] = cc[DC + j]; } }
        unpack8(ur[i], uu); unpack8(gr[i], gg);
#pragma unroll
        for (int j = 0; j < 8; ++j) { ov[j] = (cb[j] + w0[j] * um2[j] + w1[j] * um1[j] + w2[j] * uu[j]) * gg[j]; um2[j] = um1[j]; um1[j] = uu[j]; }
        v4u o; o.x = cvtpk(ov[0], ov[1]); o.y = cvtpk(ov[2], ov[3]); o.z = cvtpk(ov[4], ov[5]); o.w = cvtpk(ov[6], ov[7]);
        *(GAS v4u*)(F.MIX + (size_t)r * LDK + c) = o; }
    }
  }
}
struct Args { const float* in[16]; float* out; unsigned char* ws; int ph_lo, ph_hi; };
__global__ void __launch_bounds__(NWAVES * 64, 2) fwd(Args args) {
    extern __shared__ __attribute__((aligned(16))) unsigned char lds[];
    Frame F;
    F.lds = (LAS unsigned char*)lds;
    F.MISC = (volatile LAS unsigned*)(F.lds + MISC_OFF);
    F.tid = threadIdx.x; F.lane = F.tid & 63; F.wave = __builtin_amdgcn_readfirstlane(F.tid >> 6);
    F.G = gridDim.x; { const int bx = blockIdx.x; F.vcu = (F.G % 8 == 0) ? (bx % 8) * (F.G / 8) + bx / 8 : bx; }
    unsigned char* ws = args.ws;
    F.ctl = (gu32*)(ws + WS_CTL);
    F.x_prompt = args.in[0]; F.x_sample = args.in[1]; F.cache_k = args.in[2]; F.cache_v = args.in[3]; F.cache_conv = args.in[4]; F.c_prompt = args.in[5]; F.c_sample = args.in[6];
    F.g_norm = args.in[7]; F.w_ada = args.in[8]; F.b_ada = args.in[9]; F.w_in = args.in[10]; F.conv_w = args.in[11]; F.conv_b = args.in[12]; F.rel_bias = args.in[13]; F.w_out = args.in[14]; F.g_final = args.in[15];
    F.out = args.out;
    F.modA = (float*)(ws + WS_MOD); F.modB = (float*)(ws + WS_MOD + MOD_STRIDE); F.gate = (float*)(ws + WS_MOD + 2 * MOD_STRIDE);
    F.WT1 = (bf16*)(ws + WS_WT1); F.WT2 = (bf16*)(ws + WS_WT2); F.H = (bf16*)(ws + WS_H); F.MIX = (bf16*)(ws + WS_H);
    F.U = (bf16*)(ws + WS_U); F.Gc = (bf16*)(ws + WS_G); F.Q = (bf16*)(ws + WS_Q); F.SZ = (bf16*)(ws + WS_SZ); F.KA = (bf16*)(ws + WS_KA); F.VA = (bf16*)(ws + WS_VA); F.XN = (bf16*)(ws + WS_XN); F.PART = (bf16*)(ws + WS_PART);
    for (int u = F.tid; u < (LDS_BYTES - LDSCTL_OFF) / 4; u += NWAVES * 64) ((LAS unsigned*)(F.lds + LDSCTL_OFF))[u] = 0u;
    __syncthreads();
    XcdBarrier bar; bar.bar = (unsigned*)(F.ctl + CW_BAR); bar.x = 0; bar.st = nullptr;
    if (N_LAUNCHES != PER_PHASE) bar = xcd_barrier_post((unsigned*)(F.ctl + CW_BAR), F.MISC + 8);
#if defined(PROBE_STAMP)
    unsigned long long ta = 0, tb = 0;
#define STAMP(i) do { if ((i) == PROBE_STAMP || (PROBE_STAMP == 100 && (i) == 0)) ta = __builtin_amdgcn_s_memrealtime(); if ((i) == PROBE_STAMP + 1) tb = __builtin_amdgcn_s_memrealtime(); } while (0)
#define GRID_BAR(i) do { if (N_LAUNCHES != PER_PHASE) xcd_barrier(bar); STAMP(i); } while (0)
    STAMP(0);
#else
#define GRID_BAR(i) do { if (N_LAUNCHES != PER_PHASE) xcd_barrier(bar); } while (0)
#endif
    const int lo = args.ph_lo, hi = args.ph_hi;
    const bool splitk = (F.G == 256);
#define IN(k) (lo <= (k) && (k) < hi)
#define BOTH(k) (IN(k) && IN((k) + 1))
#ifndef PROBE_REPEAT
#define PROBE_REPEAT 0
#endif
#define REP(k) ((PROBE_REPEAT >> (4 * (k))) & 15)
#if defined(PROBE_P0SPLIT)
    if (IN(0)) { STAMP(20); p0_prologue(F, 1); xcd_barrier(bar); STAMP(21); p0_prologue(F, 2); GRID_BAR(1); STAMP(22); }
#else
    if (IN(0)) { for (int rep = 0; rep <= REP(0); ++rep) { p0_prologue(F, 0); if (BOTH(0)) GRID_BAR(1); } }
#endif
    if (IN(1)) { for (int rep = 0; rep <= REP(1); ++rep) { p1_hrows(F); if (BOTH(1)) GRID_BAR(2); } }
#if defined(PROBE_MFMA)
    if (IN(2)) {
        const bf16* ha = F.H + (size_t)(blockIdx.x * 64 + F.lane) * LDK + F.wave * 64; const bf16* wb = F.WT1 + (size_t)(blockIdx.x * 64 + F.lane) * LDK + F.wave * 64;
        bf16x8 a[8], b[8];
#pragma unroll
        for (int j = 0; j < 8; ++j) { a[j] = *(const bf16x8*)(ha + 8 * j); b[j] = *(const bf16x8*)(wb + 8 * j); }
        f32x4 acc[16];
#pragma unroll
        for (int j = 0; j < 16; ++j) acc[j] = (f32x4){0.f, 0.f, 0.f, 0.f};
        for (int it = 0; it < 17 * 64 * 4 / PROBE_MFMA; ++it) {
#pragma unroll
            for (int j = 0; j < 16; ++j) acc[j] = __builtin_amdgcn_mfma_f32_16x16x32_bf16(a[j & 7], b[(j >> 1) & 7], acc[j], 0, 0, 0);
        }
        float sacc = 0.f;
#pragma unroll
        for (int j = 0; j < 16; ++j) sacc += acc[j][0] + acc[j][1] + acc[j][2] + acc[j][3];
        if (sacc == 12345.678f) F.ctl[64] = 1u;
        GRID_BAR();
    }
#endif
    for (int rep = 0; rep <= REP(2); ++rep)
    if (IN(2)) {
        pg8::Gemm g{F.H, F.WT1, MT, NIN, DM, LDK};
#if defined(PROBE_GEMM)
        g.probe = rep ? PROBE_GEMM : 0;
#endif
        pg8::EpiIn E{F.U, F.Gc, F.Q, F.SZ, F.KA, F.VA, F.out};
        if (splitk) { typedef pg8::G1_ORDER G1; G1 S; S.init(MT, NIN, DM, (int)blockIdx.x); pg8::gemm_phase<pg8::EpiIn, G1, PG8_ALIGN, PG8_SP2>(F.lds + RING_OFF, g, S, E); }
        else { pg8::StaticOrder S; S.init(MT, NIN, DM, F.G, (int)blockIdx.x); pg8::gemm_phase<pg8::EpiIn, pg8::StaticOrder, PG8_ALIGN, PG8_SP2>(F.lds + RING_OFF, g, S, E); }
        if (BOTH(2)) GRID_BAR(3);
#if defined(PROBE_ADA_LATE)
        STAMP(30); p0_prologue(F, PROBE_ADA_LATE); xcd_barrier(bar); STAMP(31);
#endif
    }
    for (int rep = 0; rep <= REP(3); ++rep)
    if (IN(3)) {
#if defined(PROBE_P3) && PROBE_P3 == 1
        if (rep == 0) p3_convmix(F); p3_attention(F, (char*)lds + RING_OFF, rep ? PROBE_ATT : 0);
#elif defined(PROBE_P3) && PROBE_P3 == 2
        if (rep == 0) p3_attention(F, (char*)lds + RING_OFF, 0); p3_convmix(F);
#elif defined(PROBE_STAMP) && PROBE_STAMP >= 10
#if defined(PROBE_HOTKV)
        p3_attention(F, (char*)lds + RING_OFF, 8); xcd_barrier(bar);
        STAMP(10); p3_attention(F, (char*)lds + RING_OFF, 8 + 4 + PROBE_HOTKV); xcd_barrier(bar); STAMP(11);
#else
        STAMP(10); p3_attention(F, (char*)lds + RING_OFF, 8); xcd_barrier(bar); STAMP(11);
#endif
        p3_attention(F, (char*)lds + RING_OFF, 16); xcd_barrier(bar); STAMP(12); p3_convmix(F); p3_wout(F); xcd_barrier(bar); STAMP(13);
#else
        { const int xg = F.vcu >> 5, grp = xg < 3 ? 0 : (xg < 6 ? 1 : 2); char* al = (char*)lds + RING_OFF;
          if (grp == 1) { p3_convmix(F); p3_attention(F, al, 16); p3_wout(F); p3_attention(F, al, 8); }
          else if (grp == 2) { p3_attention(F, al, 8, 0, 2); p3_attention(F, al, 16); p3_convmix(F); p3_wout(F); p3_attention(F, al, 8, 2, 1 << 20); }
          else { p3_attention(F, al, 0); p3_convmix(F); p3_wout(F); } }
#endif
        if (BOTH(3)) GRID_BAR(4); }
    for (int rep = 0; rep <= REP(4); ++rep)
    if (IN(4)) {
        pg8::Gemm g{F.MIX, F.WT2, MT, DM, DM, LDK};
#if defined(PROBE_GEMM)
        g.probe = 0;
#endif
        pg8::EpiOut E{F.gate, F.XN, F.PART};
        if (splitk) { pg8::TailSplitOrder S; S.init(F.G, (int)blockIdx.x); pg8::gemm_phase<pg8::EpiOut, pg8::TailSplitOrder, PG8_ALIGN, PG8_SP2>(F.lds + RING_OFF, g, S, E); }
        else { pg8::StaticOrder S; S.init(MT, DM, DM, F.G, (int)blockIdx.x); pg8::gemm_phase<pg8::EpiOut, pg8::StaticOrder, PG8_ALIGN, PG8_SP2>(F.lds + RING_OFF, g, S, E); }
        if (BOTH(4)) GRID_BAR(5);
    }
    if (IN(5)) { p5_final(F, splitk); }
#if defined(PROBE_STAMP)
    STAMP(6);
#if PROBE_STAMP == 100
    tb = __builtin_amdgcn_s_memrealtime();
#endif
    if (blockIdx.x == 0 && F.tid == 0) { const unsigned long long d = tb - ta, te = __builtin_amdgcn_s_memrealtime();
        while (__builtin_amdgcn_s_memrealtime() - te < 4ull * d) __builtin_amdgcn_s_sleep(32); }
#endif
#undef IN
#undef BOTH
}

extern "C" void kernel_launch(void* const* d_in, const int* in_sizes, int n_in, void* d_out, int out_size, void* d_ws, size_t ws_size, hipStream_t stream) {
    static int grid = 0;
    if (grid == 0) {
        if (n_in != 16 || in_sizes[0] != MP * DM || out_size != (int)O_END || ws_size < WS_END) {
            fprintf(stderr, "kernel_launch: shape mismatch: n_in %d in0 %d out %d ws %zu (need >= %zu); nothing launched\n", n_in, n_in > 0 ? in_sizes[0] : -1, out_size, ws_size, (size_t)WS_END); grid = -1; return; }
        int dev = 0, cus = 0, per_cu = 0;
        if (hipGetDevice(&dev) != hipSuccess || hipDeviceGetAttribute(&cus, hipDeviceAttributeMultiprocessorCount, dev) != hipSuccess) { fprintf(stderr, "kernel_launch: device query failed\n"); grid = -1; return; }
        if (hipFuncSetAttribute((const void*)fwd, hipFuncAttributeMaxDynamicSharedMemorySize, LDS_BYTES) != hipSuccess) { fprintf(stderr, "kernel_launch: hipFuncSetAttribute failed\n"); grid = -1; return; }
        if (hipOccupancyMaxActiveBlocksPerMultiprocessor(&per_cu, (const void*)fwd, NWAVES * 64, LDS_BYTES) != hipSuccess || per_cu < 1)
            fprintf(stderr, "kernel_launch: note: occupancy query reports %d workgroups per CU\n", per_cu);
        (void)hipGetLastError();
        grid = cus;
    }
    if (grid < 0) return;
    if (hipMemsetAsync((char*)d_ws + WS_CTL, 0, CTL_ZERO_BYTES, stream) != hipSuccess) { fprintf(stderr, "kernel_launch: memset failed\n"); return; }
    Args a{};
    for (int i = 0; i < 16; ++i) a.in[i] = (const float*)d_in[i];
    a.out = (float*)d_out; a.ws = (unsigned char*)d_ws;
    const int nl = (N_LAUNCHES == PER_PHASE) ? PER_PHASE : 1;
    for (int li = 0; li < nl; ++li) {
        a.ph_lo = (N_LAUNCHES == PER_PHASE) ? li : 0; a.ph_hi = (N_LAUNCHES == PER_PHASE) ? li + 1 : PER_PHASE;
        hipLaunchKernelGGL(fwd, dim3(grid), dim3(NWAVES * 64), LDS_BYTES, stream, a);
        const hipError_t le = hipPeekAtLastError();
        if (le != hipSuccess) { fprintf(stderr, "kernel_launch: launch %d failed: %s\n", li, hipGetErrorName(le)); break; }
    }
}
```
